# Optimizing an MI355X kernel written in HIP

```python
import math
import jax
import jax.numpy as jnp
from jax import lax
import numpy as np

D_MODEL = 1024
BATCH = 1
SEQ = 16384
DEPTH = 1

D_MIX = D_MODEL
GM_HEADS = 8
GM_WIDTH = D_MIX // 2
GM_HEAD_DIM = GM_WIDTH // GM_HEADS
GM_CHUNK = 128
DN_HEADS = 4
DN_WIDTH = D_MIX - GM_WIDTH
DN_HEAD_DIM = DN_WIDTH // DN_HEADS
DN_CHUNK = 64
CONV_K = 4
COL_GM = 0
COL_Q = COL_GM + 2 * GM_WIDTH
COL_K = COL_Q + DN_WIDTH
COL_V = COL_K + DN_WIDTH
COL_Z = COL_V + DN_WIDTH
COL_A = COL_Z + DN_WIDTH
COL_B = COL_A + DN_HEADS
D_IN = COL_B + DN_HEADS
PEER_HEADS = 8
N_KEYS = 128
N_EXPERTS = N_KEYS * N_KEYS
PEER_QUERY_DIM = 256
PEER_HALF = PEER_QUERY_DIM // 2
PEER_TOPK = 16
PEER_BLOCK = 128
EPS = 1e-6

kernel_name = 'hybrid_gmlp_gdn_peer_adaln'


def rms_norm(x, w):
    xf = x.astype(jnp.float32)
    y = xf * lax.rsqrt(jnp.mean(xf * xf, axis=-1, keepdims=True) + EPS)
    return (y * w.astype(jnp.float32)).astype(x.dtype)


def l2_norm(x):
    return x * lax.rsqrt(jnp.sum(x * x, axis=-1, keepdims=True) + EPS)


def modulate(h, shift, scale):
    return h * (1 + scale[:, None, :]) + shift[:, None, :]


def spatial_gating(u, v, norm_w, ws, bs):
    B, S, _ = u.shape
    v = rms_norm(v, norm_w).reshape(B, S // GM_CHUNK, GM_CHUNK, GM_HEADS, GM_HEAD_DIM)
    causal = jnp.tril(jnp.ones((GM_CHUNK, GM_CHUNK), dtype=bool))
    w = jnp.where(causal, ws, 0.0)
    s = jnp.einsum('hts,bnshd->bnthd', w, v) + bs.T[:, :, None]
    return u * s.reshape(B, S, GM_WIDTH)


def short_conv(x, w):
    return lax.conv_general_dilated(
        x, w[:, None, :], window_strides=(1,), padding=[(CONV_K - 1, 0)],
        dimension_numbers=('NWC', 'WIO', 'NWC'), feature_group_count=x.shape[-1])


def gated_delta_rule(q, k, v, g, beta):
    B, S, H, Dk = q.shape
    Dv = v.shape[-1]
    C = DN_CHUNK
    N = S // C

    def chunked(t):
        return t.reshape(B, N, C, H, -1).transpose(0, 3, 1, 2, 4)

    q = chunked(q) * (Dk ** -0.5)
    k = chunked(k)
    v = chunked(v)
    g = g.reshape(B, N, C, H).transpose(0, 3, 1, 2)
    beta = beta.reshape(B, N, C, H).transpose(0, 3, 1, 2)
    gc = jnp.cumsum(g, axis=-1)
    incl = jnp.tril(jnp.ones((C, C), dtype=bool))
    strict = jnp.tril(jnp.ones((C, C), dtype=bool), -1)
    decay = jnp.exp(jnp.where(incl, gc[..., :, None] - gc[..., None, :], -jnp.inf))
    kb = k * beta[..., None]
    kk = jnp.einsum('bhnid,bhnjd->bhnij', kb, k) * decay
    a_mat = jnp.eye(C, dtype=jnp.float32) + jnp.where(strict, kk, 0.0)
    rhs = jnp.concatenate([v * beta[..., None], kb * jnp.exp(gc)[..., None]], axis=-1)
    sol = lax.linalg.triangular_solve(a_mat, rhs, left_side=True, lower=True, unit_diagonal=True)
    u_val, w = sol[..., :Dv], sol[..., Dv:]
    attn = jnp.einsum('bhnid,bhnjd->bhnij', q, k) * decay
    q_dec = q * jnp.exp(gc)[..., None]
    g_last = gc[..., -1]
    k_dec = k * jnp.exp(g_last[..., None] - gc)[..., None]

    def step(state, xs):
        q_c, a_c, w_c, u_c, k_c, gl = xs
        v_new = u_c - jnp.einsum('bhck,bhkv->bhcv', w_c, state)
        o = jnp.einsum('bhck,bhkv->bhcv', q_c, state) + jnp.einsum('bhij,bhjv->bhiv', a_c, v_new)
        state = state * jnp.exp(gl)[..., None, None] + jnp.einsum('bhck,bhcv->bhkv', k_c, v_new)
        return state, o

    xs = tuple(jnp.moveaxis(t, 2, 0) for t in (q_dec, attn, w, u_val, k_dec, g_last))
    state0 = jnp.zeros((B, H, Dk, Dv), jnp.float32)
    _, o = lax.scan(step, state0, xs)
    return o.transpose(1, 0, 3, 2, 4).reshape(B, S, H, Dv)


def hybrid_mixer(p, gm_norm_w, gm_ws, gm_bs, conv_w, a_log, dt_bias, o_norm_w):
    B, S, _ = p.shape
    uv = jax.nn.gelu(p[..., COL_GM:COL_Q])
    y_a = spatial_gating(uv[..., :GM_WIDTH], uv[..., GM_WIDTH:], gm_norm_w, gm_ws, gm_bs)
    qkv = jax.nn.silu(short_conv(p[..., COL_Q:COL_Z], conv_w)).astype(jnp.float32)
    q = l2_norm(qkv[..., :DN_WIDTH].reshape(B, S, DN_HEADS, DN_HEAD_DIM))
    k = l2_norm(qkv[..., DN_WIDTH:2 * DN_WIDTH].reshape(B, S, DN_HEADS, DN_HEAD_DIM))
    v = qkv[..., 2 * DN_WIDTH:].reshape(B, S, DN_HEADS, DN_HEAD_DIM)
    z = p[..., COL_Z:COL_A].astype(jnp.float32).reshape(B, S, DN_HEADS, DN_HEAD_DIM)
    a = p[..., COL_A:COL_B].astype(jnp.float32)
    b = p[..., COL_B:D_IN].astype(jnp.float32)
    g = -jnp.exp(a_log.astype(jnp.float32)) * jax.nn.softplus(a + dt_bias.astype(jnp.float32))
    beta = jax.nn.sigmoid(b)
    o = gated_delta_rule(q, k, v, g, beta)
    o = rms_norm(o, o_norm_w) * jax.nn.silu(z)
    y_b = o.reshape(B, S, DN_WIDTH).astype(p.dtype)
    return jnp.concatenate([y_a, y_b], axis=-1)


def peer_routing(h, wq, keys1, keys2):
    T = h.shape[0]
    q = (h @ wq).astype(jnp.float32).reshape(T, PEER_HEADS, 2, PEER_HALF)
    s1 = jnp.einsum('thd,hkd->thk', q[:, :, 0], keys1.astype(jnp.float32))
    s2 = jnp.einsum('thd,hkd->thk', q[:, :, 1], keys2.astype(jnp.float32))
    v1, i1 = lax.top_k(s1, PEER_TOPK)
    v2, i2 = lax.top_k(s2, PEER_TOPK)
    cand = (v1[..., :, None] + v2[..., None, :]).reshape(T, PEER_HEADS, PEER_TOPK * PEER_TOPK)
    cand_id = (i1[..., :, None] * N_KEYS + i2[..., None, :]).reshape(T, PEER_HEADS, PEER_TOPK * PEER_TOPK)
    score, pos = lax.top_k(cand, PEER_TOPK)
    ids = jnp.take_along_axis(cand_id, pos, axis=-1)
    gates = jax.nn.softmax(score, axis=-1)
    return ids, gates


def peer_apply(h, ids, gates, expert_u, expert_v):
    T, D = h.shape
    nb = T // PEER_BLOCK

    def block(args):
        hb, ib, gb = args
        act = jax.nn.gelu(jnp.einsum('pd,phkd->phk', hb, expert_u[ib]))
        return jnp.einsum('phk,phkd->pd', gb.astype(hb.dtype) * act, expert_v[ib])

    out = lax.map(block, (h.reshape(nb, PEER_BLOCK, D),
                          ids.reshape(nb, PEER_BLOCK, PEER_HEADS, PEER_TOPK),
                          gates.reshape(nb, PEER_BLOCK, PEER_HEADS, PEER_TOPK)))
    return out.reshape(T, D)


def setup_inputs(seed: int = 0) -> dict:
    key = jax.random.key(seed)
    ks = jax.random.split(key, 21)
    f32 = jnp.float32
    L, D = DEPTH, D_MODEL
    dt = jnp.exp(jax.random.uniform(ks[11], (L, DN_HEADS), f32, math.log(1e-3), math.log(1e-1)))
    return {
        'x': jax.random.normal(ks[0], (BATCH, SEQ, D), f32),
        'c': jax.random.normal(ks[1], (BATCH, D), f32),
        'w_ada': jax.random.normal(ks[2], (L, D, 6 * D), f32) * (0.5 * D ** -0.5),
        'b_ada': jax.random.normal(ks[3], (L, 6 * D), f32) * 0.01,
        'norm1_w': 1.0 + 0.01 * jax.random.normal(ks[4], (L, D), f32),
        'w_in': jax.random.normal(ks[5], (L, D, D_IN), f32) * D ** -0.5,
        'gm_norm_w': 1.0 + 0.01 * jax.random.normal(ks[6], (L, GM_WIDTH), f32),
        'gm_ws': jax.random.normal(ks[7], (L, GM_HEADS, GM_CHUNK, GM_CHUNK), f32) * GM_CHUNK ** -0.5,
        'gm_bs': 1.0 + 0.01 * jax.random.normal(ks[8], (L, GM_HEADS, GM_CHUNK), f32),
        'conv_w': jax.random.normal(ks[9], (L, CONV_K, 3 * DN_WIDTH), f32) * CONV_K ** -0.5,
        'a_log': jnp.log(jax.random.uniform(ks[10], (L, DN_HEADS), f32, 1.0, 16.0)),
        'dt_bias': dt + jnp.log(-jnp.expm1(-dt)),
        'o_norm_w': 1.0 + 0.01 * jax.random.normal(ks[12], (L, DN_HEAD_DIM), f32),
        'w_out': jax.random.normal(ks[13], (L, D_MIX, D), f32) * D_MIX ** -0.5,
        'norm2_w': 1.0 + 0.01 * jax.random.normal(ks[14], (L, D), f32),
        'peer_wq': jax.random.normal(ks[15], (L, D, PEER_HEADS * PEER_QUERY_DIM), f32) * D ** -0.5,
        'peer_keys1': jax.random.normal(ks[16], (L, PEER_HEADS, N_KEYS, PEER_HALF), f32) * PEER_HALF ** -0.5,
        'peer_keys2': jax.random.normal(ks[17], (L, PEER_HEADS, N_KEYS, PEER_HALF), f32) * PEER_HALF ** -0.5,
        'peer_u': jax.random.normal(ks[18], (L, N_EXPERTS, D), f32) * D ** -0.5,
        'peer_v': jax.random.normal(ks[19], (L, N_EXPERTS, D), f32) * PEER_HEADS ** -0.5,
        'final_norm_w': 1.0 + 0.01 * jax.random.normal(ks[20], (D,), f32),
    }


def reference(x, c, w_ada, b_ada, norm1_w, w_in, gm_norm_w, gm_ws, gm_bs, conv_w, a_log, dt_bias,
              o_norm_w, w_out, norm2_w, peer_wq, peer_keys1, peer_keys2, peer_u, peer_v, final_norm_w):
    B, S, D = x.shape
    for l in range(DEPTH):
        mod = jax.nn.silu(c) @ w_ada[l] + b_ada[l]
        sh1, sc1, gt1, sh2, sc2, gt2 = jnp.split(mod, 6, axis=-1)
        h = modulate(rms_norm(x, norm1_w[l]), sh1, sc1)
        p = h @ w_in[l]
        mix = hybrid_mixer(p, gm_norm_w[l], gm_ws[l], gm_bs[l], conv_w[l], a_log[l], dt_bias[l], o_norm_w[l])
        x = x + gt1[:, None, :] * (mix @ w_out[l])
        h2 = modulate(rms_norm(x, norm2_w[l]), sh2, sc2).reshape(B * S, D)
        ids, gates = peer_routing(h2, peer_wq[l], peer_keys1[l], peer_keys2[l])
        ff = peer_apply(h2, ids, gates, peer_u[l], peer_v[l]).reshape(B, S, D)
        x = x + gt2[:, None, :] * ff
    return rms_norm(x, final_norm_w)
```

```cpp
#include <hip/hip_runtime.h>
#include <stdint.h>

#define SEQ 16384
#define DM 1024
#define DIN 3080

__device__ __forceinline__ unsigned short f2bf(float f) { unsigned u = __float_as_uint(f); u += 0x7fffu + ((u >> 16) & 1u); return (unsigned short)(u >> 16); }
__device__ __forceinline__ float bf2f(unsigned short h) { return __uint_as_float(((unsigned)h) << 16); }
__device__ __forceinline__ float gelu_t(float x) { return 0.5f * x * (1.f + tanhf(0.7978845608028654f * (x + 0.044715f * x * x * x))); }
__device__ __forceinline__ float silu_f(float x) { return x / (1.f + expf(-x)); }
__device__ __forceinline__ float wave_sum(float v) {
#pragma unroll
    for (int o = 32; o > 0; o >>= 1) v += __shfl_xor(v, o);
    return v;
}

__global__ void __launch_bounds__(256) k_mod(const float* __restrict__ c, const float* __restrict__ w_ada, const float* __restrict__ b_ada, float* __restrict__ mod) {
    __shared__ float sc[1024];
    __shared__ float part[4][64];
    const int tid = threadIdx.x;
    for (int i = tid; i < 1024; i += 256) sc[i] = silu_f(c[i]);
    __syncthreads();
    const int col = blockIdx.x * 64 + (tid & 63), kq = tid >> 6;
    float acc = 0.f;
    for (int k = kq * 256; k < kq * 256 + 256; ++k) acc += sc[k] * w_ada[(size_t)k * 6144 + col];
    part[kq][tid & 63] = acc;
    __syncthreads();
    if (tid < 64) mod[col] = part[0][tid] + part[1][tid] + part[2][tid] + part[3][tid] + b_ada[col];
}

__global__ void __launch_bounds__(256) k_rowstat(const float* __restrict__ x, float* __restrict__ r) {
    const int row = blockIdx.x * 4 + (threadIdx.x >> 6), lane = threadIdx.x & 63;
    const float4* xr = (const float4*)(x + (size_t)row * 1024);
    float s = 0.f;
    for (int j = 0; j < 4; ++j) { float4 v = xr[lane + 64 * j]; s += v.x * v.x + v.y * v.y + v.z * v.z + v.w * v.w; }
    s = wave_sum(s);
    if (lane == 0) r[row] = rsqrtf(s * (1.f / 1024.f) + 1e-6f);
}

template <int MODE>
__global__ void __launch_bounds__(256) k_gemm(const float* __restrict__ A, const float* __restrict__ r, const float* __restrict__ nw, const float* __restrict__ sc,
                                              const float* __restrict__ sh, const float* __restrict__ B, int N, int K, unsigned short* __restrict__ outb,
                                              float* __restrict__ outf, const float* __restrict__ res, const float* __restrict__ gate) {
    __shared__ float As[16][68];
    __shared__ float Bs[16][64];
    const int tid = threadIdx.x, tx = tid & 15, ty = tid >> 4;
    const int m0 = blockIdx.y * 64, n0 = blockIdx.x * 64;
    float acc[4][4];
#pragma unroll
    for (int i = 0; i < 4; ++i)
#pragma unroll
        for (int j = 0; j < 4; ++j) acc[i][j] = 0.f;
    const int arow = tid >> 2, ak = (tid & 3) * 4;
    const int bk = tid >> 4, bn = (tid & 15) * 4;
    const float rr = r ? r[m0 + arow] : 1.f;
    for (int k0 = 0; k0 < K; k0 += 16) {
        float4 av = *(const float4*)(A + (size_t)(m0 + arow) * K + k0 + ak);
        if (r) {
            const int kk = k0 + ak;
            av.x = av.x * rr * (nw[kk] * (1.f + sc[kk])) + sh[kk];
            av.y = av.y * rr * (nw[kk + 1] * (1.f + sc[kk + 1])) + sh[kk + 1];
            av.z = av.z * rr * (nw[kk + 2] * (1.f + sc[kk + 2])) + sh[kk + 2];
            av.w = av.w * rr * (nw[kk + 3] * (1.f + sc[kk + 3])) + sh[kk + 3];
        }
        float4 bv = make_float4(0.f, 0.f, 0.f, 0.f);
        if (n0 + bn < N) bv = *(const float4*)(B + (size_t)(k0 + bk) * N + n0 + bn);
        __syncthreads();
        As[ak][arow] = av.x; As[ak + 1][arow] = av.y; As[ak + 2][arow] = av.z; As[ak + 3][arow] = av.w;
        *(float4*)&Bs[bk][bn] = bv;
        __syncthreads();
#pragma unroll
        for (int kk = 0; kk < 16; ++kk) {
            float a[4], b[4];
#pragma unroll
            for (int i = 0; i < 4; ++i) a[i] = As[kk][ty * 4 + i];
#pragma unroll
            for (int j = 0; j < 4; ++j) b[j] = Bs[kk][tx * 4 + j];
#pragma unroll
            for (int i = 0; i < 4; ++i)
#pragma unroll
                for (int j = 0; j < 4; ++j) acc[i][j] += a[i] * b[j];
        }
    }
#pragma unroll
    for (int i = 0; i < 4; ++i) {
        const int t = m0 + ty * 4 + i;
#pragma unroll
        for (int j = 0; j < 4; ++j) {
            const int n = n0 + tx * 4 + j;
            if (n < N) {
                if (MODE == 0) outb[(size_t)t * N + n] = f2bf(acc[i][j]);
                else if (MODE == 1) outf[(size_t)t * N + n] = res[(size_t)t * N + n] + gate[n] * acc[i][j];
                else outf[(size_t)t * N + n] = acc[i][j];
            }
        }
    }
}

__global__ void __launch_bounds__(256) k_gmlp(const unsigned short* __restrict__ p, const float* __restrict__ gm_norm_w, const float* __restrict__ gm_ws,
                                              const float* __restrict__ gm_bs, float* __restrict__ mix) {
    const int n = blockIdx.x >> 3, h = blockIdx.x & 7, tid = threadIdx.x, t0 = n * 128;
    __shared__ float rn[128];
    __shared__ float V[128][65];
    const int w = tid >> 6, lane = tid & 63;
    for (int s = w; s < 128; s += 4) {
        const unsigned short* pr = p + (size_t)(t0 + s) * DIN + 512;
        float ss = 0.f;
        for (int j = lane; j < 512; j += 64) { float g = gelu_t(bf2f(pr[j])); ss += g * g; }
        ss = wave_sum(ss);
        if (lane == 0) rn[s] = rsqrtf(ss * (1.f / 512.f) + 1e-6f);
    }
    __syncthreads();
    for (int i = tid; i < 128 * 64; i += 256) {
        const int s = i >> 6, d = i & 63;
        float g = gelu_t(bf2f(p[(size_t)(t0 + s) * DIN + 512 + h * 64 + d]));
        V[s][d] = g * rn[s] * gm_norm_w[h * 64 + d];
    }
    __syncthreads();
    const int d = tid & 63, tg = tid >> 6;
    for (int i = 0; i < 32; ++i) {
        const int t = tg + 4 * i;
        const float* wr = gm_ws + ((size_t)h * 128 + t) * 128;
        float acc = 0.f;
        for (int s = 0; s <= t; ++s) acc += wr[s] * V[s][d];
        acc += gm_bs[h * 128 + t];
        float u = gelu_t(bf2f(p[(size_t)(t0 + t) * DIN + h * 64 + d]));
        mix[(size_t)(t0 + t) * 1024 + h * 64 + d] = u * acc;
    }
}

__global__ void __launch_bounds__(256) k_dnprep(const unsigned short* __restrict__ p, const float* __restrict__ conv_w, const float* __restrict__ a_log,
                                                const float* __restrict__ dt_bias, float* __restrict__ q, float* __restrict__ k, float* __restrict__ v,
                                                float* __restrict__ g, float* __restrict__ beta) {
    const int t = blockIdx.x, tid = threadIdx.x;
    __shared__ float y[1536];
    __shared__ float nrm[8];
    for (int c = tid; c < 1536; c += 256) {
        float acc = 0.f;
        for (int j = 0; j < 4; ++j) { const int tt = t - 3 + j; if (tt >= 0) acc += conv_w[j * 1536 + c] * bf2f(p[(size_t)tt * DIN + 1024 + c]); }
        y[c] = silu_f(acc);
    }
    __syncthreads();
    const int w = tid >> 6, lane = tid & 63;
    for (int gi = w; gi < 8; gi += 4) {
        float a = y[gi * 128 + lane], b = y[gi * 128 + 64 + lane];
        float ss = wave_sum(a * a + b * b);
        if (lane == 0) nrm[gi] = rsqrtf(ss + 1e-6f);
    }
    __syncthreads();
    for (int c = tid; c < 1536; c += 256) {
        const float val = y[c];
        if (c < 512) q[(size_t)t * 512 + c] = val * nrm[c >> 7] * 0.08838834764831845f;
        else if (c < 1024) k[(size_t)t * 512 + c - 512] = val * nrm[c >> 7];
        else v[(size_t)t * 512 + c - 1024] = val;
    }
    if (tid < 4) {
        const float a = bf2f(p[(size_t)t * DIN + 3072 + tid]), b = bf2f(p[(size_t)t * DIN + 3076 + tid]);
        const float xx = a + dt_bias[tid];
        const float sp = xx > 20.f ? xx : log1pf(expf(xx));
        g[t * 4 + tid] = -expf(a_log[tid]) * sp;
        beta[t * 4 + tid] = 1.f / (1.f + expf(-b));
    }
}

__global__ void __launch_bounds__(64) k_dnrec(const float* __restrict__ q, const float* __restrict__ k, float* v, const float* __restrict__ g,
                                              const float* __restrict__ beta) {
    const int h = blockIdx.x >> 1, cb = (blockIdx.x & 1) * 64, lane = threadIdx.x;
    float S[128];
#pragma unroll
    for (int i = 0; i < 128; ++i) S[i] = 0.f;
    __shared__ float ks[32][128];
    __shared__ float qs[32][128];
    __shared__ float vs[32][64];
    __shared__ float gs[32], bs[32];
    for (int t0 = 0; t0 < SEQ; t0 += 32) {
        __syncthreads();
        for (int i = lane; i < 32 * 128; i += 64) {
            const int tt = i >> 7, d = i & 127;
            ks[tt][d] = k[(size_t)(t0 + tt) * 512 + h * 128 + d];
            qs[tt][d] = q[(size_t)(t0 + tt) * 512 + h * 128 + d];
        }
        for (int tt = 0; tt < 32; ++tt) vs[tt][lane] = v[(size_t)(t0 + tt) * 512 + h * 128 + cb + lane];
        if (lane < 32) { gs[lane] = expf(g[(t0 + lane) * 4 + h]); bs[lane] = beta[(t0 + lane) * 4 + h]; }
        __syncthreads();
        for (int tt = 0; tt < 32; ++tt) {
            const float a = gs[tt], b = bs[tt], vv = vs[tt][lane];
            float kS = 0.f;
#pragma unroll
            for (int i = 0; i < 128; ++i) kS += ks[tt][i] * S[i];
            const float coef = b * (vv - a * kS);
            float o = 0.f;
#pragma unroll
            for (int i = 0; i < 128; ++i) { S[i] = a * S[i] + ks[tt][i] * coef; o += qs[tt][i] * S[i]; }
            v[(size_t)(t0 + tt) * 512 + h * 128 + cb + lane] = o;
        }
    }
}

__global__ void __launch_bounds__(256) k_dnout(const float* __restrict__ o, const unsigned short* __restrict__ p, const float* __restrict__ o_norm_w, float* __restrict__ mix) {
    const int t = blockIdx.x, tid = threadIdx.x, h = tid >> 6, lane = tid & 63;
    const float a = o[(size_t)t * 512 + h * 128 + lane], b = o[(size_t)t * 512 + h * 128 + 64 + lane];
    const float ss = wave_sum(a * a + b * b);
    const float rn = rsqrtf(ss * (1.f / 128.f) + 1e-6f);
    const float z1 = bf2f(p[(size_t)t * DIN + 2560 + h * 128 + lane]), z2 = bf2f(p[(size_t)t * DIN + 2560 + h * 128 + 64 + lane]);
    mix[(size_t)t * 1024 + 512 + h * 128 + lane] = a * rn * o_norm_w[lane] * silu_f(z1);
    mix[(size_t)t * 1024 + 512 + h * 128 + 64 + lane] = b * rn * o_norm_w[64 + lane] * silu_f(z2);
}

__global__ void __launch_bounds__(256) k_route(const float* __restrict__ qq, const float* __restrict__ keys1, const float* __restrict__ keys2, int* __restrict__ ids,
                                               float* __restrict__ gates) {
    __shared__ float kT[64][129];
    __shared__ float qs[16][128];
    __shared__ float sc[2 * 16 * 129];
    __shared__ float tv[2][16][16];
    __shared__ int ti[2][16][16];
    __shared__ float s2[16][17];
    __shared__ int p2[16][17];
    const int tid = threadIdx.x, t0 = blockIdx.x * 16;
    for (int h = 0; h < 8; ++h) {
        for (int half = 0; half < 2; ++half) {
            const float* keys = (half ? keys2 : keys1) + (size_t)h * 128 * 128;
            __syncthreads();
            for (int i = tid; i < 16 * 128; i += 256) { const int tok = i >> 7, d = i & 127; qs[tok][d] = qq[(size_t)(t0 + tok) * 2048 + h * 256 + half * 128 + d]; }
            float acc[8];
#pragma unroll
            for (int i = 0; i < 8; ++i) acc[i] = 0.f;
            const int kk = tid & 127, tg = tid >> 7;
            for (int dh = 0; dh < 2; ++dh) {
                __syncthreads();
                for (int i = tid; i < 128 * 64; i += 256) { const int k = i >> 6, dd = i & 63; kT[dd][k] = keys[(size_t)k * 128 + dh * 64 + dd]; }
                __syncthreads();
                for (int dd = 0; dd < 64; ++dd) {
                    const float kv = kT[dd][kk];
#pragma unroll
                    for (int i = 0; i < 8; ++i) acc[i] += kv * qs[tg * 8 + i][dh * 64 + dd];
                }
            }
#pragma unroll
            for (int i = 0; i < 8; ++i) sc[(half * 16 + tg * 8 + i) * 129 + kk] = acc[i];
        }
        __syncthreads();
        if (tid < 32) {
            const int tok = tid & 15, half = tid >> 4;
            float* s = sc + (half * 16 + tok) * 129;
            for (int r = 0; r < 16; ++r) {
                float best = -INFINITY; int bi = 0;
                for (int k = 0; k < 128; ++k) { const float vv = s[k]; if (vv > best) { best = vv; bi = k; } }
                s[bi] = -INFINITY;
                tv[half][tok][r] = best; ti[half][tok][r] = bi;
            }
        }
        __syncthreads();
        if (tid < 16) {
            const int tok = tid;
            float* cd = sc + tok * 257;
            for (int i = 0; i < 16; ++i)
                for (int j = 0; j < 16; ++j) cd[i * 16 + j] = tv[0][tok][i] + tv[1][tok][j];
            for (int r = 0; r < 16; ++r) {
                float best = -INFINITY; int bi = 0;
                for (int k = 0; k < 256; ++k) { const float vv = cd[k]; if (vv > best) { best = vv; bi = k; } }
                cd[bi] = -INFINITY;
                s2[tok][r] = best; p2[tok][r] = bi;
            }
            float se = 0.f;
            const float mx = s2[tok][0];
            for (int r = 0; r < 16; ++r) { const float e = expf(s2[tok][r] - mx); s2[tok][r] = e; se += e; }
            const float inv = 1.f / se;
            for (int r = 0; r < 16; ++r) {
                const int ps = p2[tok][r];
                ids[(size_t)(t0 + tok) * 128 + h * 16 + r] = ti[0][tok][ps >> 4] * 128 + ti[1][tok][ps & 15];
                gates[(size_t)(t0 + tok) * 128 + h * 16 + r] = s2[tok][r] * inv;
            }
        }
    }
}

__global__ void __launch_bounds__(256) k_peer(const float* __restrict__ x1, const float* __restrict__ r2, const float* __restrict__ norm2_w, const float* __restrict__ mod,
                                              const int* __restrict__ ids, const float* __restrict__ gates, const float* __restrict__ pu, const float* __restrict__ pv,
                                              const float* __restrict__ fw, float* __restrict__ out) {
    const int t = blockIdx.x, tid = threadIdx.x, w = tid >> 6, lane = tid & 63;
    __shared__ float red[4][1024];
    __shared__ float ssum[4];
    const float* sh2 = mod + 3072; const float* sc2 = mod + 4096; const float* gt2 = mod + 5120;
    float hreg[16], acc[16];
    const float r = r2[t];
#pragma unroll
    for (int j = 0; j < 4; ++j) {
        const int idx = j * 256 + lane * 4;
        const float4 xv = *(const float4*)(x1 + (size_t)t * 1024 + idx);
        hreg[j * 4 + 0] = xv.x * r * (norm2_w[idx] * (1.f + sc2[idx])) + sh2[idx];
        hreg[j * 4 + 1] = xv.y * r * (norm2_w[idx + 1] * (1.f + sc2[idx + 1])) + sh2[idx + 1];
        hreg[j * 4 + 2] = xv.z * r * (norm2_w[idx + 2] * (1.f + sc2[idx + 2])) + sh2[idx + 2];
        hreg[j * 4 + 3] = xv.w * r * (norm2_w[idx + 3] * (1.f + sc2[idx + 3])) + sh2[idx + 3];
    }
#pragma unroll
    for (int i = 0; i < 16; ++i) acc[i] = 0.f;
    for (int e = w * 32; e < w * 32 + 32; ++e) {
        const int id = ids[(size_t)t * 128 + e];
        const float gt = gates[(size_t)t * 128 + e];
        const float4* ur = (const float4*)(pu + (size_t)id * 1024);
        float d = 0.f;
#pragma unroll
        for (int j = 0; j < 4; ++j) { const float4 uv = ur[j * 64 + lane]; d += uv.x * hreg[j * 4] + uv.y * hreg[j * 4 + 1] + uv.z * hreg[j * 4 + 2] + uv.w * hreg[j * 4 + 3]; }
        d = wave_sum(d);
        const float cf = gt * gelu_t(d);
        const float4* vr = (const float4*)(pv + (size_t)id * 1024);
#pragma unroll
        for (int j = 0; j < 4; ++j) { const float4 vv = vr[j * 64 + lane]; acc[j * 4] += cf * vv.x; acc[j * 4 + 1] += cf * vv.y; acc[j * 4 + 2] += cf * vv.z; acc[j * 4 + 3] += cf * vv.w; }
    }
#pragma unroll
    for (int j = 0; j < 4; ++j)
#pragma unroll
        for (int c = 0; c < 4; ++c) red[w][j * 256 + lane * 4 + c] = acc[j * 4 + c];
    __syncthreads();
    float x2[4], ss = 0.f;
#pragma unroll
    for (int c = 0; c < 4; ++c) {
        const int idx = tid * 4 + c;
        const float ff = red[0][idx] + red[1][idx] + red[2][idx] + red[3][idx];
        x2[c] = x1[(size_t)t * 1024 + idx] + gt2[idx] * ff;
        ss += x2[c] * x2[c];
    }
    ss = wave_sum(ss);
    if (lane == 0) ssum[w] = ss;
    __syncthreads();
    const float rn = rsqrtf((ssum[0] + ssum[1] + ssum[2] + ssum[3]) * (1.f / 1024.f) + 1e-6f);
#pragma unroll
    for (int c = 0; c < 4; ++c) { const int idx = tid * 4 + c; out[(size_t)t * 1024 + idx] = x2[c] * rn * fw[idx]; }
}

extern "C" void kernel_launch(void* const* d_in, const int* in_sizes, int n_in, void* d_out, int out_size, void* d_ws, size_t ws_size, hipStream_t stream) {
    const float* x = (const float*)d_in[0];
    const float* c = (const float*)d_in[1];
    const float* w_ada = (const float*)d_in[2];
    const float* b_ada = (const float*)d_in[3];
    const float* norm1_w = (const float*)d_in[4];
    const float* w_in = (const float*)d_in[5];
    const float* gm_norm_w = (const float*)d_in[6];
    const float* gm_ws = (const float*)d_in[7];
    const float* gm_bs = (const float*)d_in[8];
    const float* conv_w = (const float*)d_in[9];
    const float* a_log = (const float*)d_in[10];
    const float* dt_bias = (const float*)d_in[11];
    const float* o_norm_w = (const float*)d_in[12];
    const float* w_out = (const float*)d_in[13];
    const float* norm2_w = (const float*)d_in[14];
    const float* peer_wq = (const float*)d_in[15];
    const float* keys1 = (const float*)d_in[16];
    const float* keys2 = (const float*)d_in[17];
    const float* peer_u = (const float*)d_in[18];
    const float* peer_v = (const float*)d_in[19];
    const float* final_w = (const float*)d_in[20];
    float* out = (float*)d_out;
    char* ws = (char*)d_ws;
    const size_t MB = 1u << 20;
    float* mod = (float*)(ws + 4096);
    float* r1 = (float*)(ws + 32768);
    float* gbuf = (float*)(ws + 131072);
    float* bbuf = (float*)(ws + 393216);
    float* r2 = (float*)(ws + 655360);
    unsigned short* p = (unsigned short*)(ws + 1 * MB);
    float* qb = (float*)(ws + 102 * MB);
    float* kb = (float*)(ws + 134 * MB);
    float* vb = (float*)(ws + 166 * MB);
    float* mix = out;
    float* x1 = (float*)(ws + 1 * MB);
    float* qq = (float*)(ws + 65 * MB);
    int* ids = (int*)(ws + 200 * MB);
    float* gates = (float*)(ws + 208 * MB);

    k_mod<<<96, 256, 0, stream>>>(c, w_ada, b_ada, mod);
    k_rowstat<<<SEQ / 4, 256, 0, stream>>>(x, r1);
    k_gemm<0><<<dim3((DIN + 63) / 64, SEQ / 64), 256, 0, stream>>>(x, r1, norm1_w, mod + 1024, mod, w_in, DIN, 1024, p, nullptr, nullptr, nullptr);
    k_gmlp<<<128 * 8, 256, 0, stream>>>(p, gm_norm_w, gm_ws, gm_bs, mix);
    k_dnprep<<<SEQ, 256, 0, stream>>>(p, conv_w, a_log, dt_bias, qb, kb, vb, gbuf, bbuf);
    k_dnrec<<<8, 64, 0, stream>>>(qb, kb, vb, gbuf, bbuf);
    k_dnout<<<SEQ, 256, 0, stream>>>(vb, p, o_norm_w, mix);
    k_gemm<1><<<dim3(1024 / 64, SEQ / 64), 256, 0, stream>>>(mix, nullptr, nullptr, nullptr, nullptr, w_out, 1024, 1024, nullptr, x1, x, mod + 2048);
    k_rowstat<<<SEQ / 4, 256, 0, stream>>>(x1, r2);
    k_gemm<2><<<dim3(2048 / 64, SEQ / 64), 256, 0, stream>>>(x1, r2, norm2_w, mod + 4096, mod + 3072, peer_wq, 2048, 1024, nullptr, qq, nullptr, nullptr);
    k_route<<<SEQ / 16, 256, 0, stream>>>(qq, keys1, keys2, ids, gates);
    k_peer<<<SEQ, 256, 0, stream>>>(x1, r2, norm2_w, mod, ids, gates, peer_u, peer_v, final_w, out);
}
```

```cpp
#include <hip/hip_runtime.h>
#include <cstdio>
#include <cstdint>

namespace pg8 {
#define PG8_LAS __attribute__((address_space(3)))
typedef unsigned short bf16_t;
typedef short bf16x8 __attribute__((ext_vector_type(8)));
typedef float f32x4 __attribute__((ext_vector_type(4)));
typedef unsigned u32x4 __attribute__((ext_vector_type(4)));
constexpr int BM = 256, BK = 64, HALF = 128, HTB = HALF * BK * 2  , STAGE_BYTES = 8 * HTB, NXCD = 8, WGM = 8;

__host__ __device__ __forceinline__ int lds_byte(int r, int c) { const int st = (r >> 4) * 2 + (c >> 5), rr = r & 15, cc = c & 31, ob = rr * 64 + cc * 2; return st * 1024 + (ob ^ (((ob >> 9) & 1) << 5)); }
__host__ __device__ __forceinline__ void stage_rc(int b, int& R, int& C) { const int st = b / 1024, sb = b % 1024, swz = sb ^ (((sb >> 9) & 1) << 5); R = (st >> 1) * 16 + swz / 64; C = (st & 1) * 32 + (swz % 64) / 2; }
__host__ __device__ __forceinline__ int perm32(int rho) { const int n = rho >> 4, i = rho & 15; return 8 * (i >> 2) + 4 * n + (i & 3); }

struct Unit { int pm, pn; };
struct Gemm { const bf16_t* A; const bf16_t* Bt; int M, N, K; };

struct StaticOrder {
    int nM, nN, nwg, G, c;
    __host__ __device__ void init(int M, int N, int G_, int c_) { nM = M / BM; nN = N / BM; nwg = nM * nN; G = G_; c = c_; }
    __host__ __device__ bool next(int i, Unit& u) const {
        const long L = (long)i * G + c; if (L >= nwg) return false;
        int wgid = (int)L; { const int q = nwg / NXCD, r = nwg % NXCD, xcd = wgid % NXCD, off = wgid / NXCD; wgid = (xcd < r ? xcd * (q + 1) : r * (q + 1) + (xcd - r) * q) + off; }
        const int nig = WGM * nN, gid = wgid / nig, fm = gid * WGM, gsz = (nM - fm) < WGM ? (nM - fm) : WGM;
        u.pm = fm + ((wgid % nig) % gsz); u.pn = (wgid % nig) / gsz; return true;
    }
    __device__ __forceinline__ void a_ready(const Unit&) const {}
    __device__ __forceinline__ void done(const Unit&) const {}
};

__device__ __forceinline__ unsigned cvt_pk_bf16(float lo, float hi) { unsigned r; asm volatile("v_cvt_pk_bf16_f32 %0, %1, %2" : "=v"(r) : "v"(lo), "v"(hi)); return r; }


__device__ __forceinline__ float gelu_fast(float x) {
    const float y = x * (1.5957691216f + 0.0713548163f * x * x);
    return x * __builtin_amdgcn_rcpf(1.f + __builtin_amdgcn_exp2f(-1.4426950409f * y));
}
__device__ __forceinline__ float silu_fast(float x) { return x * __builtin_amdgcn_rcpf(1.f + __builtin_amdgcn_exp2f(-1.4426950409f * x)); }

struct Epi1 {
    static constexpr bool PERM = true, AFTER_DRAIN = false;
    bf16_t* Pgm; bf16_t* Pqkv; bf16_t* Pz; const float* r1; const float* bias1;
    __device__ __forceinline__ void operator()(const f32x4 (&acc)[2][2][4][2], const Unit& u, int wr, int wc, int fr, int fq) const {
        const int row0 = u.pm * BM + wr * 64 + fr, colt = u.pn * BM, cl = wc * 32 + 8 * fq;
        f32x4 bv[2][2];
#pragma unroll
        for (int bj = 0; bj < 2; ++bj)
#pragma unroll
            for (int n = 0; n < 2; ++n) bv[bj][n] = *(const f32x4*)(bias1 + colt + cl + bj * HALF + 4 * n);
#pragma unroll
        for (int ai = 0; ai < 2; ++ai)
#pragma unroll
            for (int m = 0; m < 4; ++m) {
                const int row = row0 + ai * HALF + m * 16;
                const float rr = r1[row];
#pragma unroll
                for (int bj = 0; bj < 2; ++bj) {
                    f32x4 v0 = acc[ai][bj][m][0] * rr + bv[bj][0], v1 = acc[ai][bj][m][1] * rr + bv[bj][1];
                    const int col = colt + cl + bj * HALF;
                    bf16_t* dst;
                    if (u.pn < 4) {
#pragma unroll
                        for (int e = 0; e < 4; ++e) { v0[e] = gelu_fast(v0[e]); v1[e] = gelu_fast(v1[e]); }
                        dst = Pgm + (size_t)row * 1024 + col;
                    } else if (u.pn < 10) {
                        dst = Pqkv + (size_t)row * 1536 + (col - 1024);
                    } else {
#pragma unroll
                        for (int e = 0; e < 4; ++e) { v0[e] = silu_fast(v0[e]); v1[e] = silu_fast(v1[e]); }
                        dst = Pz + (size_t)row * 512 + (col - 2560);
                    }
                    u32x4 w; w.x = cvt_pk_bf16(v0[0], v0[1]); w.y = cvt_pk_bf16(v0[2], v0[3]); w.z = cvt_pk_bf16(v1[0], v1[1]); w.w = cvt_pk_bf16(v1[2], v1[3]);
                    *(u32x4*)dst = w;
                }
            }
    }
};

struct Epi2 {
    static constexpr bool PERM = true, AFTER_DRAIN = false;
    const float* x; float* out; bf16_t* x1b; const float* gt1; float* rss; int M;
    __device__ __forceinline__ void operator()(const f32x4 (&acc)[2][2][4][2], const Unit& u, int wr, int wc, int fr, int fq) const {
        const int row0 = u.pm * BM + wr * 64 + fr, colt = u.pn * BM, cl = wc * 32 + 8 * fq;
        f32x4 gv[2][2];
#pragma unroll
        for (int bj = 0; bj < 2; ++bj)
#pragma unroll
            for (int n = 0; n < 2; ++n) gv[bj][n] = *(const f32x4*)(gt1 + colt + cl + bj * HALF + 4 * n);
#pragma unroll
        for (int ai = 0; ai < 2; ++ai)
#pragma unroll
            for (int m = 0; m < 4; ++m) {
                const int row = row0 + ai * HALF + m * 16;
                float ssq = 0.f;
#pragma unroll
                for (int bj = 0; bj < 2; ++bj) {
                    const int col = colt + cl + bj * HALF;
                    const f32x4 x0 = *(const f32x4*)(x + (size_t)row * 1024 + col), x1v = *(const f32x4*)(x + (size_t)row * 1024 + col + 4);
                    const f32x4 v0 = x0 + gv[bj][0] * acc[ai][bj][m][0], v1 = x1v + gv[bj][1] * acc[ai][bj][m][1];
                    *(f32x4*)(out + (size_t)row * 1024 + col) = v0; *(f32x4*)(out + (size_t)row * 1024 + col + 4) = v1;
                    u32x4 w; w.x = cvt_pk_bf16(v0[0], v0[1]); w.y = cvt_pk_bf16(v0[2], v0[3]); w.z = cvt_pk_bf16(v1[0], v1[1]); w.w = cvt_pk_bf16(v1[2], v1[3]);
                    *(u32x4*)(x1b + (size_t)row * 1024 + col) = w;
                    ssq += (v0[0] * v0[0] + v0[1] * v0[1]) + (v0[2] * v0[2] + v0[3] * v0[3]) + (v1[0] * v1[0] + v1[1] * v1[1]) + (v1[2] * v1[2] + v1[3] * v1[3]);
                }
                ssq += __shfl_xor(ssq, 16); ssq += __shfl_xor(ssq, 32);
                if (fq == 0) rss[(size_t)(u.pn * 4 + wc) * M + row] = ssq;
            }
    }
};

struct Epi3 {
    static constexpr bool PERM = true, AFTER_DRAIN = false;
    bf16_t* qq; const float* rss; const float* bias3; int M;
    __device__ __forceinline__ void operator()(const f32x4 (&acc)[2][2][4][2], const Unit& u, int wr, int wc, int fr, int fq) const {
        const int row0 = u.pm * BM + wr * 64 + fr, colt = u.pn * BM, cl = wc * 32 + 8 * fq;
        f32x4 bv[2][2];
#pragma unroll
        for (int bj = 0; bj < 2; ++bj)
#pragma unroll
            for (int n = 0; n < 2; ++n) bv[bj][n] = *(const f32x4*)(bias3 + colt + cl + bj * HALF + 4 * n);
#pragma unroll
        for (int ai = 0; ai < 2; ++ai)
#pragma unroll
            for (int m = 0; m < 4; ++m) {
                const int row = row0 + ai * HALF + m * 16;
                float s = 0.f;
#pragma unroll
                for (int i = 0; i < 4; ++i) s += rss[(size_t)(fq * 4 + i) * M + row];
                s += __shfl_xor(s, 16); s += __shfl_xor(s, 32);
                const float rr = __builtin_amdgcn_rsqf(s * (1.f / 1024.f) + 1e-6f);
#pragma unroll
                for (int bj = 0; bj < 2; ++bj) {
                    const f32x4 v0 = acc[ai][bj][m][0] * rr + bv[bj][0], v1 = acc[ai][bj][m][1] * rr + bv[bj][1];
                    const int col = colt + cl + bj * HALF;
                    u32x4 w; w.x = cvt_pk_bf16(v0[0], v0[1]); w.y = cvt_pk_bf16(v0[2], v0[3]); w.z = cvt_pk_bf16(v1[0], v1[1]); w.w = cvt_pk_bf16(v1[2], v1[3]);
                    *(u32x4*)(qq + (size_t)row * 2048 + col) = w;
                }
            }
    }
};

template <class Epi, class Sched, bool ALIGN_EPI = false, bool SP2 = false>
__device__ __forceinline__ void gemm_phase(PG8_LAS unsigned char* lds, const Gemm g, const Sched& S, const Epi& E) {
    const int tid = threadIdx.x, wid = __builtin_amdgcn_readfirstlane(tid >> 6), lane = tid & 63, wr = wid >> 2, wc = wid & 3, fr = lane & 15, fq = lane >> 4;
    const int K = g.K, nt = K / BK;
    unsigned voffA[2], voffB[2];
#pragma unroll
    for (int i = 0; i < 2; ++i) { int R, C; stage_rc(tid * 16 + i * 8192, R, C); const int Rb = Epi::PERM ? ((R & ~31) + perm32(R & 31)) : R;
        voffA[i] = (unsigned)(R * K + C) * 2u; voffB[i] = (unsigned)(Rb * K + C) * 2u; }
    const size_t kstep = (size_t)(BK * 2);
    const size_t hstep = (size_t)HALF * K * 2;
    const size_t tstep = 2 * hstep;
    const unsigned ldsw = (unsigned)wid * 1024u;
    const int aoff = lds_byte(wr * 64 + fr, fq * 8), boff = lds_byte(wc * 32 + fr, fq * 8);
#define PG8_SA(b, h) (((b) * 2 + (h)) * HTB)
#define PG8_SB(b, h) ((4 + (b) * 2 + (h)) * HTB)
#define PG8_STAGE(bufoff, gbase, voff) do { _Pragma("unroll") for (int _i = 0; _i < 2; ++_i) \
        __builtin_amdgcn_global_load_lds((const unsigned*)((const char*)(gbase) + (voff)[_i]), (PG8_LAS unsigned*)(lds + (bufoff) + ldsw + _i * 8192), 16, 0, 0); } while (0)
#define PG8_LDA(dst, b, h) do { _Pragma("unroll") for (int m = 0; m < 4; ++m) _Pragma("unroll") for (int k = 0; k < 2; ++k) dst[m][k] = *(const PG8_LAS bf16x8*)(lds + PG8_SA(b, h) + aoff + m * 2048 + k * 1024); } while (0)
#define PG8_LDB(dst, b, h) do { _Pragma("unroll") for (int n = 0; n < 2; ++n) _Pragma("unroll") for (int k = 0; k < 2; ++k) dst[n][k] = *(const PG8_LAS bf16x8*)(lds + PG8_SB(b, h) + boff + n * 2048 + k * 1024); } while (0)
#define PG8_MMA(ai, bj, At, Bt) do { __builtin_amdgcn_s_setprio(1); _Pragma("unroll") for (int m = 0; m < 4; ++m) _Pragma("unroll") for (int n = 0; n < 2; ++n) _Pragma("unroll") for (int k = 0; k < 2; ++k) \
        acc[ai][bj][m][n] = __builtin_amdgcn_mfma_f32_16x16x32_bf16(Bt[n][k], At[m][k], acc[ai][bj][m][n], 0, 0, 0); __builtin_amdgcn_s_setprio(0); } while (0)
#define PG8_WAIT_V(n) asm volatile("s_waitcnt vmcnt(" #n ")" ::: "memory")
#define PG8_WAIT_L(n) asm volatile("s_waitcnt lgkmcnt(" #n ")" ::: "memory")
#define PG8_BAR __builtin_amdgcn_s_barrier()
#define PG8_SCHED __builtin_amdgcn_sched_barrier(0)
    Unit cur, nxt; int ui = 0;
    if (!S.next(0, cur)) return;
    f32x4 acc[2][2][4][2];
#pragma unroll
    for (int a = 0; a < 2; ++a)
#pragma unroll
        for (int b = 0; b < 2; ++b)
#pragma unroll
            for (int m = 0; m < 4; ++m)
#pragma unroll
                for (int n = 0; n < 2; ++n) acc[a][b][m][n] = (f32x4){0.f, 0.f, 0.f, 0.f};
    bf16x8 At[4][2], B0[2][2], B1[2][2];
    const char* cA = (const char*)g.A + (size_t)cur.pm * tstep; const char* cB = (const char*)g.Bt + (size_t)cur.pn * tstep;
    S.a_ready(cur);
    if constexpr (SP2) {
        PG8_STAGE(PG8_SB(0, 0), cB, voffB); PG8_STAGE(PG8_SB(0, 1), cB + hstep, voffB); PG8_STAGE(PG8_SA(0, 0), cA, voffA); PG8_STAGE(PG8_SA(0, 1), cA + hstep, voffA);
        if (wr == 1) PG8_BAR;
        PG8_WAIT_V(2); PG8_BAR;
        PG8_STAGE(PG8_SB(1, 0), cB + kstep, voffB); PG8_STAGE(PG8_SA(1, 0), cA + kstep, voffA); PG8_STAGE(PG8_SB(1, 1), cB + hstep + kstep, voffB);
        PG8_WAIT_V(6); PG8_BAR;
    } else {
        PG8_STAGE(PG8_SB(0, 0), cB, voffB); PG8_STAGE(PG8_SA(0, 0), cA, voffA); PG8_STAGE(PG8_SB(0, 1), cB + hstep, voffB); PG8_STAGE(PG8_SA(0, 1), cA + hstep, voffA);
        if (wr == 1) PG8_BAR;
        PG8_WAIT_V(4); PG8_BAR;
        PG8_STAGE(PG8_SB(1, 0), cB + kstep, voffB); PG8_STAGE(PG8_SA(1, 0), cA + kstep, voffA); PG8_STAGE(PG8_SB(1, 1), cB + hstep + kstep, voffB);
        PG8_WAIT_V(6); PG8_BAR;
    }
    for (;;) {
        const bool has_next = S.next(ui + 1, nxt);
        const char* nA = has_next ? (const char*)g.A + (size_t)nxt.pm * tstep : cA; const char* nB = has_next ? (const char*)g.Bt + (size_t)nxt.pn * tstep : cB;
        for (int t = 0; t < nt; t += 2) {
            const bool last = (t == nt - 2);
            const char* a1 = cA + (size_t)(t + 1) * kstep;
            const char* a2 = last ? nA : cA + (size_t)(t + 2) * kstep; const char* b2 = last ? nB : cB + (size_t)(t + 2) * kstep;
            const char* a3 = a2 + kstep; const char* b3 = b2 + kstep;
            if (last && has_next) S.a_ready(nxt);
            if constexpr (SP2) {
            PG8_LDB(B0, 0, 0); PG8_LDB(B1, 0, 1); PG8_SCHED; PG8_LDA(At, 0, 0); PG8_STAGE(PG8_SA(1, 1), a1 + hstep, voffA);
            PG8_WAIT_V(8); PG8_WAIT_L(0); PG8_BAR; PG8_MMA(0, 0, At, B0); PG8_MMA(0, 1, At, B1); PG8_BAR; PG8_SCHED;
            PG8_LDA(At, 0, 1); PG8_STAGE(PG8_SB(0, 0), b2, voffB); PG8_STAGE(PG8_SB(0, 1), b2 + hstep, voffB); PG8_STAGE(PG8_SA(0, 0), a2, voffA);
            PG8_WAIT_V(8); PG8_WAIT_L(0); PG8_BAR; PG8_MMA(1, 0, At, B0); PG8_MMA(1, 1, At, B1); PG8_BAR; PG8_SCHED;
            PG8_LDB(B0, 1, 0); PG8_LDB(B1, 1, 1); PG8_SCHED; PG8_LDA(At, 1, 0); PG8_STAGE(PG8_SA(0, 1), a2 + hstep, voffA);
            PG8_WAIT_V(8); PG8_WAIT_L(0); PG8_BAR; PG8_MMA(0, 0, At, B0); PG8_MMA(0, 1, At, B1); PG8_BAR; PG8_SCHED;
            PG8_LDA(At, 1, 1); PG8_STAGE(PG8_SB(1, 0), b3, voffB); PG8_STAGE(PG8_SB(1, 1), b3 + hstep, voffB); PG8_STAGE(PG8_SA(1, 0), a3, voffA);
            PG8_WAIT_V(8); PG8_WAIT_L(0); PG8_BAR; PG8_MMA(1, 0, At, B0); PG8_MMA(1, 1, At, B1); PG8_BAR; PG8_SCHED;
            } else {
            PG8_LDB(B0, 0, 0); PG8_SCHED; PG8_LDA(At, 0, 0); PG8_STAGE(PG8_SA(1, 1), a1 + hstep, voffA);
            PG8_WAIT_L(8); PG8_BAR; PG8_WAIT_L(0); PG8_MMA(0, 0, At, B0); PG8_BAR; PG8_SCHED;
            PG8_LDB(B1, 0, 1); PG8_STAGE(PG8_SB(0, 0), b2, voffB);
            PG8_BAR; PG8_WAIT_L(0); PG8_MMA(0, 1, At, B1); PG8_BAR;
            PG8_LDA(At, 0, 1); PG8_STAGE(PG8_SA(0, 0), a2, voffA);
            PG8_BAR; PG8_WAIT_L(0); PG8_MMA(1, 0, At, B0); PG8_BAR; PG8_SCHED;
            PG8_STAGE(PG8_SB(0, 1), b2 + hstep, voffB);
            PG8_WAIT_V(6); PG8_BAR; PG8_MMA(1, 1, At, B1); PG8_BAR;
            PG8_LDB(B0, 1, 0); PG8_SCHED; PG8_LDA(At, 1, 0); PG8_STAGE(PG8_SA(0, 1), a2 + hstep, voffA);
            PG8_WAIT_L(8); PG8_BAR; PG8_WAIT_L(0); PG8_MMA(0, 0, At, B0); PG8_BAR; PG8_SCHED;
            PG8_LDB(B1, 1, 1); PG8_STAGE(PG8_SB(1, 0), b3, voffB);
            PG8_BAR; PG8_WAIT_L(0); PG8_MMA(0, 1, At, B1); PG8_BAR;
            PG8_LDA(At, 1, 1); PG8_STAGE(PG8_SA(1, 0), a3, voffA);
            PG8_BAR; PG8_WAIT_L(0); PG8_MMA(1, 0, At, B0); PG8_BAR; PG8_SCHED;
            PG8_STAGE(PG8_SB(1, 1), b3 + hstep, voffB);
            PG8_WAIT_V(6); PG8_BAR; PG8_MMA(1, 1, At, B1); PG8_BAR;
            }
        }
        if constexpr (ALIGN_EPI) { if (wr == 0) PG8_BAR; }
        if constexpr (!Epi::AFTER_DRAIN) { E(acc, cur, wr, wc, fr, fq); S.done(cur); }
        if (!has_next) break;
#pragma unroll
        for (int a = 0; a < 2; ++a)
#pragma unroll
            for (int b = 0; b < 2; ++b)
#pragma unroll
                for (int m = 0; m < 4; ++m)
#pragma unroll
                    for (int n = 0; n < 2; ++n) acc[a][b][m][n] = (f32x4){0.f, 0.f, 0.f, 0.f};
        cur = nxt; cA = nA; cB = nB; ++ui;
        if constexpr (ALIGN_EPI) { if (wr == 1) PG8_BAR; }
    }
    PG8_WAIT_V(0);
    if constexpr (!ALIGN_EPI) { if (wr == 0) PG8_BAR; }
    PG8_BAR;
    if constexpr (Epi::AFTER_DRAIN) { E.fused(acc, cur, wr, wc, fr, fq, lds, wid, lane); S.done(cur); }
#undef PG8_SA
#undef PG8_SB
#undef PG8_STAGE
#undef PG8_LDA
#undef PG8_LDB
#undef PG8_MMA
#undef PG8_WAIT_V
#undef PG8_WAIT_L
#undef PG8_BAR
#undef PG8_SCHED
}
}


#define GAS __attribute__((address_space(1)))
#define LAS __attribute__((address_space(3)))
typedef unsigned short bf16;
typedef unsigned v4u __attribute__((ext_vector_type(4)));
typedef float f32x4 __attribute__((ext_vector_type(4)));
#define LDS_WAIT() asm volatile("s_waitcnt lgkmcnt(0)" ::: "memory")
#define VM_WAIT() asm volatile("s_waitcnt vmcnt(0)" ::: "memory")
__device__ __forceinline__ unsigned f2bf(float f) { unsigned u = __builtin_bit_cast(unsigned, f); return (u + 0x7fffu + ((u >> 16) & 1u)) >> 16; }
__device__ __forceinline__ unsigned pk2(float lo, float hi) { return f2bf(lo) | (f2bf(hi) << 16); }
__device__ __forceinline__ float bf2f(unsigned h) { return __builtin_bit_cast(float, h << 16); }
__device__ __forceinline__ float bflo(unsigned w) { return __builtin_bit_cast(float, w << 16); }
__device__ __forceinline__ float bfhi(unsigned w) { return __builtin_bit_cast(float, w & 0xffff0000u); }
__device__ __forceinline__ float wave_sum(float v) {
#pragma unroll
    for (int o = 32; o > 0; o >>= 1) v += __shfl_xor(v, o);
    return v;
}
__device__ __forceinline__ float gelu_f(float x) { return pg8::gelu_fast(x); }
__device__ __forceinline__ float silu_f(float x) { return x / (1.f + __expf(-x)); }

#define XB_TMO      128
#define XB_XCNT(j)  (256  + 64 * (j))
#define XB_XSUB(j)  (1280 + 64 * (j))
#define XB_XGEN(j)  (2304 + 64 * (j))
#define XB_TOP      3328
#define XB_TOPGEN   3392
#define XCD_BAR_WORDS 3456
#define XB_SPIN_CAP (1u << 24)

__device__ __forceinline__ unsigned xb_ld(unsigned* p)              { return __hip_atomic_load(p, __ATOMIC_RELAXED, __HIP_MEMORY_SCOPE_AGENT); }
__device__ __forceinline__ unsigned xb_add(unsigned* p, unsigned v) { return __hip_atomic_fetch_add(p, v, __ATOMIC_RELAXED, __HIP_MEMORY_SCOPE_AGENT); }
__device__ __forceinline__ unsigned xb_xcc_id() { return (unsigned)__builtin_amdgcn_s_getreg((3 << 11) | 20) & 0xFu; }
#define XB_SPIN(cond, bar) do { unsigned _sp = 0; while (cond) { __builtin_amdgcn_s_sleep(1); \
    if ((++_sp & 255u) == 0u) { if (xb_ld(&(bar)[XB_TMO])) break; if (_sp > XB_SPIN_CAP) { atomicAdd(&(bar)[XB_TMO], 1u); break; } } } } while (0)

struct XcdBarrier {
    unsigned* bar; unsigned x;
    volatile LAS unsigned* st;
};

__device__ __forceinline__ XcdBarrier xcd_barrier_post(unsigned* bar, volatile LAS unsigned* st) {
    XcdBarrier b; b.bar = bar; b.x = xb_xcc_id(); b.st = st;
    if (threadIdx.x == 0) (void)xb_add(&bar[XB_XCNT(b.x)], 1u);
    return b;
}
__device__ __forceinline__ void xcd_barrier_complete(unsigned* bar, unsigned x, unsigned& nloc, unsigned& nx) {
    const unsigned G = gridDim.x * gridDim.y * gridDim.z;
    unsigned sum, cnt, mine, sp = 0u;
    for (;;) {
        sum = 0u; cnt = 0u; mine = 0u;
#pragma unroll
        for (unsigned j = 0; j < 16; ++j) { const unsigned c = xb_ld(&bar[XB_XCNT(j)]); sum += c; cnt += (c > 0u) ? 1u : 0u; mine = (j == x) ? c : mine; }
        if (sum == G) break;
        __builtin_amdgcn_s_sleep(1);
        if ((++sp & 255u) == 0u) { if (xb_ld(&bar[XB_TMO])) break; if (sp > XB_SPIN_CAP) { atomicAdd(&bar[XB_TMO], 1u); break; } }
    }
    nloc = mine > 0u ? mine : 1u; nx = cnt > 0u ? cnt : 1u;
}

__device__ __forceinline__ void xcd_barrier(const XcdBarrier& b) {
    asm volatile("s_waitcnt vmcnt(0)" ::: "memory");
    __syncthreads();
    if (threadIdx.x == 0) {
        unsigned* bar = b.bar;
        __builtin_amdgcn_s_waitcnt(0);
        unsigned nloc = b.st[0], nx = b.st[1];
        if (nloc == 0u) { xcd_barrier_complete(bar, b.x, nloc, nx); b.st[0] = nloc; b.st[1] = nx; }
        const unsigned old = xb_add(&bar[XB_XSUB(b.x)], 1u);
        const unsigned gen = old / nloc;
        if (old + 1u == (gen + 1u) * nloc) {
            __builtin_amdgcn_fence(__ATOMIC_RELEASE, "agent");
            asm volatile("s_waitcnt vmcnt(0)" ::: "memory");
            const unsigned og = xb_add(&bar[XB_TOP], 1u);
            const unsigned tg = og / nx;
            if (og + 1u == (tg + 1u) * nx) xb_add(&bar[XB_TOPGEN], 1u);
            else XB_SPIN(xb_ld(&bar[XB_TOPGEN]) == tg, bar);
            __builtin_amdgcn_fence(__ATOMIC_ACQUIRE, "agent");
            xb_add(&bar[XB_XGEN(b.x)], 1u);
            asm volatile("s_waitcnt vmcnt(0)" ::: "memory");
        } else {
            XB_SPIN(xb_ld(&bar[XB_XGEN(b.x)]) == gen, bar);
            __builtin_amdgcn_fence(__ATOMIC_ACQUIRE, "agent");
            asm volatile("s_waitcnt vmcnt(0)" ::: "memory");
        }
    }
    __syncthreads();
}


constexpr int SEQ = 16384, DM = 1024, DIN = 3080, NWAVES = 8, NT = 512;
constexpr size_t KiB = 1024, MiB = 1u << 20;
constexpr size_t WS_CTL = 0, CTL_ZERO_BYTES = 64 * KiB;
constexpr size_t WS_MOD = 64 * KiB, WS_BIAS1 = 96 * KiB, WS_BIAS3 = 112 * KiB, WS_R1 = 128 * KiB, WS_RSS2 = 192 * KiB  , WS_G = 1280 * KiB, WS_BETA = 1536 * KiB, WS_PAB = 1792 * KiB;
constexpr size_t WS_W1T = 3 * MiB, WS_W2T = 9 * MiB, WS_W3T = 11 * MiB;
constexpr size_t WS_XB = 16 * MiB;
constexpr size_t WS_PGM = 48 * MiB;
constexpr size_t WS_PQKV = 80 * MiB;
constexpr size_t WS_PZ = 128 * MiB;
constexpr size_t WS_Q = 144 * MiB, WS_K = 176 * MiB, WS_V = 208 * MiB;
constexpr size_t WS_IDS = 240 * MiB, WS_GATES = 248 * MiB, WS_END = 256 * MiB;
constexpr int LDS_BYTES = 147456, MISC_OFF = 131072 + 320;

struct Args {
    const float *x, *c, *w_ada, *b_ada, *norm1_w, *w_in, *gm_norm_w, *gm_ws, *gm_bs, *conv_w, *a_log, *dt_bias, *o_norm_w, *w_out, *norm2_w, *peer_wq, *keys1, *keys2, *peer_u, *peer_v, *final_w;
    float* out; unsigned char* ws;
};

__device__ __forceinline__ void gemv_item(const LAS float* vec, const float* W, int ldw, int col0, int ncols, float* out, const float* addb, LAS float* part, int tid) {
    const int c = tid & 63, kg = tid >> 6, col = col0 + c;
    float acc = 0.f;
    if (col < ncols) {
        const float* wp = W + (size_t)(kg * 128) * ldw + col;
#pragma unroll 8
        for (int k = 0; k < 128; ++k) acc += vec[kg * 128 + k] * wp[(size_t)k * ldw];
    }
    part[kg * 64 + c] = acc;
    __syncthreads();
    if (tid < 64 && col < ncols) {
        float s = 0.f;
#pragma unroll
        for (int g = 0; g < 8; ++g) s += part[g * 64 + c];
        out[col] = s + (addb ? addb[col] : 0.f);
    }
    __syncthreads();
}
__device__ __forceinline__ void transpose_item(const float* W, int ldw, int K, int nblk, bf16* WT, LAS float* scr, int item, int lane, const float* nw, const float* sc) {
    const int kb = item / nblk, nb = item % nblk, k0 = 64 * kb, n0 = 32 * nb;
#pragma unroll 8
    for (int i = 0; i < 32; ++i) {
        const int kk = 2 * i + (lane >> 5);
        float s = 1.f;
        if (nw) s = nw[k0 + kk] * (1.f + sc[k0 + kk]);
        scr[kk * 33 + (lane & 31)] = W[(size_t)(k0 + kk) * ldw + n0 + (lane & 31)] * s;
    }
    LDS_WAIT(); asm volatile("" ::: "memory");
    const int c = lane & 7;
#pragma unroll
    for (int j = 0; j < 4; ++j) {
        const int n = (lane >> 3) + 8 * j; const LAS float* s = scr + (8 * c) * 33 + n;
        v4u o; o.x = pk2(s[0 * 33], s[1 * 33]); o.y = pk2(s[2 * 33], s[3 * 33]); o.z = pk2(s[4 * 33], s[5 * 33]); o.w = pk2(s[6 * 33], s[7 * 33]);
        *(v4u*)(WT + (size_t)(n0 + n) * K + k0 + 8 * c) = o;
    }
    LDS_WAIT(); asm volatile("" ::: "memory");
}

__global__ void __launch_bounds__(NT, 2) fwd_kernel(Args A) {
    extern __shared__ __attribute__((aligned(16))) unsigned char lds_raw[];
    LAS unsigned char* lds = (LAS unsigned char*)lds_raw;
    LAS float* ldsf = (LAS float*)lds;
    const int tid = threadIdx.x, lane = tid & 63, wave = __builtin_amdgcn_readfirstlane(tid >> 6);
    const int G = gridDim.x, bx = blockIdx.x;
    const int gw = bx * NWAVES + wave, NGW = G * NWAVES;
    unsigned char* ws = A.ws;
    float* mod = (float*)(ws + WS_MOD); float* bias1 = (float*)(ws + WS_BIAS1); float* bias3 = (float*)(ws + WS_BIAS3);
    float* r1 = (float*)(ws + WS_R1); float* rss2 = (float*)(ws + WS_RSS2); float* gbuf = (float*)(ws + WS_G); float* bbuf = (float*)(ws + WS_BETA); float* pab = (float*)(ws + WS_PAB);
    bf16* W1T = (bf16*)(ws + WS_W1T); bf16* W2T = (bf16*)(ws + WS_W2T); bf16* W3T = (bf16*)(ws + WS_W3T);
    bf16* xb = (bf16*)(ws + WS_XB); bf16* mixb = (bf16*)(ws + WS_XB);
    bf16* Pgm = (bf16*)(ws + WS_PGM); bf16* x1b = (bf16*)(ws + WS_PGM);
    bf16* Pqkv = (bf16*)(ws + WS_PQKV); bf16* qq = (bf16*)(ws + WS_PQKV);
    bf16* Pz = (bf16*)(ws + WS_PZ);
    float* qf = (float*)(ws + WS_Q); float* kf = (float*)(ws + WS_K); float* vf = (float*)(ws + WS_V);
    int* ids = (int*)(ws + WS_IDS); float* gates = (float*)(ws + WS_GATES);

    if (tid < 128) ((LAS unsigned*)(lds + 131072))[tid] = 0u;
    __syncthreads();
    XcdBarrier bar = xcd_barrier_post((unsigned*)(ws + WS_CTL) + 1024, (volatile LAS unsigned*)(lds + MISC_OFF));

    {
        if (bx < 96) {
            for (int i = tid; i < 1024; i += NT) ldsf[i] = silu_f(A.c[i]);
            __syncthreads();
            for (int it = bx; it < 96; it += G) gemv_item(ldsf, A.w_ada, 6144, it * 64, 6144, mod, A.b_ada, ldsf + 1024, tid);
        } else {
            LAS float* scr = ldsf + 4096 + wave * 2176;
            const int w0 = (bx - 96) * NWAVES + wave, nwv = (G - 96) * NWAVES;
            if (nwv > 0) for (int it = w0; it < 512; it += nwv) transpose_item(A.w_out, 1024, 1024, 32, W2T, scr, it, lane, nullptr, nullptr);
        }
        if (G <= 96) { LAS float* scr = ldsf + 4096 + wave * 2176; for (int it = gw; it < 512; it += NGW) transpose_item(A.w_out, 1024, 1024, 32, W2T, scr, it, lane, nullptr, nullptr); }
    }
    xcd_barrier(bar);

    {
        const float* sh1 = mod; const float* sc1 = mod + 1024; const float* sh2 = mod + 3072; const float* sc2 = mod + 4096;
        LAS float* vec1 = ldsf;
        LAS float* vec2 = ldsf + 1024;
        LAS float* part = ldsf + 2048;
        LAS float* wab = ldsf + 4096;
        LAS float* bab = ldsf + 12288;
        LAS float* scr = ldsf + 12544 + wave * 2176;
        for (int i = tid; i < 1024; i += NT) { vec1[i] = sh1[i]; vec2[i] = sh2[i]; }
        for (int i = tid; i < 8192; i += NT) { const int k = i >> 3, j = i & 7; wab[j * 1024 + k] = A.norm1_w[k] * (1.f + sc1[k]) * A.w_in[(size_t)k * DIN + 3072 + j]; }
        __syncthreads();
        {
            float s = 0.f;
            for (int k = lane; k < 1024; k += 64) s += vec1[k] * A.w_in[(size_t)k * DIN + 3072 + wave];
            s = wave_sum(s);
            if (lane == 0) bab[wave] = s;
        }
        __syncthreads();
        for (int it = bx; it < 80; it += G) {
            if (it < 48) gemv_item(vec1, A.w_in, DIN, it * 64, 3072, bias1, nullptr, part, tid);
            else gemv_item(vec2, A.peer_wq, 2048, (it - 48) * 64, 2048, bias3, nullptr, part, tid);
        }
        for (int it = gw; it < 1536 + 1024; it += NGW) {
            if (it < 1536) transpose_item(A.w_in, DIN, 1024, 96, W1T, scr, it, lane, A.norm1_w, sc1);
            else transpose_item(A.peer_wq, 2048, 1024, 64, W3T, scr, it - 1536, lane, A.norm2_w, sc2);
        }
        for (int row = gw; row < SEQ; row += NGW) {
            const f32x4* xr = (const f32x4*)(A.x + (size_t)row * 1024) + lane;
            f32x4 v[4]; float ss = 0.f;
#pragma unroll
            for (int j = 0; j < 4; ++j) { v[j] = xr[64 * j]; ss += (v[j].x * v[j].x + v[j].y * v[j].y) + (v[j].z * v[j].z + v[j].w * v[j].w); }
            const float rr = __builtin_amdgcn_rsqf(wave_sum(ss) * (1.f / 1024.f) + 1e-6f);
            unsigned long long* o8 = (unsigned long long*)(xb + (size_t)row * 1024) + lane;
#pragma unroll
            for (int j = 0; j < 4; ++j) o8[64 * j] = (unsigned long long)pk2(v[j].x, v[j].y) | ((unsigned long long)pk2(v[j].z, v[j].w) << 32);
            float d[8];
#pragma unroll
            for (int jc = 0; jc < 8; ++jc) {
                float s = 0.f;
#pragma unroll
                for (int j = 0; j < 4; ++j) { const LAS float* wp = wab + jc * 1024 + j * 256 + lane * 4; s += (v[j].x * wp[0] + v[j].y * wp[1]) + (v[j].z * wp[2] + v[j].w * wp[3]); }
                d[jc] = wave_sum(s);
            }
            if (lane == 0) {
                r1[row] = rr;
#pragma unroll
                for (int jc = 0; jc < 8; ++jc) pab[(size_t)row * 8 + jc] = d[jc] * rr + bab[jc];
            }
        }
    }
    xcd_barrier(bar);

    {
        pg8::Gemm g{xb, W1T, SEQ, 3072, 1024}; pg8::StaticOrder S; S.init(SEQ, 3072, G, bx);
        pg8::Epi1 E{Pgm, Pqkv, Pz, r1, bias1};
        pg8::gemm_phase<pg8::Epi1, pg8::StaticOrder, true, true>(lds, g, S, E);
    }
    xcd_barrier(bar);

    {
        LAS float* rn = ldsf;
        LAS float* V = ldsf + 128;
        for (int it = bx; it < 1024; it += G) {
            const int n = it >> 3, h = it & 7, t0 = n * 128;
            for (int s = wave; s < 128; s += NWAVES) {
                const bf16* pr = Pgm + (size_t)(t0 + s) * 1024 + 512;
                float ss = 0.f;
                for (int j = lane; j < 512; j += 64) { const float gq = bf2f(pr[j]); ss += gq * gq; }
                ss = wave_sum(ss);
                if (lane == 0) rn[s] = __builtin_amdgcn_rsqf(ss * (1.f / 512.f) + 1e-6f);
            }
            __syncthreads();
            for (int i = tid; i < 128 * 64; i += NT) { const int s = i >> 6, d = i & 63; V[s * 65 + d] = bf2f(Pgm[(size_t)(t0 + s) * 1024 + 512 + h * 64 + d]) * rn[s] * A.gm_norm_w[h * 64 + d]; }
            __syncthreads();
            const int d = tid & 63, tg = tid >> 6;
            for (int i = 0; i < 16; ++i) {
                const int t = tg + 8 * i;
                const float* wr = A.gm_ws + ((size_t)h * 128 + t) * 128;
                float acc = 0.f;
                for (int s = 0; s <= t; ++s) acc += wr[s] * V[s * 65 + d];
                acc += A.gm_bs[h * 128 + t];
                const float u = bf2f(Pgm[(size_t)(t0 + t) * 1024 + h * 64 + d]);
                mixb[(size_t)(t0 + t) * 1024 + h * 64 + d] = (bf16)f2bf(u * acc);
            }
            __syncthreads();
        }
        LAS float* y = ldsf;
        LAS float* nrm = ldsf + 1536;
        for (int t = bx; t < SEQ; t += G) {
            for (int c = tid; c < 1536; c += NT) {
                float acc = 0.f;
#pragma unroll
                for (int j = 0; j < 4; ++j) { const int tt = t - 3 + j; if (tt >= 0) acc += A.conv_w[j * 1536 + c] * bf2f(Pqkv[(size_t)tt * 1536 + c]); }
                y[c] = silu_f(acc);
            }
            __syncthreads();
            {
                const float a = y[wave * 128 + lane], b = y[wave * 128 + 64 + lane];
                const float ss = wave_sum(a * a + b * b);
                if (lane == 0) nrm[wave] = __builtin_amdgcn_rsqf(ss + 1e-6f);
            }
            __syncthreads();
            for (int c = tid; c < 1536; c += NT) {
                const float val = y[c];
                if (c < 512) qf[(size_t)t * 512 + c] = val * nrm[c >> 7] * 0.08838834764831845f;
                else if (c < 1024) kf[(size_t)t * 512 + c - 512] = val * nrm[c >> 7];
                else vf[(size_t)t * 512 + c - 1024] = val;
            }
            if (tid < 4) {
                const float a = pab[(size_t)t * 8 + tid], b = pab[(size_t)t * 8 + 4 + tid];
                const float xx = a + A.dt_bias[tid];
                const float sp = xx > 20.f ? xx : log1pf(__expf(xx));
                gbuf[t * 4 + tid] = -__expf(A.a_log[tid]) * sp;
                bbuf[t * 4 + tid] = 1.f / (1.f + __expf(-b));
            }
            __syncthreads();
        }
    }
    xcd_barrier(bar);

    if (bx < 4) {
        const int h = bx;
        LAS float* ks = ldsf;
        LAS float* qs = ldsf + 4096;
        LAS float* vs = ldsf + 8192;
        LAS float* gs = ldsf + 12288;
        LAS float* bs = ldsf + 12320;
        float S[128];
#pragma unroll
        for (int i = 0; i < 128; ++i) S[i] = 0.f;
        for (int t0 = 0; t0 < SEQ; t0 += 32) {
            __syncthreads();
            for (int i = tid; i < 32 * 128; i += NT) {
                const int tt = i >> 7, d = i & 127;
                ks[i] = kf[(size_t)(t0 + tt) * 512 + h * 128 + d];
                qs[i] = qf[(size_t)(t0 + tt) * 512 + h * 128 + d];
                vs[i] = vf[(size_t)(t0 + tt) * 512 + h * 128 + d];
            }
            if (tid < 32) { gs[tid] = __expf(gbuf[(t0 + tid) * 4 + h]); bs[tid] = bbuf[(t0 + tid) * 4 + h]; }
            __syncthreads();
            if (wave < 2) {
                const int col = wave * 64 + lane;
                for (int tt = 0; tt < 32; ++tt) {
                    const float a = gs[tt], b = bs[tt], vv = vs[tt * 128 + col];
                    float kS = 0.f;
#pragma unroll
                    for (int i = 0; i < 128; ++i) kS += ks[tt * 128 + i] * S[i];
                    const float coef = b * (vv - a * kS);
                    float o = 0.f;
#pragma unroll
                    for (int i = 0; i < 128; ++i) { S[i] = a * S[i] + ks[tt * 128 + i] * coef; o += qs[tt * 128 + i] * S[i]; }
                    vf[(size_t)(t0 + tt) * 512 + h * 128 + col] = o;
                }
            }
        }
    }
    xcd_barrier(bar);

    for (int it = gw; it < SEQ * 4; it += NGW) {
        const int t = it >> 2, h = it & 3;
        const float a = vf[(size_t)t * 512 + h * 128 + lane], b = vf[(size_t)t * 512 + h * 128 + 64 + lane];
        const float rn = __builtin_amdgcn_rsqf(wave_sum(a * a + b * b) * (1.f / 128.f) + 1e-6f);
        const float z1 = bf2f(Pz[(size_t)t * 512 + h * 128 + lane]), z2 = bf2f(Pz[(size_t)t * 512 + h * 128 + 64 + lane]);
        mixb[(size_t)t * 1024 + 512 + h * 128 + lane] = (bf16)f2bf(a * rn * A.o_norm_w[lane] * z1);
        mixb[(size_t)t * 1024 + 512 + h * 128 + 64 + lane] = (bf16)f2bf(b * rn * A.o_norm_w[64 + lane] * z2);
    }
    xcd_barrier(bar);

    {
        pg8::Gemm g{mixb, W2T, SEQ, 1024, 1024}; pg8::StaticOrder S; S.init(SEQ, 1024, G, bx);
        pg8::Epi2 E{A.x, A.out, x1b, mod + 2048, rss2, SEQ};
        pg8::gemm_phase<pg8::Epi2, pg8::StaticOrder, true, true>(lds, g, S, E);
    }
    xcd_barrier(bar);

    {
        pg8::Gemm g{x1b, W3T, SEQ, 2048, 1024}; pg8::StaticOrder S; S.init(SEQ, 2048, G, bx);
        pg8::Epi3 E{qq, rss2, bias3, SEQ};
        pg8::gemm_phase<pg8::Epi3, pg8::StaticOrder, true, true>(lds, g, S, E);
    }
    xcd_barrier(bar);

    {
        LAS float* kT = ldsf;
        LAS float* qs = ldsf + 8256;
        LAS float* sc = ldsf + 8256 + 2048;
        LAS float* tv = sc + 4128;
        LAS int* ti = (LAS int*)(tv + 512);
        LAS float* s2 = (LAS float*)(ti + 512);
        LAS int* p2 = (LAS int*)(s2 + 272);
        for (int it = bx; it < SEQ / 16; it += G) {
            const int t0 = it * 16;
            for (int h = 0; h < 8; ++h) {
                for (int half = 0; half < 2; ++half) {
                    const float* keys = (half ? A.keys2 : A.keys1) + (size_t)h * 128 * 128;
                    __syncthreads();
                    for (int i = tid; i < 16 * 128; i += NT) { const int tok = i >> 7, d = i & 127; qs[i] = bf2f(qq[(size_t)(t0 + tok) * 2048 + h * 256 + half * 128 + d]); }
                    float acc[4];
#pragma unroll
                    for (int i = 0; i < 4; ++i) acc[i] = 0.f;
                    const int kk = tid & 127, tg = tid >> 7;
                    for (int dh = 0; dh < 2; ++dh) {
                        __syncthreads();
                        for (int i = tid; i < 128 * 64; i += NT) { const int k = i >> 6, dd = i & 63; kT[dd * 129 + k] = keys[(size_t)k * 128 + dh * 64 + dd]; }
                        __syncthreads();
                        for (int dd = 0; dd < 64; ++dd) {
                            const float kv = kT[dd * 129 + kk];
#pragma unroll
                            for (int i = 0; i < 4; ++i) acc[i] += kv * qs[(tg * 4 + i) * 128 + dh * 64 + dd];
                        }
                    }
#pragma unroll
                    for (int i = 0; i < 4; ++i) sc[(half * 16 + tg * 4 + i) * 129 + kk] = acc[i];
                }
                __syncthreads();
                if (tid < 32) {
                    const int tok = tid & 15, half = tid >> 4;
                    LAS float* s = sc + (half * 16 + tok) * 129;
                    for (int r = 0; r < 16; ++r) {
                        float best = -INFINITY; int bi = 0;
                        for (int k = 0; k < 128; ++k) { const float vv = s[k]; if (vv > best) { best = vv; bi = k; } }
                        s[bi] = -INFINITY;
                        tv[(half * 16 + tok) * 16 + r] = best; ti[(half * 16 + tok) * 16 + r] = bi;
                    }
                }
                __syncthreads();
                if (tid < 16) {
                    const int tok = tid;
                    LAS float* cd = sc + tok * 257;
                    for (int i = 0; i < 16; ++i)
                        for (int j = 0; j < 16; ++j) cd[i * 16 + j] = tv[tok * 16 + i] + tv[(16 + tok) * 16 + j];
                    for (int r = 0; r < 16; ++r) {
                        float best = -INFINITY; int bi = 0;
                        for (int k = 0; k < 256; ++k) { const float vv = cd[k]; if (vv > best) { best = vv; bi = k; } }
                        cd[bi] = -INFINITY;
                        s2[tok * 17 + r] = best; p2[tok * 17 + r] = bi;
                    }
                    float se = 0.f;
                    const float mx = s2[tok * 17];
                    for (int r = 0; r < 16; ++r) { const float e = __expf(s2[tok * 17 + r] - mx); s2[tok * 17 + r] = e; se += e; }
                    const float inv = 1.f / se;
                    for (int r = 0; r < 16; ++r) {
                        const int ps = p2[tok * 17 + r];
                        ids[(size_t)(t0 + tok) * 128 + h * 16 + r] = ti[tok * 16 + (ps >> 4)] * 128 + ti[(16 + tok) * 16 + (ps & 15)];
                        gates[(size_t)(t0 + tok) * 128 + h * 16 + r] = s2[tok * 17 + r] * inv;
                    }
                }
            }
            __syncthreads();
        }
    }
    xcd_barrier(bar);

    {
        const float* sh2 = mod + 3072; const float* sc2 = mod + 4096; const float* gt2 = mod + 5120;
        LAS float* red = ldsf;
        LAS float* ssum = ldsf + 8192;
        const int half = wave >> 2, w = wave & 3, htid = tid & 255;
        for (int tp = bx; tp < SEQ / 2; tp += G) {
            const int t = tp * 2 + half;
            float rs = (lane < 16) ? rss2[(size_t)lane * SEQ + t] : 0.f;
            const float r = __builtin_amdgcn_rsqf(wave_sum(rs) * (1.f / 1024.f) + 1e-6f);
            float hreg[16], acc[16];
#pragma unroll
            for (int j = 0; j < 4; ++j) {
                const int idx = j * 256 + lane * 4;
                const f32x4 xv = *(const f32x4*)(A.out + (size_t)t * 1024 + idx);
#pragma unroll
                for (int c = 0; c < 4; ++c) hreg[j * 4 + c] = xv[c] * r * (A.norm2_w[idx + c] * (1.f + sc2[idx + c])) + sh2[idx + c];
            }
#pragma unroll
            for (int i = 0; i < 16; ++i) acc[i] = 0.f;
            for (int e = w * 32; e < w * 32 + 32; ++e) {
                const int id = ids[(size_t)t * 128 + e];
                const float gt = gates[(size_t)t * 128 + e];
                const f32x4* ur = (const f32x4*)(A.peer_u + (size_t)id * 1024);
                float d = 0.f;
#pragma unroll
                for (int j = 0; j < 4; ++j) { const f32x4 uv = ur[j * 64 + lane]; d += (uv.x * hreg[j * 4] + uv.y * hreg[j * 4 + 1]) + (uv.z * hreg[j * 4 + 2] + uv.w * hreg[j * 4 + 3]); }
                d = wave_sum(d);
                const float cf = gt * gelu_f(d);
                const f32x4* vr = (const f32x4*)(A.peer_v + (size_t)id * 1024);
#pragma unroll
                for (int j = 0; j < 4; ++j) { const f32x4 vv = vr[j * 64 + lane]; acc[j * 4] += cf * vv.x; acc[j * 4 + 1] += cf * vv.y; acc[j * 4 + 2] += cf * vv.z; acc[j * 4 + 3] += cf * vv.w; }
            }
            __syncthreads();
#pragma unroll
            for (int j = 0; j < 4; ++j)
#pragma unroll
                for (int c = 0; c < 4; ++c) red[(half * 4 + w) * 1024 + j * 256 + lane * 4 + c] = acc[j * 4 + c];
            __syncthreads();
            float x2[4], ss = 0.f;
#pragma unroll
            for (int c = 0; c < 4; ++c) {
                const int idx = htid * 4 + c;
                const float ff = (red[(half * 4 + 0) * 1024 + idx] + red[(half * 4 + 1) * 1024 + idx]) + (red[(half * 4 + 2) * 1024 + idx] + red[(half * 4 + 3) * 1024 + idx]);
                x2[c] = A.out[(size_t)t * 1024 + idx] + gt2[idx] * ff;
                ss += x2[c] * x2[c];
            }
            ss = wave_sum(ss);
            if (lane == 0) ssum[half * 4 + w] = ss;
            __syncthreads();
            const float rn = __builtin_amdgcn_rsqf(((ssum[half * 4] + ssum[half * 4 + 1]) + (ssum[half * 4 + 2] + ssum[half * 4 + 3])) * (1.f / 1024.f) + 1e-6f);
#pragma unroll
            for (int c = 0; c < 4; ++c) { const int idx = htid * 4 + c; A.out[(size_t)t * 1024 + idx] = x2[c] * rn * A.final_w[idx]; }
        }
    }
}

extern "C" void kernel_launch(void* const* d_in, const int* in_sizes, int n_in, void* d_out, int out_size, void* d_ws, size_t ws_size, hipStream_t stream) {
    static int grid = 0;
    if (grid == 0) {
        if (n_in != 21 || in_sizes[0] != SEQ * DM || out_size != SEQ * DM || ws_size < WS_END) { fprintf(stderr, "kernel_launch: unexpected shapes (n_in %d, ws %zu); nothing launched\n", n_in, ws_size); grid = -1; return; }
        int dev = 0, cus = 0, per_cu = 0;
        if (hipGetDevice(&dev) != hipSuccess || hipDeviceGetAttribute(&cus, hipDeviceAttributeMultiprocessorCount, dev) != hipSuccess) { grid = -1; return; }
        if (hipFuncSetAttribute((const void*)fwd_kernel, hipFuncAttributeMaxDynamicSharedMemorySize, LDS_BYTES) != hipSuccess) { fprintf(stderr, "kernel_launch: hipFuncSetAttribute failed\n"); grid = -1; return; }
        if (hipOccupancyMaxActiveBlocksPerMultiprocessor(&per_cu, (const void*)fwd_kernel, NT, LDS_BYTES) != hipSuccess || per_cu < 1) { fprintf(stderr, "kernel_launch: occupancy query says %d blocks per CU\n", per_cu); }
        (void)hipGetLastError();
        grid = cus;
    }
    if (grid < 0) return;
    (void)hipMemsetAsync((char*)d_ws + WS_CTL, 0, CTL_ZERO_BYTES, stream);
    Args a{};
    a.x = (const float*)d_in[0]; a.c = (const float*)d_in[1]; a.w_ada = (const float*)d_in[2]; a.b_ada = (const float*)d_in[3]; a.norm1_w = (const float*)d_in[4];
    a.w_in = (const float*)d_in[5]; a.gm_norm_w = (const float*)d_in[6]; a.gm_ws = (const float*)d_in[7]; a.gm_bs = (const float*)d_in[8]; a.conv_w = (const float*)d_in[9];
    a.a_log = (const float*)d_in[10]; a.dt_bias = (const float*)d_in[11]; a.o_norm_w = (const float*)d_in[12]; a.w_out = (const float*)d_in[13]; a.norm2_w = (const float*)d_in[14];
    a.peer_wq = (const float*)d_in[15]; a.keys1 = (const float*)d_in[16]; a.keys2 = (const float*)d_in[17]; a.peer_u = (const float*)d_in[18]; a.peer_v = (const float*)d_in[19];
    a.final_w = (const float*)d_in[20]; a.out = (float*)d_out; a.ws = (unsigned char*)d_ws;
    hipLaunchKernelGGL(fwd_kernel, dim3(grid), dim3(NT), LDS_BYTES, stream, a);
}
```

```cpp
#include <hip/hip_runtime.h>
#include <cstdio>
#include <cstdint>

namespace pg8 {
#define PG8_LAS __attribute__((address_space(3)))
typedef unsigned short bf16_t;
typedef short bf16x8 __attribute__((ext_vector_type(8)));
typedef float f32x4 __attribute__((ext_vector_type(4)));
typedef unsigned u32x4 __attribute__((ext_vector_type(4)));
constexpr int BM = 256, BK = 64, HALF = 128, HTB = HALF * BK * 2  , STAGE_BYTES = 8 * HTB, NXCD = 8, WGM = 8;

__host__ __device__ __forceinline__ int lds_byte(int r, int c) { const int st = (r >> 4) * 2 + (c >> 5), rr = r & 15, cc = c & 31, ob = rr * 64 + cc * 2; return st * 1024 + (ob ^ (((ob >> 9) & 1) << 5)); }
__host__ __device__ __forceinline__ void stage_rc(int b, int& R, int& C) { const int st = b / 1024, sb = b % 1024, swz = sb ^ (((sb >> 9) & 1) << 5); R = (st >> 1) * 16 + swz / 64; C = (st & 1) * 32 + (swz % 64) / 2; }
__host__ __device__ __forceinline__ int perm32(int rho) { const int n = rho >> 4, i = rho & 15; return 8 * (i >> 2) + 4 * n + (i & 3); }

struct Unit { int pm, pn; };
struct Gemm { const bf16_t* A; const bf16_t* Bt; int M, N, K; };

struct StaticOrder {
    int nM, nN, nwg, G, c;
    __host__ __device__ void init(int M, int N, int G_, int c_) { nM = M / BM; nN = N / BM; nwg = nM * nN; G = G_; c = c_; }
    __host__ __device__ bool next(int i, Unit& u) const {
        const long L = (long)i * G + c; if (L >= nwg) return false;
        int wgid = (int)L; { const int q = nwg / NXCD, r = nwg % NXCD, xcd = wgid % NXCD, off = wgid / NXCD; wgid = (xcd < r ? xcd * (q + 1) : r * (q + 1) + (xcd - r) * q) + off; }
        const int nig = WGM * nN, gid = wgid / nig, fm = gid * WGM, gsz = (nM - fm) < WGM ? (nM - fm) : WGM;
        u.pm = fm + ((wgid % nig) % gsz); u.pn = (wgid % nig) / gsz; return true;
    }
    __device__ __forceinline__ void a_ready(const Unit&) const {}
    __device__ __forceinline__ void done(const Unit&) const {}
};

__device__ __forceinline__ unsigned cvt_pk_bf16(float lo, float hi) { unsigned r; asm volatile("v_cvt_pk_bf16_f32 %0, %1, %2" : "=v"(r) : "v"(lo), "v"(hi)); return r; }


__device__ __forceinline__ float gelu_fast(float x) {
    const float y = x * (1.5957691216f + 0.0713548163f * x * x);
    return x * __builtin_amdgcn_rcpf(1.f + __builtin_amdgcn_exp2f(-1.4426950409f * y));
}
__device__ __forceinline__ float silu_fast(float x) { return x * __builtin_amdgcn_rcpf(1.f + __builtin_amdgcn_exp2f(-1.4426950409f * x)); }

struct Epi1 {
    static constexpr bool PERM = true, AFTER_DRAIN = false;
    bf16_t* Pgm; bf16_t* Pqkv; bf16_t* Pz; const float* r1; const float* bias1;
    __device__ __forceinline__ void operator()(const f32x4 (&acc)[2][2][4][2], const Unit& u, int wr, int wc, int fr, int fq) const {
        const int row0 = u.pm * BM + wr * 64 + fr, colt = u.pn * BM, cl = wc * 32 + 8 * fq;
        f32x4 bv[2][2];
#pragma unroll
        for (int bj = 0; bj < 2; ++bj)
#pragma unroll
            for (int n = 0; n < 2; ++n) bv[bj][n] = *(const f32x4*)(bias1 + colt + cl + bj * HALF + 4 * n);
#pragma unroll
        for (int ai = 0; ai < 2; ++ai)
#pragma unroll
            for (int m = 0; m < 4; ++m) {
                const int row = row0 + ai * HALF + m * 16;
                const float rr = r1[row];
#pragma unroll
                for (int bj = 0; bj < 2; ++bj) {
                    f32x4 v0 = acc[ai][bj][m][0] * rr + bv[bj][0], v1 = acc[ai][bj][m][1] * rr + bv[bj][1];
                    const int col = colt + cl + bj * HALF;
                    bf16_t* dst;
                    if (u.pn < 4) {
#pragma unroll
                        for (int e = 0; e < 4; ++e) { v0[e] = gelu_fast(v0[e]); v1[e] = gelu_fast(v1[e]); }
                        dst = Pgm + (size_t)row * 1024 + col;
                    } else if (u.pn < 10) {
                        dst = Pqkv + (size_t)row * 1536 + (col - 1024);
                    } else {
#pragma unroll
                        for (int e = 0; e < 4; ++e) { v0[e] = silu_fast(v0[e]); v1[e] = silu_fast(v1[e]); }
                        dst = Pz + (size_t)row * 512 + (col - 2560);
                    }
                    u32x4 w; w.x = cvt_pk_bf16(v0[0], v0[1]); w.y = cvt_pk_bf16(v0[2], v0[3]); w.z = cvt_pk_bf16(v1[0], v1[1]); w.w = cvt_pk_bf16(v1[2], v1[3]);
                    *(u32x4*)dst = w;
                }
            }
    }
};

struct Epi2 {
    static constexpr bool PERM = true, AFTER_DRAIN = false;
    const float* x; float* out; bf16_t* x1b; const float* gt1; float* rss; int M;
    __device__ __forceinline__ void operator()(const f32x4 (&acc)[2][2][4][2], const Unit& u, int wr, int wc, int fr, int fq) const {
        const int row0 = u.pm * BM + wr * 64 + fr, colt = u.pn * BM, cl = wc * 32 + 8 * fq;
        f32x4 gv[2][2];
#pragma unroll
        for (int bj = 0; bj < 2; ++bj)
#pragma unroll
            for (int n = 0; n < 2; ++n) gv[bj][n] = *(const f32x4*)(gt1 + colt + cl + bj * HALF + 4 * n);
#pragma unroll
        for (int ai = 0; ai < 2; ++ai)
#pragma unroll
            for (int m = 0; m < 4; ++m) {
                const int row = row0 + ai * HALF + m * 16;
                float ssq = 0.f;
#pragma unroll
                for (int bj = 0; bj < 2; ++bj) {
                    const int col = colt + cl + bj * HALF;
                    const f32x4 x0 = *(const f32x4*)(x + (size_t)row * 1024 + col), x1v = *(const f32x4*)(x + (size_t)row * 1024 + col + 4);
                    const f32x4 v0 = x0 + gv[bj][0] * acc[ai][bj][m][0], v1 = x1v + gv[bj][1] * acc[ai][bj][m][1];
                    *(f32x4*)(out + (size_t)row * 1024 + col) = v0; *(f32x4*)(out + (size_t)row * 1024 + col + 4) = v1;
                    u32x4 w; w.x = cvt_pk_bf16(v0[0], v0[1]); w.y = cvt_pk_bf16(v0[2], v0[3]); w.z = cvt_pk_bf16(v1[0], v1[1]); w.w = cvt_pk_bf16(v1[2], v1[3]);
                    *(u32x4*)(x1b + (size_t)row * 1024 + col) = w;
                    ssq += (v0[0] * v0[0] + v0[1] * v0[1]) + (v0[2] * v0[2] + v0[3] * v0[3]) + (v1[0] * v1[0] + v1[1] * v1[1]) + (v1[2] * v1[2] + v1[3] * v1[3]);
                }
                ssq += __shfl_xor(ssq, 16); ssq += __shfl_xor(ssq, 32);
                if (fq == 0) rss[(size_t)(u.pn * 4 + wc) * M + row] = ssq;
            }
    }
};

struct Epi3 {
    static constexpr bool PERM = true, AFTER_DRAIN = false;
    bf16_t* qq; const float* rss; const float* bias3; int M;
    __device__ __forceinline__ void operator()(const f32x4 (&acc)[2][2][4][2], const Unit& u, int wr, int wc, int fr, int fq) const {
        const int row0 = u.pm * BM + wr * 64 + fr, colt = u.pn * BM, cl = wc * 32 + 8 * fq;
        f32x4 bv[2][2];
#pragma unroll
        for (int bj = 0; bj < 2; ++bj)
#pragma unroll
            for (int n = 0; n < 2; ++n) bv[bj][n] = *(const f32x4*)(bias3 + colt + cl + bj * HALF + 4 * n);
#pragma unroll
        for (int ai = 0; ai < 2; ++ai)
#pragma unroll
            for (int m = 0; m < 4; ++m) {
                const int row = row0 + ai * HALF + m * 16;
                float s = 0.f;
#pragma unroll
                for (int i = 0; i < 4; ++i) s += rss[(size_t)(fq * 4 + i) * M + row];
                s += __shfl_xor(s, 16); s += __shfl_xor(s, 32);
                const float rr = __builtin_amdgcn_rsqf(s * (1.f / 1024.f) + 1e-6f);
#pragma unroll
                for (int bj = 0; bj < 2; ++bj) {
                    const f32x4 v0 = acc[ai][bj][m][0] * rr + bv[bj][0], v1 = acc[ai][bj][m][1] * rr + bv[bj][1];
                    const int col = colt + cl + bj * HALF;
                    u32x4 w; w.x = cvt_pk_bf16(v0[0], v0[1]); w.y = cvt_pk_bf16(v0[2], v0[3]); w.z = cvt_pk_bf16(v1[0], v1[1]); w.w = cvt_pk_bf16(v1[2], v1[3]);
                    *(u32x4*)(qq + (size_t)row * 2048 + col) = w;
                }
            }
    }
};

template <class Epi, class Sched, bool ALIGN_EPI = false, bool SP2 = false>
__device__ __forceinline__ void gemm_phase(PG8_LAS unsigned char* lds, const Gemm g, const Sched& S, const Epi& E) {
    const int tid = threadIdx.x, wid = __builtin_amdgcn_readfirstlane(tid >> 6), lane = tid & 63, wr = wid >> 2, wc = wid & 3, fr = lane & 15, fq = lane >> 4;
    const int K = g.K, nt = K / BK;
    unsigned voffA[2], voffB[2];
#pragma unroll
    for (int i = 0; i < 2; ++i) { int R, C; stage_rc(tid * 16 + i * 8192, R, C); const int Rb = Epi::PERM ? ((R & ~31) + perm32(R & 31)) : R;
        voffA[i] = (unsigned)(R * K + C) * 2u; voffB[i] = (unsigned)(Rb * K + C) * 2u; }
    const size_t kstep = (size_t)(BK * 2);
    const size_t hstep = (size_t)HALF * K * 2;
    const size_t tstep = 2 * hstep;
    const unsigned ldsw = (unsigned)wid * 1024u;
    const int aoff = lds_byte(wr * 64 + fr, fq * 8), boff = lds_byte(wc * 32 + fr, fq * 8);
#define PG8_SA(b, h) (((b) * 2 + (h)) * HTB)
#define PG8_SB(b, h) ((4 + (b) * 2 + (h)) * HTB)
#define PG8_STAGE(bufoff, gbase, voff) do { _Pragma("unroll") for (int _i = 0; _i < 2; ++_i) \
        __builtin_amdgcn_global_load_lds((const unsigned*)((const char*)(gbase) + (voff)[_i]), (PG8_LAS unsigned*)(lds + (bufoff) + ldsw + _i * 8192), 16, 0, 0); } while (0)
#define PG8_LDA(dst, b, h) do { _Pragma("unroll") for (int m = 0; m < 4; ++m) _Pragma("unroll") for (int k = 0; k < 2; ++k) dst[m][k] = *(const PG8_LAS bf16x8*)(lds + PG8_SA(b, h) + aoff + m * 2048 + k * 1024); } while (0)
#define PG8_LDB(dst, b, h) do { _Pragma("unroll") for (int n = 0; n < 2; ++n) _Pragma("unroll") for (int k = 0; k < 2; ++k) dst[n][k] = *(const PG8_LAS bf16x8*)(lds + PG8_SB(b, h) + boff + n * 2048 + k * 1024); } while (0)
#define PG8_MMA(ai, bj, At, Bt) do { __builtin_amdgcn_s_setprio(1); _Pragma("unroll") for (int m = 0; m < 4; ++m) _Pragma("unroll") for (int n = 0; n < 2; ++n) _Pragma("unroll") for (int k = 0; k < 2; ++k) \
        acc[ai][bj][m][n] = __builtin_amdgcn_mfma_f32_16x16x32_bf16(Bt[n][k], At[m][k], acc[ai][bj][m][n], 0, 0, 0); __builtin_amdgcn_s_setprio(0); } while (0)
#define PG8_WAIT_V(n) asm volatile("s_waitcnt vmcnt(" #n ")" ::: "memory")
#define PG8_WAIT_L(n) asm volatile("s_waitcnt lgkmcnt(" #n ")" ::: "memory")
#define PG8_BAR __builtin_amdgcn_s_barrier()
#define PG8_SCHED __builtin_amdgcn_sched_barrier(0)
    Unit cur, nxt; int ui = 0;
    if (!S.next(0, cur)) return;
    f32x4 acc[2][2][4][2];
#pragma unroll
    for (int a = 0; a < 2; ++a)
#pragma unroll
        for (int b = 0; b < 2; ++b)
#pragma unroll
            for (int m = 0; m < 4; ++m)
#pragma unroll
                for (int n = 0; n < 2; ++n) acc[a][b][m][n] = (f32x4){0.f, 0.f, 0.f, 0.f};
    bf16x8 At[4][2], B0[2][2], B1[2][2];
    const char* cA = (const char*)g.A + (size_t)cur.pm * tstep; const char* cB = (const char*)g.Bt + (size_t)cur.pn * tstep;
    S.a_ready(cur);
    if constexpr (SP2) {
        PG8_STAGE(PG8_SB(0, 0), cB, voffB); PG8_STAGE(PG8_SB(0, 1), cB + hstep, voffB); PG8_STAGE(PG8_SA(0, 0), cA, voffA); PG8_STAGE(PG8_SA(0, 1), cA + hstep, voffA);
        if (wr == 1) PG8_BAR;
        PG8_WAIT_V(2); PG8_BAR;
        PG8_STAGE(PG8_SB(1, 0), cB + kstep, voffB); PG8_STAGE(PG8_SA(1, 0), cA + kstep, voffA); PG8_STAGE(PG8_SB(1, 1), cB + hstep + kstep, voffB);
        PG8_WAIT_V(6); PG8_BAR;
    } else {
        PG8_STAGE(PG8_SB(0, 0), cB, voffB); PG8_STAGE(PG8_SA(0, 0), cA, voffA); PG8_STAGE(PG8_SB(0, 1), cB + hstep, voffB); PG8_STAGE(PG8_SA(0, 1), cA + hstep, voffA);
        if (wr == 1) PG8_BAR;
        PG8_WAIT_V(4); PG8_BAR;
        PG8_STAGE(PG8_SB(1, 0), cB + kstep, voffB); PG8_STAGE(PG8_SA(1, 0), cA + kstep, voffA); PG8_STAGE(PG8_SB(1, 1), cB + hstep + kstep, voffB);
        PG8_WAIT_V(6); PG8_BAR;
    }
    for (;;) {
        const bool has_next = S.next(ui + 1, nxt);
        const char* nA = has_next ? (const char*)g.A + (size_t)nxt.pm * tstep : cA; const char* nB = has_next ? (const char*)g.Bt + (size_t)nxt.pn * tstep : cB;
        for (int t = 0; t < nt; t += 2) {
            const bool last = (t == nt - 2);
            const char* a1 = cA + (size_t)(t + 1) * kstep;
            const char* a2 = last ? nA : cA + (size_t)(t + 2) * kstep; const char* b2 = last ? nB : cB + (size_t)(t + 2) * kstep;
            const char* a3 = a2 + kstep; const char* b3 = b2 + kstep;
            if (last && has_next) S.a_ready(nxt);
            if constexpr (SP2) {
            PG8_LDB(B0, 0, 0); PG8_LDB(B1, 0, 1); PG8_SCHED; PG8_LDA(At, 0, 0); PG8_STAGE(PG8_SA(1, 1), a1 + hstep, voffA);
            PG8_WAIT_V(8); PG8_WAIT_L(0); PG8_BAR; PG8_MMA(0, 0, At, B0); PG8_MMA(0, 1, At, B1); PG8_BAR; PG8_SCHED;
            PG8_LDA(At, 0, 1); PG8_STAGE(PG8_SB(0, 0), b2, voffB); PG8_STAGE(PG8_SB(0, 1), b2 + hstep, voffB); PG8_STAGE(PG8_SA(0, 0), a2, voffA);
            PG8_WAIT_V(8); PG8_WAIT_L(0); PG8_BAR; PG8_MMA(1, 0, At, B0); PG8_MMA(1, 1, At, B1); PG8_BAR; PG8_SCHED;
            PG8_LDB(B0, 1, 0); PG8_LDB(B1, 1, 1); PG8_SCHED; PG8_LDA(At, 1, 0); PG8_STAGE(PG8_SA(0, 1), a2 + hstep, voffA);
            PG8_WAIT_V(8); PG8_WAIT_L(0); PG8_BAR; PG8_MMA(0, 0, At, B0); PG8_MMA(0, 1, At, B1); PG8_BAR; PG8_SCHED;
            PG8_LDA(At, 1, 1); PG8_STAGE(PG8_SB(1, 0), b3, voffB); PG8_STAGE(PG8_SB(1, 1), b3 + hstep, voffB); PG8_STAGE(PG8_SA(1, 0), a3, voffA);
            PG8_WAIT_V(8); PG8_WAIT_L(0); PG8_BAR; PG8_MMA(1, 0, At, B0); PG8_MMA(1, 1, At, B1); PG8_BAR; PG8_SCHED;
            } else {
            PG8_LDB(B0, 0, 0); PG8_SCHED; PG8_LDA(At, 0, 0); PG8_STAGE(PG8_SA(1, 1), a1 + hstep, voffA);
            PG8_WAIT_L(8); PG8_BAR; PG8_WAIT_L(0); PG8_MMA(0, 0, At, B0); PG8_BAR; PG8_SCHED;
            PG8_LDB(B1, 0, 1); PG8_STAGE(PG8_SB(0, 0), b2, voffB);
            PG8_BAR; PG8_WAIT_L(0); PG8_MMA(0, 1, At, B1); PG8_BAR;
            PG8_LDA(At, 0, 1); PG8_STAGE(PG8_SA(0, 0), a2, voffA);
            PG8_BAR; PG8_WAIT_L(0); PG8_MMA(1, 0, At, B0); PG8_BAR; PG8_SCHED;
            PG8_STAGE(PG8_SB(0, 1), b2 + hstep, voffB);
            PG8_WAIT_V(6); PG8_BAR; PG8_MMA(1, 1, At, B1); PG8_BAR;
            PG8_LDB(B0, 1, 0); PG8_SCHED; PG8_LDA(At, 1, 0); PG8_STAGE(PG8_SA(0, 1), a2 + hstep, voffA);
            PG8_WAIT_L(8); PG8_BAR; PG8_WAIT_L(0); PG8_MMA(0, 0, At, B0); PG8_BAR; PG8_SCHED;
            PG8_LDB(B1, 1, 1); PG8_STAGE(PG8_SB(1, 0), b3, voffB);
            PG8_BAR; PG8_WAIT_L(0); PG8_MMA(0, 1, At, B1); PG8_BAR;
            PG8_LDA(At, 1, 1); PG8_STAGE(PG8_SA(1, 0), a3, voffA);
            PG8_BAR; PG8_WAIT_L(0); PG8_MMA(1, 0, At, B0); PG8_BAR; PG8_SCHED;
            PG8_STAGE(PG8_SB(1, 1), b3 + hstep, voffB);
            PG8_WAIT_V(6); PG8_BAR; PG8_MMA(1, 1, At, B1); PG8_BAR;
            }
        }
        if constexpr (ALIGN_EPI) { if (wr == 0) PG8_BAR; }
        if constexpr (!Epi::AFTER_DRAIN) { E(acc, cur, wr, wc, fr, fq); S.done(cur); }
        if (!has_next) break;
#pragma unroll
        for (int a = 0; a < 2; ++a)
#pragma unroll
            for (int b = 0; b < 2; ++b)
#pragma unroll
                for (int m = 0; m < 4; ++m)
#pragma unroll
                    for (int n = 0; n < 2; ++n) acc[a][b][m][n] = (f32x4){0.f, 0.f, 0.f, 0.f};
        cur = nxt; cA = nA; cB = nB; ++ui;
        if constexpr (ALIGN_EPI) { if (wr == 1) PG8_BAR; }
    }
    PG8_WAIT_V(0);
    if constexpr (!ALIGN_EPI) { if (wr == 0) PG8_BAR; }
    PG8_BAR;
    if constexpr (Epi::AFTER_DRAIN) { E.fused(acc, cur, wr, wc, fr, fq, lds, wid, lane); S.done(cur); }
#undef PG8_SA
#undef PG8_SB
#undef PG8_STAGE
#undef PG8_LDA
#undef PG8_LDB
#undef PG8_MMA
#undef PG8_WAIT_V
#undef PG8_WAIT_L
#undef PG8_BAR
#undef PG8_SCHED
}
}


#define GAS __attribute__((address_space(1)))
#define LAS __attribute__((address_space(3)))
typedef unsigned short bf16;
typedef unsigned v4u __attribute__((ext_vector_type(4)));
typedef float f32x4 __attribute__((ext_vector_type(4)));
#define LDS_WAIT() asm volatile("s_waitcnt lgkmcnt(0)" ::: "memory")
#define VM_WAIT() asm volatile("s_waitcnt vmcnt(0)" ::: "memory")
__device__ __forceinline__ unsigned f2bf(float f) { unsigned u = __builtin_bit_cast(unsigned, f); return (u + 0x7fffu + ((u >> 16) & 1u)) >> 16; }
__device__ __forceinline__ unsigned pk2(float lo, float hi) { return f2bf(lo) | (f2bf(hi) << 16); }
__device__ __forceinline__ float bf2f(unsigned h) { return __builtin_bit_cast(float, h << 16); }
__device__ __forceinline__ float bflo(unsigned w) { return __builtin_bit_cast(float, w << 16); }
__device__ __forceinline__ float bfhi(unsigned w) { return __builtin_bit_cast(float, w & 0xffff0000u); }
__device__ __forceinline__ float wave_sum(float v) {
#pragma unroll
    for (int o = 32; o > 0; o >>= 1) v += __shfl_xor(v, o);
    return v;
}
__device__ __forceinline__ float gelu_f(float x) { return pg8::gelu_fast(x); }
__device__ __forceinline__ float silu_f(float x) { return x / (1.f + __expf(-x)); }

#define XB_TMO      128
#define XB_XCNT(j)  (256  + 64 * (j))
#define XB_XSUB(j)  (1280 + 64 * (j))
#define XB_XGEN(j)  (2304 + 64 * (j))
#define XB_TOP      3328
#define XB_TOPGEN   3392
#define XCD_BAR_WORDS 3456
#define XB_SPIN_CAP (1u << 24)

__device__ __forceinline__ unsigned xb_ld(unsigned* p)              { return __hip_atomic_load(p, __ATOMIC_RELAXED, __HIP_MEMORY_SCOPE_AGENT); }
__device__ __forceinline__ unsigned xb_add(unsigned* p, unsigned v) { return __hip_atomic_fetch_add(p, v, __ATOMIC_RELAXED, __HIP_MEMORY_SCOPE_AGENT); }
__device__ __forceinline__ unsigned xb_xcc_id() { return (unsigned)__builtin_amdgcn_s_getreg((3 << 11) | 20) & 0xFu; }
#define XB_SPIN(cond, bar) do { unsigned _sp = 0; while (cond) { __builtin_amdgcn_s_sleep(1); \
    if ((++_sp & 255u) == 0u) { if (xb_ld(&(bar)[XB_TMO])) break; if (_sp > XB_SPIN_CAP) { atomicAdd(&(bar)[XB_TMO], 1u); break; } } } } while (0)

struct XcdBarrier {
    unsigned* bar; unsigned x;
    volatile LAS unsigned* st;
};

__device__ __forceinline__ XcdBarrier xcd_barrier_post(unsigned* bar, volatile LAS unsigned* st) {
    XcdBarrier b; b.bar = bar; b.x = xb_xcc_id(); b.st = st;
    if (threadIdx.x == 0) (void)xb_add(&bar[XB_XCNT(b.x)], 1u);
    return b;
}
__device__ __forceinline__ void xcd_barrier_complete(unsigned* bar, unsigned x, unsigned& nloc, unsigned& nx) {
    const unsigned G = gridDim.x * gridDim.y * gridDim.z;
    unsigned sum, cnt, mine, sp = 0u;
    for (;;) {
        sum = 0u; cnt = 0u; mine = 0u;
#pragma unroll
        for (unsigned j = 0; j < 16; ++j) { const unsigned c = xb_ld(&bar[XB_XCNT(j)]); sum += c; cnt += (c > 0u) ? 1u : 0u; mine = (j == x) ? c : mine; }
        if (sum == G) break;
        __builtin_amdgcn_s_sleep(1);
        if ((++sp & 255u) == 0u) { if (xb_ld(&bar[XB_TMO])) break; if (sp > XB_SPIN_CAP) { atomicAdd(&bar[XB_TMO], 1u); break; } }
    }
    nloc = mine > 0u ? mine : 1u; nx = cnt > 0u ? cnt : 1u;
}

__device__ __forceinline__ void xcd_barrier(const XcdBarrier& b) {
    asm volatile("s_waitcnt vmcnt(0)" ::: "memory");
    __syncthreads();
    if (threadIdx.x == 0) {
        unsigned* bar = b.bar;
        __builtin_amdgcn_s_waitcnt(0);
        unsigned nloc = b.st[0], nx = b.st[1];
        if (nloc == 0u) { xcd_barrier_complete(bar, b.x, nloc, nx); b.st[0] = nloc; b.st[1] = nx; }
        const unsigned old = xb_add(&bar[XB_XSUB(b.x)], 1u);
        const unsigned gen = old / nloc;
        if (old + 1u == (gen + 1u) * nloc) {
            __builtin_amdgcn_fence(__ATOMIC_RELEASE, "agent");
            asm volatile("s_waitcnt vmcnt(0)" ::: "memory");
            const unsigned og = xb_add(&bar[XB_TOP], 1u);
            const unsigned tg = og / nx;
            if (og + 1u == (tg + 1u) * nx) xb_add(&bar[XB_TOPGEN], 1u);
            else XB_SPIN(xb_ld(&bar[XB_TOPGEN]) == tg, bar);
            __builtin_amdgcn_fence(__ATOMIC_ACQUIRE, "agent");
            xb_add(&bar[XB_XGEN(b.x)], 1u);
            asm volatile("s_waitcnt vmcnt(0)" ::: "memory");
        } else {
            XB_SPIN(xb_ld(&bar[XB_XGEN(b.x)]) == gen, bar);
            __builtin_amdgcn_fence(__ATOMIC_ACQUIRE, "agent");
            asm volatile("s_waitcnt vmcnt(0)" ::: "memory");
        }
    }
    __syncthreads();
}


constexpr int SEQ = 16384, DM = 1024, DIN = 3080, NWAVES = 8, NT = 512;
constexpr size_t KiB = 1024, MiB = 1u << 20;
constexpr size_t WS_CTL = 0, CTL_ZERO_BYTES = 64 * KiB;
constexpr size_t WS_MOD = 64 * KiB, WS_BIAS1 = 96 * KiB, WS_BIAS3 = 112 * KiB, WS_R1 = 128 * KiB, WS_RSS2 = 192 * KiB  , WS_G = 1280 * KiB, WS_BETA = 1536 * KiB, WS_PAB = 1792 * KiB;
constexpr size_t WS_W1T = 3 * MiB, WS_W2T = 9 * MiB, WS_W3T = 11 * MiB, WS_K1B = 15 * MiB, WS_K2B = 15 * MiB + 256 * KiB;
constexpr size_t WS_XB = 16 * MiB;
constexpr size_t WS_PGM = 48 * MiB;
constexpr size_t WS_PQKV = 80 * MiB;
constexpr size_t WS_PZ = 128 * MiB;
constexpr size_t WS_WC = 144 * MiB, WS_KDT = 160 * MiB, WS_UC = 176 * MiB, WS_QD = 192 * MiB, WS_AT = 208 * MiB;
constexpr size_t WS_UB = 96 * MiB, WS_VB = 216 * MiB;
constexpr size_t WS_IDS = 48 * MiB, WS_GATES = 56 * MiB, WS_END = 256 * MiB;
constexpr int LDS_BYTES = 147456, LDSCTL_OFF = 146944, MISC_OFF = LDSCTL_OFF + 64;

struct Args {
    const float *x, *c, *w_ada, *b_ada, *norm1_w, *w_in, *gm_norm_w, *gm_ws, *gm_bs, *conv_w, *a_log, *dt_bias, *o_norm_w, *w_out, *norm2_w, *peer_wq, *keys1, *keys2, *peer_u, *peer_v, *final_w;
    float* out; unsigned char* ws;
};

__device__ __forceinline__ void gemv_item(const LAS float* vec, const float* W, int ldw, int col0, int ncols, float* out, const float* addb, LAS float* part, int tid) {
    const int c = tid & 63, kg = tid >> 6, col = col0 + c;
    float acc = 0.f;
    if (col < ncols) {
        const float* wp = W + (size_t)(kg * 128) * ldw + col;
#pragma unroll 8
        for (int k = 0; k < 128; ++k) acc += vec[kg * 128 + k] * wp[(size_t)k * ldw];
    }
    part[kg * 64 + c] = acc;
    __syncthreads();
    if (tid < 64 && col < ncols) {
        float s = 0.f;
#pragma unroll
        for (int g = 0; g < 8; ++g) s += part[g * 64 + c];
        out[col] = s + (addb ? addb[col] : 0.f);
    }
    __syncthreads();
}
__device__ __forceinline__ void transpose_item(const float* W, int ldw, int K, int nblk, bf16* WT, LAS float* scr, int item, int lane, const float* nw, const float* sc) {
    const int kb = item / nblk, nb = item % nblk, k0 = 64 * kb, n0 = 32 * nb;
#pragma unroll 8
    for (int i = 0; i < 32; ++i) {
        const int kk = 2 * i + (lane >> 5);
        float s = 1.f;
        if (nw) s = nw[k0 + kk] * (1.f + sc[k0 + kk]);
        scr[kk * 33 + (lane & 31)] = W[(size_t)(k0 + kk) * ldw + n0 + (lane & 31)] * s;
    }
    LDS_WAIT(); asm volatile("" ::: "memory");
    const int c = lane & 7;
#pragma unroll
    for (int j = 0; j < 4; ++j) {
        const int n = (lane >> 3) + 8 * j; const LAS float* s = scr + (8 * c) * 33 + n;
        v4u o; o.x = pk2(s[0 * 33], s[1 * 33]); o.y = pk2(s[2 * 33], s[3 * 33]); o.z = pk2(s[4 * 33], s[5 * 33]); o.w = pk2(s[6 * 33], s[7 * 33]);
        *(v4u*)(WT + (size_t)(n0 + n) * K + k0 + 8 * c) = o;
    }
    LDS_WAIT(); asm volatile("" ::: "memory");
}

typedef short s16x8 __attribute__((ext_vector_type(8)));
typedef unsigned short u16;
__device__ __forceinline__ unsigned cvtpk(float lo, float hi) { return pg8::cvt_pk_bf16(lo, hi); }
__device__ __forceinline__ s16x8 pack8(const f32x4 a, const f32x4 b) {
    v4u w; w.x = cvtpk(a[0], a[1]); w.y = cvtpk(a[2], a[3]); w.z = cvtpk(b[0], b[1]); w.w = cvtpk(b[2], b[3]);
    return __builtin_bit_cast(s16x8, w);
}
#define MFMA16(a, b, c) __builtin_amdgcn_mfma_f32_16x16x32_bf16((a), (b), (c), 0, 0, 0)

constexpr int DNP_HALF_BYTES = 61440;
constexpr int DNP_QT = 0, DNP_KT = 17408, DNP_LM = 34816, DNP_AM = 51200, DNP_MISC = 60416, DNP_ROW = 272  , DNP_XROW = 528  ;

__device__ __forceinline__ void dn_prep(LAS unsigned char* lds, int bx, int G, int tid, const bf16* Pqkv, const float* pab, const float* conv_w, const float* a_log, const float* dt_bias,
                                        bf16* Wc, bf16* KdT, bf16* Uc, bf16* Qd, bf16* At, float* glb) {
    const int lane = tid & 63, wave = tid >> 6, half = wave >> 2, hw = wave & 3, ht = tid & 255;
    const int niter = (1024 + 2 * G - 1) / (2 * G);
    for (int it = 0; it < niter; ++it) {
        int opq = 0; asm volatile("" : "+v"(opq));
        LAS unsigned char* L = lds + half * DNP_HALF_BYTES + opq;
        LAS float* Lm = (LAS float*)(L + DNP_LM);
        LAS float* gcs = (LAS float*)(L + DNP_MISC); LAS float* bts = gcs + 64; LAS float* egs = gcs + 128; LAS float* eks = gcs + 192;
        const int u = (it * G + bx) * 2 + half;
        const bool active = u < 1024;
        const int n = u >> 2, h = u & 3, t0 = n * 64, ui = h * 256 + n;
        if (active) {
            const int i0 = 16 * hw;
            const int chq = h * 128 + 2 * lane, chk = 512 + h * 128 + 2 * lane;
            float wq0[4], wq1[4], wk0[4], wk1[4];
#pragma unroll
            for (int j = 0; j < 4; ++j) { wq0[j] = conv_w[j * 1536 + chq]; wq1[j] = conv_w[j * 1536 + chq + 1]; wk0[j] = conv_w[j * 1536 + chk]; wk1[j] = conv_w[j * 1536 + chk + 1]; }
            unsigned xq[19], xk[19];
#pragma unroll
            for (int r = 0; r < 19; ++r) {
                const int tt = t0 + i0 - 3 + r;
                xq[r] = 0u; xk[r] = 0u;
                if (tt >= 0) { xq[r] = *(const unsigned*)(Pqkv + (size_t)tt * 1536 + chq); xk[r] = *(const unsigned*)(Pqkv + (size_t)tt * 1536 + chk); }
            }
#pragma unroll
            for (int r = 0; r < 16; ++r) {
                float q0 = 0.f, q1 = 0.f, k0 = 0.f, k1 = 0.f;
#pragma unroll
                for (int j = 0; j < 4; ++j) { q0 += wq0[j] * bflo(xq[r + j]); q1 += wq1[j] * bfhi(xq[r + j]); k0 += wk0[j] * bflo(xk[r + j]); k1 += wk1[j] * bfhi(xk[r + j]); }
                q0 = silu_f(q0); q1 = silu_f(q1); k0 = silu_f(k0); k1 = silu_f(k1);
                const float rq = __builtin_amdgcn_rsqf(wave_sum(q0 * q0 + q1 * q1) + 1e-6f) * 0.08838834764831845f;
                const float rk = __builtin_amdgcn_rsqf(wave_sum(k0 * k0 + k1 * k1) + 1e-6f);
                *(LAS unsigned*)(L + DNP_QT + (i0 + r) * DNP_ROW + lane * 4) = cvtpk(q0 * rq, q1 * rq);
                *(LAS unsigned*)(L + DNP_KT + (i0 + r) * DNP_ROW + lane * 4) = cvtpk(k0 * rk, k1 * rk);
            }
            if (hw == 0) {
                const float a = pab[(size_t)(t0 + lane) * 8 + h], b = pab[(size_t)(t0 + lane) * 8 + 4 + h];
                const float xx = a + dt_bias[h];
                const float sp = xx > 20.f ? xx : log1pf(__expf(xx));
                const float g = -__expf(a_log[h]) * sp;
                float gc = g;
#pragma unroll
                for (int off = 1; off < 64; off <<= 1) { const float tq = __shfl_up(gc, off); if (lane >= off) gc += tq; }
                const float glast = __shfl(gc, 63);
                gcs[lane] = gc; bts[lane] = 1.f / (1.f + __expf(-b)); egs[lane] = __expf(gc); eks[lane] = __expf(glast - gc);
                if (lane == 63) glb[ui] = __expf(gc);
            }
        }
        __syncthreads();
        if (active) {
            const int mt = hw, fr = lane & 15, g = lane >> 4;
            s16x8 Ka[4], Qa[4];
#pragma unroll
            for (int s = 0; s < 4; ++s) {
                Ka[s] = *(const LAS s16x8*)(L + DNP_KT + (16 * mt + fr) * DNP_ROW + (32 * s + 8 * g) * 2);
                Qa[s] = *(const LAS s16x8*)(L + DNP_QT + (16 * mt + fr) * DNP_ROW + (32 * s + 8 * g) * 2);
            }
#pragma unroll
            for (int nt = 0; nt < 4; ++nt) {
                const int j = 16 * nt + fr;
                if (nt <= mt) {
                    f32x4 aK = {0.f, 0.f, 0.f, 0.f}, aA = {0.f, 0.f, 0.f, 0.f};
#pragma unroll
                    for (int s = 0; s < 4; ++s) {
                        const s16x8 Kb = *(const LAS s16x8*)(L + DNP_KT + (16 * nt + fr) * DNP_ROW + (32 * s + 8 * g) * 2);
                        aK = MFMA16(Ka[s], Kb, aK); aA = MFMA16(Qa[s], Kb, aA);
                    }
                    const float gj = gcs[j];
#pragma unroll
                    for (int r = 0; r < 4; ++r) {
                        const int i = 16 * mt + 4 * g + r;
                        const float dec = __expf(fminf(gcs[i] - gj, 0.f));
                        Lm[i * 64 + j] = (i > j) ? -(bts[i] * aK[r] * dec) : 0.f;
                        *(LAS u16*)(L + DNP_AM + i * 144 + j * 2) = (u16)f2bf((i >= j) ? aA[r] * dec : 0.f);
                    }
                } else {
#pragma unroll
                    for (int r = 0; r < 4; ++r) { const int i = 16 * mt + 4 * g + r; *(LAS u16*)(L + DNP_AM + i * 144 + j * 2) = (u16)0; }
                }
            }
#pragma unroll
            for (int k = 0; k < 4; ++k) {
                const int p = k * 256 + ht, f = p >> 6, lp = p & 63, pm = f >> 2, ps = f & 3, i = 16 * pm + (lp & 15), gp = lp >> 4;
                const LAS unsigned char* src = L + DNP_QT + i * DNP_ROW + (32 * ps + 4 * gp) * 2;
                const unsigned long long lo = *(const LAS unsigned long long*)src, hi = *(const LAS unsigned long long*)(src + 32);
                const float e = egs[i];
                v4u o;
                o.x = cvtpk(bflo((unsigned)lo) * e, bfhi((unsigned)lo) * e); o.y = cvtpk(bflo((unsigned)(lo >> 32)) * e, bfhi((unsigned)(lo >> 32)) * e);
                o.z = cvtpk(bflo((unsigned)hi) * e, bfhi((unsigned)hi) * e); o.w = cvtpk(bflo((unsigned)(hi >> 32)) * e, bfhi((unsigned)(hi >> 32)) * e);
                *(v4u*)((unsigned char*)Qd + (size_t)ui * 16384 + (size_t)p * 16) = o;
            }
#pragma unroll
            for (int k = 0; k < 4; ++k) {
                const int p = k * 256 + ht, f = p >> 6, lp = p & 63, pm = f >> 1, ps = f & 1, dk = 16 * pm + (lp & 15), gp = lp >> 4;
                float vv[8];
#pragma unroll
                for (int jj = 0; jj < 8; ++jj) { const int i = 32 * ps + 16 * (jj >> 2) + 4 * gp + (jj & 3); vv[jj] = bf2f(*(const LAS u16*)(L + DNP_KT + i * DNP_ROW + dk * 2)) * eks[i]; }
                v4u o; o.x = cvtpk(vv[0], vv[1]); o.y = cvtpk(vv[2], vv[3]); o.z = cvtpk(vv[4], vv[5]); o.w = cvtpk(vv[6], vv[7]);
                *(v4u*)((unsigned char*)KdT + (size_t)ui * 16384 + (size_t)p * 16) = o;
            }
        }
        __syncthreads();
        float X[64];
        if (active) {
            const int c = ht;
            if (c < 128) {
                const int ch = 1024 + h * 128 + c;
                float w0 = conv_w[ch], w1 = conv_w[1536 + ch], w2 = conv_w[2 * 1536 + ch], w3 = conv_w[3 * 1536 + ch];
                float xm3 = 0.f, xm2 = 0.f, xm1 = 0.f;
                if (t0 > 0) { xm3 = bf2f(Pqkv[(size_t)(t0 - 3) * 1536 + ch]); xm2 = bf2f(Pqkv[(size_t)(t0 - 2) * 1536 + ch]); xm1 = bf2f(Pqkv[(size_t)(t0 - 1) * 1536 + ch]); }
#pragma unroll
                for (int i = 0; i < 64; ++i) X[i] = bf2f(Pqkv[(size_t)(t0 + i) * 1536 + ch]);
#pragma unroll
                for (int i = 63; i >= 0; --i) {
                    const float a3 = X[i], a2 = (i >= 1) ? X[i - 1] : xm1, a1 = (i >= 2) ? X[i - 2] : ((i == 1) ? xm1 : xm2), a0 = (i >= 3) ? X[i - 3] : ((i == 2) ? xm1 : ((i == 1) ? xm2 : xm3));
                    X[i] = silu_f(w0 * a0 + w1 * a1 + w2 * a2 + w3 * a3) * bts[i];
                }
            } else {
                const int dk = c - 128;
#pragma unroll
                for (int i = 0; i < 64; ++i) X[i] = bf2f(*(const LAS u16*)(L + DNP_KT + i * DNP_ROW + dk * 2)) * bts[i] * egs[i];
            }
#pragma unroll
            for (int i = 1; i < 64; ++i) {
                float acc = X[i];
#pragma unroll
                for (int j4 = 0; j4 < (i + 3) / 4; ++j4) {
                    const f32x4 l = *(const LAS f32x4*)(Lm + i * 64 + 4 * j4);
#pragma unroll
                    for (int e = 0; e < 4; ++e) if (4 * j4 + e < i) asm("v_fmac_f32_e32 %0, %1, %2" : "+v"(acc) : "v"(l[e]), "v"(X[4 * j4 + e]));
                }
                X[i] = acc;
            }
        }
        __syncthreads();
        if (active) {
#pragma unroll
            for (int i = 0; i < 64; ++i) *(LAS u16*)(L + i * DNP_XROW + ht * 2) = (u16)f2bf(X[i]);
        }
        __syncthreads();
        if (active) {
#pragma unroll
            for (int k = 0; k < 4; ++k) {
                const int p = k * 256 + ht, f = p >> 6, lp = p & 63, pm = f >> 2, ps = f & 3, i = 16 * pm + (lp & 15), gp = lp >> 4;
                const LAS unsigned char* src = L + i * DNP_XROW + (128 + 32 * ps + 4 * gp) * 2;
                const unsigned long long lo = *(const LAS unsigned long long*)src, hi = *(const LAS unsigned long long*)(src + 32);
                v4u o; o.x = (unsigned)lo; o.y = (unsigned)(lo >> 32); o.z = (unsigned)hi; o.w = (unsigned)(hi >> 32);
                *(v4u*)((unsigned char*)Wc + (size_t)ui * 16384 + (size_t)p * 16) = o;
            }
#pragma unroll
            for (int k = 0; k < 4; ++k) {
                const int p = k * 256 + ht, sl = p >> 7, lp = (p >> 1) & 63, hh = p & 1, gp = lp >> 4, col = 16 * sl + (lp & 15);
                unsigned short e[8];
#pragma unroll
                for (int q = 0; q < 8; ++q) { const int i = 16 * (2 * hh + (q >> 2)) + 4 * gp + (q & 3); e[q] = *(const LAS u16*)(L + i * DNP_XROW + col * 2); }
                v4u o; o.x = e[0] | ((unsigned)e[1] << 16); o.y = e[2] | ((unsigned)e[3] << 16); o.z = e[4] | ((unsigned)e[5] << 16); o.w = e[6] | ((unsigned)e[7] << 16);
                *(v4u*)((unsigned char*)Uc + (size_t)ui * 16384 + (size_t)p * 16) = o;
            }
#pragma unroll
            for (int k = 0; k < 2; ++k) {
                const int p = k * 256 + ht, f = p >> 6, lp = p & 63, pm = f >> 1, ps = f & 1, i = 16 * pm + (lp & 15), gp = lp >> 4;
                const LAS unsigned char* src = L + DNP_AM + i * 144 + (32 * ps + 4 * gp) * 2;
                const unsigned long long lo = *(const LAS unsigned long long*)src, hi = *(const LAS unsigned long long*)(src + 32);
                v4u o; o.x = (unsigned)lo; o.y = (unsigned)(lo >> 32); o.z = (unsigned)hi; o.w = (unsigned)(hi >> 32);
                *(v4u*)((unsigned char*)At + (size_t)ui * 8192 + (size_t)p * 16) = o;
            }
        }
        __syncthreads();
    }
}

#define DN_WAITV(n) asm volatile("s_waitcnt vmcnt(" #n ")" ::: "memory")
__device__ __forceinline__ void dn_scan(LAS unsigned char* lds, int b, int tid, const bf16* Wc, const bf16* KdT, const bf16* Uc, const float* glb, bf16* Sbuf, bf16* Vbuf) {
    const int lane = tid & 63, wave = __builtin_amdgcn_readfirstlane(tid >> 6), h = b >> 1;
    if (wave >= 4) {
        const int lw = wave - 4, lt = tid - 256;
        const unsigned char* wsrc = (const unsigned char*)Wc + (size_t)h * 256 * 16384 + (size_t)lt * 16;
        const unsigned char* ksrc = (const unsigned char*)KdT + (size_t)h * 256 * 16384 + (size_t)lt * 16;
#define DN_ISSUE(n) do { const int _n = (n); LAS unsigned char* _d = lds + (_n & 3) * 32768 + lw * 1024; \
        _Pragma("unroll") for (int _j = 0; _j < 4; ++_j) __builtin_amdgcn_global_load_lds((const unsigned*)(wsrc + (size_t)_n * 16384 + _j * 4096), (LAS unsigned*)(_d + _j * 4096), 16, 0, 0); \
        _Pragma("unroll") for (int _j = 0; _j < 4; ++_j) __builtin_amdgcn_global_load_lds((const unsigned*)(ksrc + (size_t)_n * 16384 + _j * 4096), (LAS unsigned*)(_d + 16384 + _j * 4096), 16, 0, 0); } while (0)
        DN_ISSUE(0); DN_ISSUE(1); DN_ISSUE(2);
        DN_WAITV(16);
        __builtin_amdgcn_s_barrier();
        for (int n = 0; n < 256; ++n) {
            if (n + 3 < 256) { DN_ISSUE(n + 3); DN_WAITV(16); }
            else if (n + 2 < 256) { DN_WAITV(8); }
            else { DN_WAITV(0); }
            __builtin_amdgcn_s_barrier();
        }
#undef DN_ISSUE
    } else {
        const int sl = (b & 1) * 4 + wave;
        f32x4 S[8];
#pragma unroll
        for (int m = 0; m < 8; ++m) S[m] = (f32x4){0.f, 0.f, 0.f, 0.f};
        const unsigned char* usrc = (const unsigned char*)Uc + (size_t)h * 256 * 16384 + (size_t)(sl * 64 + lane) * 32;
        unsigned char* sdst = (unsigned char*)Sbuf + ((size_t)h * 256 * 8 + sl) * 4096 + (size_t)lane * 16;
        unsigned char* vdst = (unsigned char*)Vbuf + ((size_t)h * 256 * 8 + sl) * 2048 + (size_t)lane * 16;
        v4u un0 = *(const v4u*)usrc, un1 = *(const v4u*)(usrc + 16);
        __builtin_amdgcn_s_barrier();
        for (int n = 0; n < 256; ++n) {
            const v4u u0 = un0, u1 = un1;
            if (n + 1 < 256) { un0 = *(const v4u*)(usrc + (size_t)(n + 1) * 16384); un1 = *(const v4u*)(usrc + (size_t)(n + 1) * 16384 + 16); }
            const float glv = glb[h * 256 + n];
            const LAS unsigned char* base = lds + (n & 3) * 32768 + lane * 16;
            s16x8 Sb[4];
#pragma unroll
            for (int s = 0; s < 4; ++s) { Sb[s] = pack8(S[2 * s], S[2 * s + 1]); *(s16x8*)(sdst + (size_t)n * 32768 + s * 1024) = Sb[s]; }
            f32x4 acc[4];
#pragma unroll
            for (int m = 0; m < 4; ++m) {
                acc[m] = (f32x4){0.f, 0.f, 0.f, 0.f};
#pragma unroll
                for (int s = 0; s < 4; ++s) { const s16x8 a = *(const LAS s16x8*)(base + (m * 4 + s) * 1024); acc[m] = MFMA16(a, Sb[s], acc[m]); }
            }
            f32x4 vn[4];
            vn[0] = (f32x4){bflo(u0.x), bfhi(u0.x), bflo(u0.y), bfhi(u0.y)} - acc[0];
            vn[1] = (f32x4){bflo(u0.z), bfhi(u0.z), bflo(u0.w), bfhi(u0.w)} - acc[1];
            vn[2] = (f32x4){bflo(u1.x), bfhi(u1.x), bflo(u1.y), bfhi(u1.y)} - acc[2];
            vn[3] = (f32x4){bflo(u1.z), bfhi(u1.z), bflo(u1.w), bfhi(u1.w)} - acc[3];
            s16x8 Vb[2];
#pragma unroll
            for (int s = 0; s < 2; ++s) { Vb[s] = pack8(vn[2 * s], vn[2 * s + 1]); *(s16x8*)(vdst + (size_t)n * 16384 + s * 1024) = Vb[s]; }
#pragma unroll
            for (int m = 0; m < 8; ++m) {
                S[m] = S[m] * glv;
#pragma unroll
                for (int s = 0; s < 2; ++s) { const s16x8 a = *(const LAS s16x8*)(base + 16384 + (m * 2 + s) * 1024); S[m] = MFMA16(a, Vb[s], S[m]); }
            }
            __builtin_amdgcn_s_barrier();
        }
    }
}

__device__ __forceinline__ void dn_out(LAS unsigned char* lds, int bx, int G, int tid, const bf16* Qd, const bf16* At, const bf16* Sbuf, const bf16* Vbuf, const bf16* Pz, const float* o_norm_w, bf16* mixb) {
    const int lane = tid & 63, wave = tid >> 6, fr = lane & 15, g = lane >> 4;
    LAS float* part = (LAS float*)lds;
    LAS float* rnorm = part + 512;
    for (int ui = bx; ui < 1024; ui += G) {
        const int h = ui >> 8, n = ui & 255;
        const unsigned char* qsrc = (const unsigned char*)Qd + (size_t)ui * 16384 + lane * 16;
        const unsigned char* asrc = (const unsigned char*)At + (size_t)ui * 8192 + lane * 16;
        const unsigned char* ssrc = (const unsigned char*)Sbuf + ((size_t)ui * 8 + wave) * 4096 + lane * 16;
        const unsigned char* vsrc = (const unsigned char*)Vbuf + ((size_t)ui * 8 + wave) * 2048 + lane * 16;
        s16x8 Sb[4], Vb[2];
#pragma unroll
        for (int s = 0; s < 4; ++s) Sb[s] = *(const s16x8*)(ssrc + s * 1024);
#pragma unroll
        for (int s = 0; s < 2; ++s) Vb[s] = *(const s16x8*)(vsrc + s * 1024);
        f32x4 o[4];
#pragma unroll
        for (int m = 0; m < 4; ++m) {
            o[m] = (f32x4){0.f, 0.f, 0.f, 0.f};
#pragma unroll
            for (int s = 0; s < 4; ++s) { const s16x8 a = *(const s16x8*)(qsrc + (m * 4 + s) * 1024); o[m] = MFMA16(a, Sb[s], o[m]); }
#pragma unroll
            for (int s = 0; s < 2; ++s) { const s16x8 a = *(const s16x8*)(asrc + (m * 2 + s) * 1024); o[m] = MFMA16(a, Vb[s], o[m]); }
        }
#pragma unroll
        for (int m = 0; m < 4; ++m)
#pragma unroll
            for (int r = 0; r < 4; ++r) {
                float q = o[m][r] * o[m][r];
                q += __shfl_xor(q, 1); q += __shfl_xor(q, 2); q += __shfl_xor(q, 4); q += __shfl_xor(q, 8);
                if (fr == 0) part[wave * 64 + 16 * m + 4 * g + r] = q;
            }
        __syncthreads();
        if (tid < 64) {
            float s = 0.f;
#pragma unroll
            for (int w = 0; w < 8; ++w) s += part[w * 64 + tid];
            rnorm[tid] = __builtin_amdgcn_rsqf(s * (1.f / 128.f) + 1e-6f);
        }
        __syncthreads();
        const int dv = 16 * wave + fr;
        const float ow = o_norm_w[dv];
#pragma unroll
        for (int m = 0; m < 4; ++m)
#pragma unroll
            for (int r = 0; r < 4; ++r) {
                const int i = 16 * m + 4 * g + r; const size_t t = (size_t)n * 64 + i;
                const float z = bf2f(Pz[t * 512 + h * 128 + dv]);
                mixb[t * 1024 + 512 + h * 128 + dv] = (bf16)f2bf(o[m][r] * rnorm[i] * ow * z);
            }
        __syncthreads();
    }
}


typedef __bf16 v2bf __attribute__((ext_vector_type(2)));
__device__ __forceinline__ float dot2bf(unsigned a, unsigned b, float c) { return __builtin_amdgcn_fdot2_f32_bf16(__builtin_bit_cast(v2bf, a), __builtin_bit_cast(v2bf, b), c, false); }

__device__ __forceinline__ void uv_convert_row(const float* src, unsigned char* dst, int e, int lane) {
    const f32x4* s = (const f32x4*)(src + (size_t)e * 1024) + lane;
#pragma unroll
    for (int j = 0; j < 4; ++j) {
        const f32x4 v = s[64 * j];
        const int c = j * 4 + (lane >> 4);
        *(unsigned long long*)(dst + ((size_t)c * 16384 + e) * 128 + (lane & 15) * 8) = (unsigned long long)pk2(v.x, v.y) | ((unsigned long long)pk2(v.z, v.w) << 32);
    }
}
__device__ __forceinline__ float* pre_slab(unsigned char* ws, int c) {
    const size_t off = (c < 4) ? (WS_XB + (size_t)c * 8 * MiB) : (c < 8) ? (64 * MiB + (size_t)(c - 4) * 8 * MiB) : (128 * MiB + (size_t)(c - 8) * 8 * MiB);
    return (float*)(ws + off);
}
struct XcdMap { int rank, nloc, px, np; };

__device__ __forceinline__ void peer_pre(const XcdMap M, int tid, unsigned char* ws, const unsigned char* Ub, const float* x1, const float* r2, const float* mod, const float* norm2_w, const int* ids) {
    const int lane = tid & 63, wave = tid >> 6, a = lane >> 3, b = lane & 7;
    const float* sh2 = mod + 3072; const float* sc2 = mod + 4096;
    for (int c = M.px; c < 16; c += M.np) {
        float a2[8], s2[8];
#pragma unroll
        for (int e = 0; e < 8; ++e) { const int k = 64 * c + 8 * b + e; a2[e] = norm2_w[k] * (1.f + sc2[k]); s2[e] = sh2[k]; }
        const unsigned char* ub = Ub + (size_t)c * 2 * MiB + b * 16;
        float* slab = pre_slab(ws, c);
        for (int q = M.rank; q < SEQ / 8; q += M.nloc) {
            const int t = q * 8 + wave;
            int idv[16];
#pragma unroll
            for (int i = 0; i < 16; ++i) idv[i] = ids[(size_t)t * 128 + i * 8 + a];
            const float rr = r2[t];
            const f32x4 xa = *(const f32x4*)(x1 + (size_t)t * 1024 + 64 * c + 8 * b), xc = *(const f32x4*)(x1 + (size_t)t * 1024 + 64 * c + 8 * b + 4);
            unsigned hb[4];
            hb[0] = cvtpk(xa[0] * rr * a2[0] + s2[0], xa[1] * rr * a2[1] + s2[1]); hb[1] = cvtpk(xa[2] * rr * a2[2] + s2[2], xa[3] * rr * a2[3] + s2[3]);
            hb[2] = cvtpk(xc[0] * rr * a2[4] + s2[4], xc[1] * rr * a2[5] + s2[5]); hb[3] = cvtpk(xc[2] * rr * a2[6] + s2[6], xc[3] * rr * a2[7] + s2[7]);
            v4u gq[16];
#pragma unroll
            for (int i = 0; i < 16; ++i) gq[i] = *(const v4u*)(ub + (size_t)idv[i] * 128);
            float p[16];
#pragma unroll
            for (int i = 0; i < 16; ++i) p[i] = dot2bf(gq[i].x, hb[0], dot2bf(gq[i].y, hb[1], dot2bf(gq[i].z, hb[2], dot2bf(gq[i].w, hb[3], 0.f))));
            const bool h4 = (b & 4) != 0, h2 = (b & 2) != 0, h1 = (b & 1) != 0;
            float q8[8], r4[4], s1[2];
#pragma unroll
            for (int i = 0; i < 8; ++i) { const float send = h4 ? p[i] : p[i + 8], keep = h4 ? p[i + 8] : p[i]; q8[i] = keep + __shfl_xor(send, 4); }
#pragma unroll
            for (int i = 0; i < 4; ++i) { const float send = h2 ? q8[i] : q8[i + 4], keep = h2 ? q8[i + 4] : q8[i]; r4[i] = keep + __shfl_xor(send, 2); }
#pragma unroll
            for (int i = 0; i < 2; ++i) { const float send = h1 ? r4[i] : r4[i + 2], keep = h1 ? r4[i + 2] : r4[i]; s1[i] = keep + __shfl_xor(send, 1); }
            const int slot = 8 * (b >> 2) + 4 * ((b >> 1) & 1) + 2 * (b & 1);
            slab[(size_t)t * 128 + (slot + 0) * 8 + a] = s1[0];
            slab[(size_t)t * 128 + (slot + 1) * 8 + a] = s1[1];
        }
    }
}

__device__ __forceinline__ void peer_out(const XcdMap M, int tid, const unsigned char* Vb, float* x1, const float* mod, const int* ids, const float* coef, float* rss3) {
    const int lane = tid & 63, wave = tid >> 6, a = lane >> 3, b = lane & 7;
    const float* gt2 = mod + 5120;
    const bool h32 = (a & 4) != 0, h16 = (a & 2) != 0, h8 = (a & 1) != 0;
    const int col = 8 * b + 4 * ((a >> 2) & 1) + 2 * ((a >> 1) & 1) + (a & 1);
    for (int c = M.px; c < 16; c += M.np) {
        const unsigned char* vb = Vb + (size_t)c * 2 * MiB + b * 16;
        const float g2 = gt2[64 * c + col];
        for (int q = M.rank; q < SEQ / 8; q += M.nloc) {
            const int t = q * 8 + wave;
            int idv[16]; float cf[16];
#pragma unroll
            for (int i = 0; i < 16; ++i) { idv[i] = ids[(size_t)t * 128 + i * 8 + a]; cf[i] = coef[(size_t)t * 128 + i * 8 + a]; }
            const float xv = x1[(size_t)t * 1024 + 64 * c + col];
            v4u gq[16];
#pragma unroll
            for (int i = 0; i < 16; ++i) gq[i] = *(const v4u*)(vb + (size_t)idv[i] * 128);
            float acc[8];
#pragma unroll
            for (int e = 0; e < 8; ++e) acc[e] = 0.f;
#pragma unroll
            for (int i = 0; i < 16; ++i) {
                acc[0] += cf[i] * bflo(gq[i].x); acc[1] += cf[i] * bfhi(gq[i].x); acc[2] += cf[i] * bflo(gq[i].y); acc[3] += cf[i] * bfhi(gq[i].y);
                acc[4] += cf[i] * bflo(gq[i].z); acc[5] += cf[i] * bfhi(gq[i].z); acc[6] += cf[i] * bflo(gq[i].w); acc[7] += cf[i] * bfhi(gq[i].w);
            }
            float q4[4], r2v[2];
#pragma unroll
            for (int i = 0; i < 4; ++i) { const float send = h32 ? acc[i] : acc[i + 4], keep = h32 ? acc[i + 4] : acc[i]; q4[i] = keep + __shfl_xor(send, 32); }
#pragma unroll
            for (int i = 0; i < 2; ++i) { const float send = h16 ? q4[i] : q4[i + 2], keep = h16 ? q4[i + 2] : q4[i]; r2v[i] = keep + __shfl_xor(send, 16); }
            const float send = h8 ? r2v[0] : r2v[1], keep = h8 ? r2v[1] : r2v[0];
            const float ff = keep + __shfl_xor(send, 8);
            const float x2 = xv + g2 * ff;
            x1[(size_t)t * 1024 + 64 * c + col] = x2;
            const float ss = wave_sum(x2 * x2);
            if (lane == 0) rss3[(size_t)c * SEQ + t] = ss;
        }
    }
}


__device__ __forceinline__ unsigned ord_key(float v) { const unsigned b = __builtin_bit_cast(unsigned, v); return (b & 0x80000000u) ? ~b : (b | 0x80000000u); }
__device__ __forceinline__ float ord_val(unsigned k, unsigned lowmask) {
    const unsigned b = (k & 0x80000000u) ? (k & 0x7fffffffu) : ~k;
    return __builtin_bit_cast(float, b & ~lowmask);
}
#define RT_INS(T, key) do { unsigned _k = (key); _Pragma("unroll") for (int _i = 0; _i < 16; ++_i) { const unsigned _hi = max(T[_i], _k); _k = min(T[_i], _k); T[_i] = _hi; } } while (0)

__device__ __forceinline__ void route_phase(LAS unsigned char* lds, int bx, int G, int tid, const bf16* qq, const bf16* K1b, const bf16* K2b, int* ids, float* gates) {
    const int lane = tid & 63, wave = tid >> 6, fr = lane & 15, g = lane >> 4;
    LAS float* sc = (LAS float*)lds;
    LAS unsigned* scu = (LAS unsigned*)lds;
    for (int u = bx; u < 1024; u += G) {
        const int tile = u >> 2, hp = u & 3, t0 = tile * 64;
        {
            const int hh = wave >> 2, half = (wave >> 1) & 1, th = wave & 1, h = 2 * hp + hh;
            const bf16* kb = (half ? K2b : K1b) + (size_t)h * 128 * 128;
            s16x8 Aq[2][4];
#pragma unroll
            for (int mt = 0; mt < 2; ++mt)
#pragma unroll
                for (int s = 0; s < 4; ++s) Aq[mt][s] = *(const s16x8*)(qq + (size_t)(t0 + 32 * th + 16 * mt + fr) * 2048 + h * 256 + half * 128 + 32 * s + 8 * g);
            const int lbase = (hh * 2 + half) * 64 + 32 * th;
#pragma unroll
            for (int nt = 0; nt < 8; ++nt) {
                f32x4 a0 = {0.f, 0.f, 0.f, 0.f}, a1 = {0.f, 0.f, 0.f, 0.f};
#pragma unroll
                for (int s = 0; s < 4; ++s) {
                    const s16x8 Bk = *(const s16x8*)(kb + (size_t)(16 * nt + fr) * 128 + 32 * s + 8 * g);
                    a0 = MFMA16(Aq[0][s], Bk, a0); a1 = MFMA16(Aq[1][s], Bk, a1);
                }
#pragma unroll
                for (int r = 0; r < 4; ++r) { sc[(lbase + 4 * g + r) * 129 + 16 * nt + fr] = a0[r]; sc[(lbase + 16 + 4 * g + r) * 129 + 16 * nt + fr] = a1[r]; }
            }
        }
        __syncthreads();
        unsigned T[16];
        const int li = tid & 255, part = tid >> 8;
        {
#pragma unroll
            for (int i = 0; i < 16; ++i) T[i] = 0u;
            const LAS float* src = sc + li * 129 + 64 * part;
#pragma unroll 4
            for (int k = 0; k < 64; ++k) { const unsigned key = (ord_key(src[k]) & ~127u) | (unsigned)(127 - (64 * part + k)); RT_INS(T, key); }
            if (part == 1) {
#pragma unroll
                for (int i = 0; i < 16; ++i) scu[li * 129 + 64 + i] = T[i];
            }
        }
        __syncthreads();
        if (part == 0) {
#pragma unroll
            for (int i = 0; i < 16; ++i) T[i] = max(T[i], scu[li * 129 + 64 + 15 - i]);
#pragma unroll
            for (int st = 8; st >= 1; st >>= 1)
#pragma unroll
                for (int i = 0; i < 16; ++i) if ((i & st) == 0) { const unsigned hi = max(T[i], T[i + st]), lo = min(T[i], T[i + st]); T[i] = hi; T[i + st] = lo; }
#pragma unroll
            for (int i = 0; i < 16; ++i) scu[li * 129 + i] = T[i];
        }
        __syncthreads();
        if (tid < 128) {
            const int tok = tid & 63, hh = tid >> 6, h = 2 * hp + hh;
            const int l1 = (hh * 2 + 0) * 64 + tok, l2 = (hh * 2 + 1) * 64 + tok;
            float v1[16], v2[16];
#pragma unroll
            for (int i = 0; i < 16; ++i) { v1[i] = ord_val(scu[l1 * 129 + i], 127u); v2[i] = ord_val(scu[l2 * 129 + i], 127u); }
#pragma unroll
            for (int i = 0; i < 16; ++i) T[i] = 0u;
#pragma unroll
            for (int i = 0; i < 16; ++i)
#pragma unroll
                for (int j = 0; j < 16; ++j)
                    if ((i + 1) * (j + 1) <= 16) { const unsigned key = (ord_key(v1[i] + v2[j]) & ~255u) | (unsigned)(255 - (i * 16 + j)); RT_INS(T, key); }
            const float mx = ord_val(T[0], 255u);
            float e[16], se = 0.f;
#pragma unroll
            for (int r = 0; r < 16; ++r) { e[r] = __expf(ord_val(T[r], 255u) - mx); se += e[r]; }
            const float inv = 1.f / se;
            const size_t ob = (size_t)(t0 + tok) * 128 + h * 16;
#pragma unroll
            for (int r = 0; r < 16; ++r) {
                const int pos = 255 - (int)(T[r] & 255u), i = pos >> 4, j = pos & 15;
                const int i1 = 127 - (int)(scu[l1 * 129 + i] & 127u), i2 = 127 - (int)(scu[l2 * 129 + j] & 127u);
                ids[ob + r] = i1 * 128 + i2;
                gates[ob + r] = e[r] * inv;
            }
        }
        __syncthreads();
    }
}


__device__ __forceinline__ int otid() { int t = threadIdx.x; asm volatile("" : "+v"(t)); return t; }
#define PH_IDS const int tid = otid(), lane = tid & 63, wave = __builtin_amdgcn_readfirstlane(tid >> 6), gw = bx * NWAVES + wave; (void)lane; (void)wave; (void)gw
__global__ void __launch_bounds__(NT, 2) fwd_kernel(Args A) {
    extern __shared__ __attribute__((aligned(16))) unsigned char lds_raw[];
    LAS unsigned char* lds = (LAS unsigned char*)lds_raw;
    LAS float* ldsf = (LAS float*)lds;
    const int G = gridDim.x, bx = blockIdx.x, NGW = G * NWAVES;
    unsigned char* ws = A.ws;
    float* mod = (float*)(ws + WS_MOD); float* bias1 = (float*)(ws + WS_BIAS1); float* bias3 = (float*)(ws + WS_BIAS3);
    float* r1 = (float*)(ws + WS_R1); float* rss2 = (float*)(ws + WS_RSS2); float* gbuf = (float*)(ws + WS_G); float* bbuf = (float*)(ws + WS_BETA); float* pab = (float*)(ws + WS_PAB);
    bf16* K1b = (bf16*)(ws + WS_K1B); bf16* K2b = (bf16*)(ws + WS_K2B);
    bf16* W1T = (bf16*)(ws + WS_W1T); bf16* W2T = (bf16*)(ws + WS_W2T); bf16* W3T = (bf16*)(ws + WS_W3T);
    bf16* xb = (bf16*)(ws + WS_XB); bf16* mixb = (bf16*)(ws + WS_XB);
    bf16* Pgm = (bf16*)(ws + WS_PGM); bf16* x1b = (bf16*)(ws + WS_PGM);
    bf16* Pqkv = (bf16*)(ws + WS_PQKV); bf16* qq = (bf16*)(ws + WS_WC);
    bf16* Pz = (bf16*)(ws + WS_PZ);
    bf16* Wc = (bf16*)(ws + WS_WC); bf16* KdT = (bf16*)(ws + WS_KDT); bf16* Uc = (bf16*)(ws + WS_UC); bf16* Qd = (bf16*)(ws + WS_QD); bf16* At = (bf16*)(ws + WS_AT);
    bf16* Sbuf = (bf16*)(ws + WS_PGM); bf16* Vbuf = (bf16*)(ws + WS_PQKV); float* glb = gbuf;
    int* ids = (int*)(ws + WS_IDS); float* gates = (float*)(ws + WS_GATES);

    if (threadIdx.x < 128) ((LAS unsigned*)(lds + LDSCTL_OFF))[threadIdx.x] = 0u;
    __syncthreads();
    XcdBarrier bar; bar.bar = (unsigned*)(ws + WS_CTL) + 1024; bar.x = xb_xcc_id(); bar.st = (volatile LAS unsigned*)(lds + MISC_OFF);
    if (threadIdx.x == 0) bar.st[2] = xb_add(&bar.bar[XB_XCNT(bar.x)], 1u);

    {
        PH_IDS;
        if (bx < 96) {
            for (int i = tid; i < 1024; i += NT) ldsf[i] = silu_f(A.c[i]);
            __syncthreads();
            for (int it = bx; it < 96; it += G) gemv_item(ldsf, A.w_ada, 6144, it * 64, 6144, mod, A.b_ada, ldsf + 1024, tid);
        } else {
            LAS float* scr = ldsf + 4096 + wave * 2176;
            const int w0 = (bx - 96) * NWAVES + wave, nwv = (G - 96) * NWAVES;
            if (nwv > 0) for (int it = w0; it < 512; it += nwv) transpose_item(A.w_out, 1024, 1024, 32, W2T, scr, it, lane, nullptr, nullptr);
            for (int i = (bx - 96) * NT + tid; i < 2 * 32768; i += (G - 96) * NT) {
                const f32x4 v = (i < 32768) ? ((const f32x4*)A.keys1)[i] : ((const f32x4*)A.keys2)[i - 32768];
                unsigned long long* dst = (i < 32768) ? (unsigned long long*)K1b + i : (unsigned long long*)K2b + (i - 32768);
                *dst = (unsigned long long)pk2(v.x, v.y) | ((unsigned long long)pk2(v.z, v.w) << 32);
            }
        }
        if (G <= 96) {
            LAS float* scr = ldsf + 4096 + wave * 2176; for (int it = gw; it < 512; it += NGW) transpose_item(A.w_out, 1024, 1024, 32, W2T, scr, it, lane, nullptr, nullptr);
            for (int i = bx * NT + tid; i < 2 * 32768; i += G * NT) {
                const f32x4 v = (i < 32768) ? ((const f32x4*)A.keys1)[i] : ((const f32x4*)A.keys2)[i - 32768];
                unsigned long long* dst = (i < 32768) ? (unsigned long long*)K1b + i : (unsigned long long*)K2b + (i - 32768);
                *dst = (unsigned long long)pk2(v.x, v.y) | ((unsigned long long)pk2(v.z, v.w) << 32);
            }
        }
    }
    xcd_barrier(bar);

    {
        PH_IDS;
        const float* sh1 = mod; const float* sc1 = mod + 1024; const float* sh2 = mod + 3072; const float* sc2 = mod + 4096;
        LAS float* vec1 = ldsf;
        LAS float* vec2 = ldsf + 1024;
        LAS float* part = ldsf + 2048;
        LAS float* wab = ldsf + 4096;
        LAS float* bab = ldsf + 12288;
        LAS float* scr = ldsf + 12544 + wave * 2176;
        for (int i = tid; i < 1024; i += NT) { vec1[i] = sh1[i]; vec2[i] = sh2[i]; }
        for (int i = tid; i < 8192; i += NT) { const int k = i >> 3, j = i & 7; wab[j * 1024 + k] = A.norm1_w[k] * (1.f + sc1[k]) * A.w_in[(size_t)k * DIN + 3072 + j]; }
        __syncthreads();
        {
            float s = 0.f;
            for (int k = lane; k < 1024; k += 64) s += vec1[k] * A.w_in[(size_t)k * DIN + 3072 + wave];
            s = wave_sum(s);
            if (lane == 0) bab[wave] = s;
        }
        __syncthreads();
        for (int it = bx; it < 80; it += G) {
            if (it < 48) gemv_item(vec1, A.w_in, DIN, it * 64, 3072, bias1, nullptr, part, tid);
            else gemv_item(vec2, A.peer_wq, 2048, (it - 48) * 64, 2048, bias3, nullptr, part, tid);
        }
        for (int it = gw; it < 1536 + 1024; it += NGW) {
            if (it < 1536) transpose_item(A.w_in, DIN, 1024, 96, W1T, scr, it, lane, A.norm1_w, sc1);
            else transpose_item(A.peer_wq, 2048, 1024, 64, W3T, scr, it - 1536, lane, A.norm2_w, sc2);
        }
        for (int row = gw; row < SEQ; row += NGW) {
            const f32x4* xr = (const f32x4*)(A.x + (size_t)row * 1024) + lane;
            f32x4 v[4]; float ss = 0.f;
#pragma unroll
            for (int j = 0; j < 4; ++j) { v[j] = xr[64 * j]; ss += (v[j].x * v[j].x + v[j].y * v[j].y) + (v[j].z * v[j].z + v[j].w * v[j].w); }
            const float rr = __builtin_amdgcn_rsqf(wave_sum(ss) * (1.f / 1024.f) + 1e-6f);
            unsigned long long* o8 = (unsigned long long*)(xb + (size_t)row * 1024) + lane;
#pragma unroll
            for (int j = 0; j < 4; ++j) o8[64 * j] = (unsigned long long)pk2(v[j].x, v[j].y) | ((unsigned long long)pk2(v[j].z, v[j].w) << 32);
            float d[8];
#pragma unroll
            for (int jc = 0; jc < 8; ++jc) {
                float s = 0.f;
#pragma unroll
                for (int j = 0; j < 4; ++j) { const LAS float* wp = wab + jc * 1024 + j * 256 + lane * 4; s += (v[j].x * wp[0] + v[j].y * wp[1]) + (v[j].z * wp[2] + v[j].w * wp[3]); }
                d[jc] = wave_sum(s);
            }
            if (lane == 0) {
                r1[row] = rr;
#pragma unroll
                for (int jc = 0; jc < 8; ++jc) pab[(size_t)row * 8 + jc] = d[jc] * rr + bab[jc];
            }
        }
    }
    xcd_barrier(bar);

    {
        pg8::Gemm g{xb, W1T, SEQ, 3072, 1024}; pg8::StaticOrder S; S.init(SEQ, 3072, G, bx);
        pg8::Epi1 E{Pgm, Pqkv, Pz, r1, bias1};
        pg8::gemm_phase<pg8::Epi1, pg8::StaticOrder, true, true>(lds, g, S, E);
    }
    xcd_barrier(bar);

    {
        PH_IDS;
        LAS float* rn = ldsf;
        LAS float* V = ldsf + 128;
        for (int it = bx; it < 1024; it += G) {
            const int n = it >> 3, h = it & 7, t0 = n * 128;
            for (int s = wave; s < 128; s += NWAVES) {
                const bf16* pr = Pgm + (size_t)(t0 + s) * 1024 + 512;
                float ss = 0.f;
                for (int j = lane; j < 512; j += 64) { const float gq = bf2f(pr[j]); ss += gq * gq; }
                ss = wave_sum(ss);
                if (lane == 0) rn[s] = __builtin_amdgcn_rsqf(ss * (1.f / 512.f) + 1e-6f);
            }
            __syncthreads();
            for (int i = tid; i < 128 * 64; i += NT) { const int s = i >> 6, d = i & 63; V[s * 65 + d] = bf2f(Pgm[(size_t)(t0 + s) * 1024 + 512 + h * 64 + d]) * rn[s] * A.gm_norm_w[h * 64 + d]; }
            __syncthreads();
            const int d = tid & 63, tg = tid >> 6;
            for (int i = 0; i < 16; ++i) {
                const int t = tg + 8 * i;
                const float* wr = A.gm_ws + ((size_t)h * 128 + t) * 128;
                float acc = 0.f;
                for (int s = 0; s <= t; ++s) acc += wr[s] * V[s * 65 + d];
                acc += A.gm_bs[h * 128 + t];
                const float u = bf2f(Pgm[(size_t)(t0 + t) * 1024 + h * 64 + d]);
                mixb[(size_t)(t0 + t) * 1024 + h * 64 + d] = (bf16)f2bf(u * acc);
            }
            __syncthreads();
        }
        dn_prep(lds, bx, G, otid(), Pqkv, pab, A.conv_w, A.a_log, A.dt_bias, Wc, KdT, Uc, Qd, At, glb);
    }
    xcd_barrier(bar);

    if (bx < 8) dn_scan(lds, bx, otid(), Wc, KdT, Uc, glb, Sbuf, Vbuf);
    {
        PH_IDS;
        const int cb = (G > 8) ? bx - 8 : bx, ncb = (G > 8) ? G - 8 : G;
        if (cb >= 0) for (int it = cb * NWAVES + wave; it < 2 * 16384; it += ncb * NWAVES) {
            if (it < 16384) uv_convert_row(A.peer_u, ws + WS_UB, it, lane); else uv_convert_row(A.peer_v, ws + WS_VB, it - 16384, lane);
        }
    }
    xcd_barrier(bar);

    dn_out(lds, bx, G, otid(), Qd, At, Sbuf, Vbuf, Pz, A.o_norm_w, mixb);
    xcd_barrier(bar);

    {
        pg8::Gemm g{mixb, W2T, SEQ, 1024, 1024}; pg8::StaticOrder S; S.init(SEQ, 1024, G, bx);
        pg8::Epi2 E{A.x, A.out, x1b, mod + 2048, rss2, SEQ};
        pg8::gemm_phase<pg8::Epi2, pg8::StaticOrder, true, true>(lds, g, S, E);
    }
    xcd_barrier(bar);

    {
        pg8::Gemm g{x1b, W3T, SEQ, 2048, 1024}; pg8::StaticOrder S; S.init(SEQ, 2048, G, bx);
        pg8::Epi3 E{qq, rss2, bias3, SEQ};
        pg8::gemm_phase<pg8::Epi3, pg8::StaticOrder, true, true>(lds, g, S, E);
    }
    xcd_barrier(bar);

    {
        PH_IDS;
        for (int row = gw; row < SEQ; row += NGW) {
            const float rs = (lane < 16) ? rss2[(size_t)lane * SEQ + row] : 0.f;
            const float r = __builtin_amdgcn_rsqf(wave_sum(rs) * (1.f / 1024.f) + 1e-6f);
            if (lane == 0) r1[row] = r;
        }
        route_phase(lds, bx, G, tid, qq, K1b, K2b, ids, gates);
    }
    xcd_barrier(bar);

    {
    PH_IDS;
    XcdMap XM;
    {
        int np = 0, px = 0, nloc = 1;
#pragma unroll
        for (int j = 0; j < 16; ++j) { const unsigned c = xb_ld(&bar.bar[XB_XCNT(j)]); if (c > 0u) { if (j < (int)bar.x) ++px; ++np; } if (j == (int)bar.x) nloc = (int)c; }
        XM.rank = (int)bar.st[2]; XM.nloc = nloc > 0 ? nloc : 1; XM.px = px; XM.np = np > 0 ? np : 1;
    }
    peer_pre(XM, tid, ws, ws + WS_UB, A.out, r1, mod, A.norm2_w, ids);
    xcd_barrier(bar);

    for (int idx = bx * NT + tid; idx < SEQ * 128 / 4; idx += G * NT) {
        f32x4 sacc = {0.f, 0.f, 0.f, 0.f};
#pragma unroll
        for (int c = 0; c < 16; ++c) sacc += *(const f32x4*)(pre_slab(ws, c) + (size_t)idx * 4);
        const f32x4 gt = *(const f32x4*)(gates + (size_t)idx * 4);
        f32x4 o; o.x = gt.x * gelu_f(sacc.x); o.y = gt.y * gelu_f(sacc.y); o.z = gt.z * gelu_f(sacc.z); o.w = gt.w * gelu_f(sacc.w);
        *(f32x4*)(gates + (size_t)idx * 4) = o;
    }
    xcd_barrier(bar);

    peer_out(XM, tid, ws + WS_VB, A.out, mod, ids, gates, rss2);
    xcd_barrier(bar);

    for (int row = gw; row < SEQ; row += NGW) {
        const float rs = (lane < 16) ? rss2[(size_t)lane * SEQ + row] : 0.f;
        const float rn = __builtin_amdgcn_rsqf(wave_sum(rs) * (1.f / 1024.f) + 1e-6f);
        f32x4* o = (f32x4*)(A.out + (size_t)row * 1024) + lane; const f32x4* fw = (const f32x4*)A.final_w + lane;
#pragma unroll
        for (int j = 0; j < 4; ++j) o[64 * j] = o[64 * j] * rn * fw[64 * j];
    }
    }
}

extern "C" void kernel_launch(void* const* d_in, const int* in_sizes, int n_in, void* d_out, int out_size, void* d_ws, size_t ws_size, hipStream_t stream) {
    static int grid = 0;
    if (grid == 0) {
        if (n_in != 21 || in_sizes[0] != SEQ * DM || out_size != SEQ * DM || ws_size < WS_END) { fprintf(stderr, "kernel_launch: unexpected shapes (n_in %d, ws %zu); nothing launched\n", n_in, ws_size); grid = -1; return; }
        int dev = 0, cus = 0, per_cu = 0;
        if (hipGetDevice(&dev) != hipSuccess || hipDeviceGetAttribute(&cus, hipDeviceAttributeMultiprocessorCount, dev) != hipSuccess) { grid = -1; return; }
        if (hipFuncSetAttribute((const void*)fwd_kernel, hipFuncAttributeMaxDynamicSharedMemorySize, LDS_BYTES) != hipSuccess) { fprintf(stderr, "kernel_launch: hipFuncSetAttribute failed\n"); grid = -1; return; }
        if (hipOccupancyMaxActiveBlocksPerMultiprocessor(&per_cu, (const void*)fwd_kernel, NT, LDS_BYTES) != hipSuccess || per_cu < 1) { fprintf(stderr, "kernel_launch: occupancy query says %d blocks per CU\n", per_cu); }
        (void)hipGetLastError();
        grid = cus;
    }
    if (grid < 0) return;
    (void)hipMemsetAsync((char*)d_ws + WS_CTL, 0, CTL_ZERO_BYTES, stream);
    Args a{};
    a.x = (const float*)d_in[0]; a.c = (const float*)d_in[1]; a.w_ada = (const float*)d_in[2]; a.b_ada = (const float*)d_in[3]; a.norm1_w = (const float*)d_in[4];
    a.w_in = (const float*)d_in[5]; a.gm_norm_w = (const float*)d_in[6]; a.gm_ws = (const float*)d_in[7]; a.gm_bs = (const float*)d_in[8]; a.conv_w = (const float*)d_in[9];
    a.a_log = (const float*)d_in[10]; a.dt_bias = (const float*)d_in[11]; a.o_norm_w = (const float*)d_in[12]; a.w_out = (const float*)d_in[13]; a.norm2_w = (const float*)d_in[14];
    a.peer_wq = (const float*)d_in[15]; a.keys1 = (const float*)d_in[16]; a.keys2 = (const float*)d_in[17]; a.peer_u = (const float*)d_in[18]; a.peer_v = (const float*)d_in[19];
    a.final_w = (const float*)d_in[20]; a.out = (float*)d_out; a.ws = (unsigned char*)d_ws;
    hipLaunchKernelGGL(fwd_kernel, dim3(grid), dim3(NT), LDS_BYTES, stream, a);
}
```

```cpp
#include <hip/hip_runtime.h>
#include <cstdio>
#include <cstdint>

namespace pg8 {
#define PG8_LAS __attribute__((address_space(3)))
typedef unsigned short bf16_t;
typedef short bf16x8 __attribute__((ext_vector_type(8)));
typedef float f32x4 __attribute__((ext_vector_type(4)));
typedef unsigned u32x4 __attribute__((ext_vector_type(4)));
constexpr int BM = 256, BK = 64, HALF = 128, HTB = HALF * BK * 2  , STAGE_BYTES = 8 * HTB, NXCD = 8, WGM = 8;

__host__ __device__ __forceinline__ int lds_byte(int r, int c) { const int st = (r >> 4) * 2 + (c >> 5), rr = r & 15, cc = c & 31, ob = rr * 64 + cc * 2; return st * 1024 + (ob ^ (((ob >> 9) & 1) << 5)); }
__host__ __device__ __forceinline__ void stage_rc(int b, int& R, int& C) { const int st = b / 1024, sb = b % 1024, swz = sb ^ (((sb >> 9) & 1) << 5); R = (st >> 1) * 16 + swz / 64; C = (st & 1) * 32 + (swz % 64) / 2; }
__host__ __device__ __forceinline__ int perm32(int rho) { const int n = rho >> 4, i = rho & 15; return 8 * (i >> 2) + 4 * n + (i & 3); }

struct Unit { int pm, pn; };
struct Gemm { const bf16_t* A; const bf16_t* Bt; int M, N, K; };

struct StaticOrder {
    int nM, nN, nwg, G, c;
    __host__ __device__ void init(int M, int N, int G_, int c_) { nM = M / BM; nN = N / BM; nwg = nM * nN; G = G_; c = c_; }
    __host__ __device__ bool next(int i, Unit& u) const {
        const long L = (long)i * G + c; if (L >= nwg) return false;
        int wgid = (int)L; { const int q = nwg / NXCD, r = nwg % NXCD, xcd = wgid % NXCD, off = wgid / NXCD; wgid = (xcd < r ? xcd * (q + 1) : r * (q + 1) + (xcd - r) * q) + off; }
        const int nig = WGM * nN, gid = wgid / nig, fm = gid * WGM, gsz = (nM - fm) < WGM ? (nM - fm) : WGM;
        u.pm = fm + ((wgid % nig) % gsz); u.pn = (wgid % nig) / gsz; return true;
    }
    __device__ __forceinline__ void a_ready(const Unit&) const {}
    __device__ __forceinline__ void done(const Unit&) const {}
};

__device__ __forceinline__ unsigned cvt_pk_bf16(float lo, float hi) { unsigned r; asm volatile("v_cvt_pk_bf16_f32 %0, %1, %2" : "=v"(r) : "v"(lo), "v"(hi)); return r; }


__device__ __forceinline__ float gelu_fast(float x) {
    const float y = x * (1.5957691216f + 0.0713548163f * x * x);
    return x * __builtin_amdgcn_rcpf(1.f + __builtin_amdgcn_exp2f(-1.4426950409f * y));
}
__device__ __forceinline__ float silu_fast(float x) { return x * __builtin_amdgcn_rcpf(1.f + __builtin_amdgcn_exp2f(-1.4426950409f * x)); }

struct Epi1 {
    static constexpr bool PERM = true, AFTER_DRAIN = false;
    bf16_t* Pgm; bf16_t* Pqkv; bf16_t* Pz; const float* r1; const float* bias1; float* vss; int M;
    __device__ __forceinline__ void operator()(const f32x4 (&acc)[2][2][4][2], const Unit& u, int wr, int wc, int fr, int fq) const {
        const int row0 = u.pm * BM + wr * 64 + fr, colt = u.pn * BM, cl = wc * 32 + 8 * fq;
        f32x4 bv[2][2];
#pragma unroll
        for (int bj = 0; bj < 2; ++bj)
#pragma unroll
            for (int n = 0; n < 2; ++n) bv[bj][n] = *(const f32x4*)(bias1 + colt + cl + bj * HALF + 4 * n);
        float rrv[2][4];
#pragma unroll
        for (int ai = 0; ai < 2; ++ai)
#pragma unroll
            for (int m = 0; m < 4; ++m) rrv[ai][m] = r1[row0 + ai * HALF + m * 16];
#pragma unroll
        for (int ai = 0; ai < 2; ++ai)
#pragma unroll
            for (int m = 0; m < 4; ++m) {
                const int row = row0 + ai * HALF + m * 16;
                const float rr = rrv[ai][m];
                float ssq = 0.f;
#pragma unroll
                for (int bj = 0; bj < 2; ++bj) {
                    f32x4 v0 = acc[ai][bj][m][0] * rr + bv[bj][0], v1 = acc[ai][bj][m][1] * rr + bv[bj][1];
                    const int col = colt + cl + bj * HALF;
                    bf16_t* dst;
                    if (u.pn < 4) {
#pragma unroll
                        for (int e = 0; e < 4; ++e) { v0[e] = gelu_fast(v0[e]); v1[e] = gelu_fast(v1[e]); }
                        ssq += (v0[0] * v0[0] + v0[1] * v0[1]) + (v0[2] * v0[2] + v0[3] * v0[3]) + (v1[0] * v1[0] + v1[1] * v1[1]) + (v1[2] * v1[2] + v1[3] * v1[3]);
                        dst = Pgm + (size_t)row * 1024 + col;
                    } else if (u.pn < 10) {
                        dst = Pqkv + (size_t)row * 1536 + (col - 1024);
                    } else {
#pragma unroll
                        for (int e = 0; e < 4; ++e) { v0[e] = silu_fast(v0[e]); v1[e] = silu_fast(v1[e]); }
                        dst = Pz + (size_t)row * 512 + (col - 2560);
                    }
                    u32x4 w; w.x = cvt_pk_bf16(v0[0], v0[1]); w.y = cvt_pk_bf16(v0[2], v0[3]); w.z = cvt_pk_bf16(v1[0], v1[1]); w.w = cvt_pk_bf16(v1[2], v1[3]);
                    *(u32x4*)dst = w;
                }
                if (u.pn == 2 || u.pn == 3) {
                    ssq += __shfl_xor(ssq, 16); ssq += __shfl_xor(ssq, 32);
                    if (fq == 0) vss[(size_t)((u.pn - 2) * 4 + wc) * M + row] = ssq;
                }
            }
    }
};

struct Epi2 {
    static constexpr bool PERM = true, AFTER_DRAIN = false;
    const float* x; bf16_t* x1u; bf16_t* x1b; const float* gt1; float* rss; int M; const float* a2;
    __device__ __forceinline__ void operator()(const f32x4 (&acc)[2][2][4][2], const Unit& u, int wr, int wc, int fr, int fq) const {
        const int row0 = u.pm * BM + wr * 64 + fr, colt = u.pn * BM, cl = wc * 32 + 8 * fq;
        f32x4 gv[2][2], av[2][2];
#pragma unroll
        for (int bj = 0; bj < 2; ++bj)
#pragma unroll
            for (int n = 0; n < 2; ++n) { gv[bj][n] = *(const f32x4*)(gt1 + colt + cl + bj * HALF + 4 * n); av[bj][n] = *(const f32x4*)(a2 + colt + cl + bj * HALF + 4 * n); }
#pragma unroll
        for (int aim = 0; aim < 4; ++aim) {
            const int ai = aim >> 1;
            f32x4 xin[2][2][2];
#pragma unroll
            for (int mm = 0; mm < 2; ++mm)
#pragma unroll
                for (int bj = 0; bj < 2; ++bj) { const float* xp = x + (size_t)(row0 + ai * HALF + ((aim & 1) * 2 + mm) * 16) * 1024 + colt + cl + bj * HALF; xin[mm][bj][0] = *(const f32x4*)xp; xin[mm][bj][1] = *(const f32x4*)(xp + 4); }
#pragma unroll
            for (int mm = 0; mm < 2; ++mm) {
                const int m = (aim & 1) * 2 + mm;
                const int row = row0 + ai * HALF + m * 16;
                float ssq = 0.f;
#pragma unroll
                for (int bj = 0; bj < 2; ++bj) {
                    const int col = colt + cl + bj * HALF;
                    const f32x4 x0 = xin[mm][bj][0], x1v = xin[mm][bj][1];
                    const f32x4 v0 = x0 + gv[bj][0] * acc[ai][bj][m][0], v1 = x1v + gv[bj][1] * acc[ai][bj][m][1];
                    { u32x4 wu; wu.x = cvt_pk_bf16(v0[0], v0[1]); wu.y = cvt_pk_bf16(v0[2], v0[3]); wu.z = cvt_pk_bf16(v1[0], v1[1]); wu.w = cvt_pk_bf16(v1[2], v1[3]); *(u32x4*)(x1u + (size_t)row * 1024 + col) = wu; }
                    const f32x4 s0 = v0 * av[bj][0], s1 = v1 * av[bj][1];
                    u32x4 w; w.x = cvt_pk_bf16(s0[0], s0[1]); w.y = cvt_pk_bf16(s0[2], s0[3]); w.z = cvt_pk_bf16(s1[0], s1[1]); w.w = cvt_pk_bf16(s1[2], s1[3]);
                    *(u32x4*)(x1b + (size_t)row * 1024 + col) = w;
                    ssq += (v0[0] * v0[0] + v0[1] * v0[1]) + (v0[2] * v0[2] + v0[3] * v0[3]) + (v1[0] * v1[0] + v1[1] * v1[1]) + (v1[2] * v1[2] + v1[3] * v1[3]);
                }
                ssq += __shfl_xor(ssq, 16); ssq += __shfl_xor(ssq, 32);
                if (fq == 0) rss[(size_t)(u.pn * 4 + wc) * M + row] = ssq;
            }
        }
    }
};

struct Epi3 {
    static constexpr bool PERM = true, AFTER_DRAIN = false;
    bf16_t* qq; const float* rss; const float* bias3; int M;
    __device__ __forceinline__ void operator()(const f32x4 (&acc)[2][2][4][2], const Unit& u, int wr, int wc, int fr, int fq) const {
        const int row0 = u.pm * BM + wr * 64 + fr, colt = u.pn * BM, cl = wc * 32 + 8 * fq;
        f32x4 bv[2][2];
#pragma unroll
        for (int bj = 0; bj < 2; ++bj)
#pragma unroll
            for (int n = 0; n < 2; ++n) bv[bj][n] = *(const f32x4*)(bias3 + colt + cl + bj * HALF + 4 * n);
        float rrv[2][4];
#pragma unroll
        for (int ai = 0; ai < 2; ++ai)
#pragma unroll
            for (int m = 0; m < 4; ++m) {
                const int row = row0 + ai * HALF + m * 16;
                float s = 0.f;
#pragma unroll
                for (int i = 0; i < 4; ++i) s += rss[(size_t)(fq * 4 + i) * M + row];
                rrv[ai][m] = s;
            }
#pragma unroll
        for (int ai = 0; ai < 2; ++ai)
#pragma unroll
            for (int m = 0; m < 4; ++m) {
                const int row = row0 + ai * HALF + m * 16;
                float s = rrv[ai][m];
                s += __shfl_xor(s, 16); s += __shfl_xor(s, 32);
                const float rr = __builtin_amdgcn_rsqf(s * (1.f / 1024.f) + 1e-6f);
#pragma unroll
                for (int bj = 0; bj < 2; ++bj) {
                    const f32x4 v0 = acc[ai][bj][m][0] * rr + bv[bj][0], v1 = acc[ai][bj][m][1] * rr + bv[bj][1];
                    const int col = colt + cl + bj * HALF;
                    u32x4 w; w.x = cvt_pk_bf16(v0[0], v0[1]); w.y = cvt_pk_bf16(v0[2], v0[3]); w.z = cvt_pk_bf16(v1[0], v1[1]); w.w = cvt_pk_bf16(v1[2], v1[3]);
                    *(u32x4*)(qq + (size_t)row * 2048 + col) = w;
                }
            }
    }
};

template <class Epi, class Sched, bool ALIGN_EPI = false, bool SP2 = false>
__device__ __forceinline__ void gemm_phase(PG8_LAS unsigned char* lds, const Gemm g, const Sched& S, const Epi& E, const int tid_in) {
    const int tid = tid_in, wid = __builtin_amdgcn_readfirstlane(tid >> 6), lane = tid & 63, wr = wid >> 2, wc = wid & 3, fr = lane & 15, fq = lane >> 4;
    const int K = g.K, nt = K / BK;
    unsigned voffA[2], voffB[2];
#pragma unroll
    for (int i = 0; i < 2; ++i) { int R, C; stage_rc(tid * 16 + i * 8192, R, C); const int Rb = Epi::PERM ? ((R & ~31) + perm32(R & 31)) : R;
        voffA[i] = (unsigned)(R * K + C) * 2u; voffB[i] = (unsigned)(Rb * K + C) * 2u; }
    const size_t kstep = (size_t)(BK * 2);
    const size_t hstep = (size_t)HALF * K * 2;
    const size_t tstep = 2 * hstep;
    const unsigned ldsw = (unsigned)wid * 1024u;
    const int aoff = lds_byte(wr * 64 + fr, fq * 8), boff = lds_byte(wc * 32 + fr, fq * 8);
#define PG8_SA(b, h) (((b) * 2 + (h)) * HTB)
#define PG8_SB(b, h) ((4 + (b) * 2 + (h)) * HTB)
#define PG8_STAGE(bufoff, gbase, voff) do { _Pragma("unroll") for (int _i = 0; _i < 2; ++_i) \
        __builtin_amdgcn_global_load_lds((const unsigned*)((const char*)(gbase) + (voff)[_i]), (PG8_LAS unsigned*)(lds + (bufoff) + ldsw + _i * 8192), 16, 0, 0); } while (0)
#define PG8_LDA(dst, b, h) do { _Pragma("unroll") for (int m = 0; m < 4; ++m) _Pragma("unroll") for (int k = 0; k < 2; ++k) dst[m][k] = *(const PG8_LAS bf16x8*)(lds + PG8_SA(b, h) + aoff + m * 2048 + k * 1024); } while (0)
#define PG8_LDB(dst, b, h) do { _Pragma("unroll") for (int n = 0; n < 2; ++n) _Pragma("unroll") for (int k = 0; k < 2; ++k) dst[n][k] = *(const PG8_LAS bf16x8*)(lds + PG8_SB(b, h) + boff + n * 2048 + k * 1024); } while (0)
#define PG8_MMA(ai, bj, At, Bt) do { __builtin_amdgcn_s_setprio(1); _Pragma("unroll") for (int m = 0; m < 4; ++m) _Pragma("unroll") for (int n = 0; n < 2; ++n) _Pragma("unroll") for (int k = 0; k < 2; ++k) \
        acc[ai][bj][m][n] = __builtin_amdgcn_mfma_f32_16x16x32_bf16(Bt[n][k], At[m][k], acc[ai][bj][m][n], 0, 0, 0); __builtin_amdgcn_s_setprio(0); } while (0)
#define PG8_WAIT_V(n) asm volatile("s_waitcnt vmcnt(" #n ")" ::: "memory")
#define PG8_WAIT_L(n) asm volatile("s_waitcnt lgkmcnt(" #n ")" ::: "memory")
#define PG8_BAR __builtin_amdgcn_s_barrier()
#define PG8_SCHED __builtin_amdgcn_sched_barrier(0)
    Unit cur, nxt; int ui = 0;
    if (!S.next(0, cur)) return;
    f32x4 acc[2][2][4][2];
#pragma unroll
    for (int a = 0; a < 2; ++a)
#pragma unroll
        for (int b = 0; b < 2; ++b)
#pragma unroll
            for (int m = 0; m < 4; ++m)
#pragma unroll
                for (int n = 0; n < 2; ++n) acc[a][b][m][n] = (f32x4){0.f, 0.f, 0.f, 0.f};
    bf16x8 At[4][2], B0[2][2], B1[2][2];
    const char* cA = (const char*)g.A + (size_t)cur.pm * tstep; const char* cB = (const char*)g.Bt + (size_t)cur.pn * tstep;
    S.a_ready(cur);
    if constexpr (SP2) {
        PG8_STAGE(PG8_SB(0, 0), cB, voffB); PG8_STAGE(PG8_SB(0, 1), cB + hstep, voffB); PG8_STAGE(PG8_SA(0, 0), cA, voffA); PG8_STAGE(PG8_SA(0, 1), cA + hstep, voffA);
        if (wr == 1) PG8_BAR;
        PG8_WAIT_V(2); PG8_BAR;
        PG8_STAGE(PG8_SB(1, 0), cB + kstep, voffB); PG8_STAGE(PG8_SA(1, 0), cA + kstep, voffA); PG8_STAGE(PG8_SB(1, 1), cB + hstep + kstep, voffB);
        PG8_WAIT_V(6); PG8_BAR;
    } else {
        PG8_STAGE(PG8_SB(0, 0), cB, voffB); PG8_STAGE(PG8_SA(0, 0), cA, voffA); PG8_STAGE(PG8_SB(0, 1), cB + hstep, voffB); PG8_STAGE(PG8_SA(0, 1), cA + hstep, voffA);
        if (wr == 1) PG8_BAR;
        PG8_WAIT_V(4); PG8_BAR;
        PG8_STAGE(PG8_SB(1, 0), cB + kstep, voffB); PG8_STAGE(PG8_SA(1, 0), cA + kstep, voffA); PG8_STAGE(PG8_SB(1, 1), cB + hstep + kstep, voffB);
        PG8_WAIT_V(6); PG8_BAR;
    }
    for (;;) {
        const bool has_next = S.next(ui + 1, nxt);
        const char* nA = has_next ? (const char*)g.A + (size_t)nxt.pm * tstep : cA; const char* nB = has_next ? (const char*)g.Bt + (size_t)nxt.pn * tstep : cB;
        for (int t = 0; t < nt; t += 2) {
            const bool last = (t == nt - 2);
            const char* a1 = cA + (size_t)(t + 1) * kstep;
            const char* a2 = last ? nA : cA + (size_t)(t + 2) * kstep; const char* b2 = last ? nB : cB + (size_t)(t + 2) * kstep;
            const char* a3 = a2 + kstep; const char* b3 = b2 + kstep;
            if (last && has_next) S.a_ready(nxt);
            if constexpr (SP2) {
            PG8_LDB(B0, 0, 0); PG8_LDB(B1, 0, 1); PG8_SCHED; PG8_LDA(At, 0, 0); PG8_STAGE(PG8_SA(1, 1), a1 + hstep, voffA);
            PG8_WAIT_V(8); PG8_WAIT_L(0); PG8_BAR; PG8_MMA(0, 0, At, B0); PG8_MMA(0, 1, At, B1); PG8_BAR; PG8_SCHED;
            PG8_LDA(At, 0, 1); PG8_STAGE(PG8_SB(0, 0), b2, voffB); PG8_STAGE(PG8_SB(0, 1), b2 + hstep, voffB); PG8_STAGE(PG8_SA(0, 0), a2, voffA);
            PG8_WAIT_V(8); PG8_WAIT_L(0); PG8_BAR; PG8_MMA(1, 0, At, B0); PG8_MMA(1, 1, At, B1); PG8_BAR; PG8_SCHED;
            PG8_LDB(B0, 1, 0); PG8_LDB(B1, 1, 1); PG8_SCHED; PG8_LDA(At, 1, 0); PG8_STAGE(PG8_SA(0, 1), a2 + hstep, voffA);
            PG8_WAIT_V(8); PG8_WAIT_L(0); PG8_BAR; PG8_MMA(0, 0, At, B0); PG8_MMA(0, 1, At, B1); PG8_BAR; PG8_SCHED;
            PG8_LDA(At, 1, 1); PG8_STAGE(PG8_SB(1, 0), b3, voffB); PG8_STAGE(PG8_SB(1, 1), b3 + hstep, voffB); PG8_STAGE(PG8_SA(1, 0), a3, voffA);
            PG8_WAIT_V(8); PG8_WAIT_L(0); PG8_BAR; PG8_MMA(1, 0, At, B0); PG8_MMA(1, 1, At, B1); PG8_BAR; PG8_SCHED;
            } else {
            PG8_LDB(B0, 0, 0); PG8_SCHED; PG8_LDA(At, 0, 0); PG8_STAGE(PG8_SA(1, 1), a1 + hstep, voffA);
            PG8_WAIT_L(8); PG8_BAR; PG8_WAIT_L(0); PG8_MMA(0, 0, At, B0); PG8_BAR; PG8_SCHED;
            PG8_LDB(B1, 0, 1); PG8_STAGE(PG8_SB(0, 0), b2, voffB);
            PG8_BAR; PG8_WAIT_L(0); PG8_MMA(0, 1, At, B1); PG8_BAR;
            PG8_LDA(At, 0, 1); PG8_STAGE(PG8_SA(0, 0), a2, voffA);
            PG8_BAR; PG8_WAIT_L(0); PG8_MMA(1, 0, At, B0); PG8_BAR; PG8_SCHED;
            PG8_STAGE(PG8_SB(0, 1), b2 + hstep, voffB);
            PG8_WAIT_V(6); PG8_BAR; PG8_MMA(1, 1, At, B1); PG8_BAR;
            PG8_LDB(B0, 1, 0); PG8_SCHED; PG8_LDA(At, 1, 0); PG8_STAGE(PG8_SA(0, 1), a2 + hstep, voffA);
            PG8_WAIT_L(8); PG8_BAR; PG8_WAIT_L(0); PG8_MMA(0, 0, At, B0); PG8_BAR; PG8_SCHED;
            PG8_LDB(B1, 1, 1); PG8_STAGE(PG8_SB(1, 0), b3, voffB);
            PG8_BAR; PG8_WAIT_L(0); PG8_MMA(0, 1, At, B1); PG8_BAR;
            PG8_LDA(At, 1, 1); PG8_STAGE(PG8_SA(1, 0), a3, voffA);
            PG8_BAR; PG8_WAIT_L(0); PG8_MMA(1, 0, At, B0); PG8_BAR; PG8_SCHED;
            PG8_STAGE(PG8_SB(1, 1), b3 + hstep, voffB);
            PG8_WAIT_V(6); PG8_BAR; PG8_MMA(1, 1, At, B1); PG8_BAR;
            }
        }
        if constexpr (ALIGN_EPI) { if (wr == 0) PG8_BAR; }
        if constexpr (!Epi::AFTER_DRAIN) { E(acc, cur, wr, wc, fr, fq); S.done(cur); }
        if (!has_next) break;
#pragma unroll
        for (int a = 0; a < 2; ++a)
#pragma unroll
            for (int b = 0; b < 2; ++b)
#pragma unroll
                for (int m = 0; m < 4; ++m)
#pragma unroll
                    for (int n = 0; n < 2; ++n) acc[a][b][m][n] = (f32x4){0.f, 0.f, 0.f, 0.f};
        cur = nxt; cA = nA; cB = nB; ++ui;
        if constexpr (ALIGN_EPI) { if (wr == 1) PG8_BAR; }
    }
    PG8_WAIT_V(0);
    if constexpr (!ALIGN_EPI) { if (wr == 0) PG8_BAR; }
    PG8_BAR;
    if constexpr (Epi::AFTER_DRAIN) { E.fused(acc, cur, wr, wc, fr, fq, lds, wid, lane); S.done(cur); }
#undef PG8_SA
#undef PG8_SB
#undef PG8_STAGE
#undef PG8_LDA
#undef PG8_LDB
#undef PG8_MMA
#undef PG8_WAIT_V
#undef PG8_WAIT_L
#undef PG8_BAR
#undef PG8_SCHED
}
}


#define GAS __attribute__((address_space(1)))
#define LAS __attribute__((address_space(3)))
typedef unsigned short bf16;
typedef unsigned v4u __attribute__((ext_vector_type(4)));
typedef float f32x4 __attribute__((ext_vector_type(4)));
#define LDS_WAIT() asm volatile("s_waitcnt lgkmcnt(0)" ::: "memory")
#define VM_WAIT() asm volatile("s_waitcnt vmcnt(0)" ::: "memory")
__device__ __forceinline__ unsigned f2bf(float f) { unsigned u = __builtin_bit_cast(unsigned, f); return (u + 0x7fffu + ((u >> 16) & 1u)) >> 16; }
__device__ __forceinline__ unsigned pk2(float lo, float hi) { return f2bf(lo) | (f2bf(hi) << 16); }
__device__ __forceinline__ float bf2f(unsigned h) { return __builtin_bit_cast(float, h << 16); }
__device__ __forceinline__ float bflo(unsigned w) { return __builtin_bit_cast(float, w << 16); }
__device__ __forceinline__ float bfhi(unsigned w) { return __builtin_bit_cast(float, w & 0xffff0000u); }
__device__ __forceinline__ float wave_sum(float v) {
#pragma unroll
    for (int o = 32; o > 0; o >>= 1) v += __shfl_xor(v, o);
    return v;
}
__device__ __forceinline__ float gelu_f(float x) { return pg8::gelu_fast(x); }
__device__ __forceinline__ float silu_f(float x) { return x / (1.f + __expf(-x)); }

#define XB_TMO      128
#define XB_XCNT(j)  (256  + 64 * (j))
#define XB_XSUB(j)  (1280 + 64 * (j))
#define XB_XGEN(j)  (2304 + 64 * (j))
#define XB_TOP      3328
#define XB_TOPGEN   3392
#define XCD_BAR_WORDS 3456
#define XB_SPIN_CAP (1u << 24)

__device__ __forceinline__ unsigned xb_ld(unsigned* p)              { return __hip_atomic_load(p, __ATOMIC_RELAXED, __HIP_MEMORY_SCOPE_AGENT); }
__device__ __forceinline__ unsigned xb_add(unsigned* p, unsigned v) { return __hip_atomic_fetch_add(p, v, __ATOMIC_RELAXED, __HIP_MEMORY_SCOPE_AGENT); }
__device__ __forceinline__ unsigned xb_xcc_id() { return (unsigned)__builtin_amdgcn_s_getreg((3 << 11) | 20) & 0xFu; }
#define XB_SPIN(cond, bar) do { unsigned _sp = 0; while (cond) { __builtin_amdgcn_s_sleep(1); \
    if ((++_sp & 255u) == 0u) { if (xb_ld(&(bar)[XB_TMO])) break; if (_sp > XB_SPIN_CAP) { atomicAdd(&(bar)[XB_TMO], 1u); break; } } } } while (0)

struct XcdBarrier {
    unsigned* bar; unsigned x; int w;
    volatile LAS unsigned* st;
};

__device__ __forceinline__ XcdBarrier xcd_barrier_post(unsigned* bar, volatile LAS unsigned* st) {
    XcdBarrier b; b.bar = bar; b.x = xb_xcc_id(); b.st = st;
    if (threadIdx.x == 0) (void)xb_add(&bar[XB_XCNT(b.x)], 1u);
    return b;
}
__device__ __forceinline__ void xcd_barrier_complete(unsigned* bar, unsigned x, unsigned& nloc, unsigned& nx) {
    const unsigned G = gridDim.x * gridDim.y * gridDim.z;
    unsigned sum, cnt, mine, sp = 0u;
    for (;;) {
        sum = 0u; cnt = 0u; mine = 0u;
#pragma unroll
        for (unsigned j = 0; j < 16; ++j) { const unsigned c = xb_ld(&bar[XB_XCNT(j)]); sum += c; cnt += (c > 0u) ? 1u : 0u; mine = (j == x) ? c : mine; }
        if (sum == G) break;
        __builtin_amdgcn_s_sleep(1);
        if ((++sp & 255u) == 0u) { if (xb_ld(&bar[XB_TMO])) break; if (sp > XB_SPIN_CAP) { atomicAdd(&bar[XB_TMO], 1u); break; } }
    }
    nloc = mine > 0u ? mine : 1u; nx = cnt > 0u ? cnt : 1u;
}

__device__ __forceinline__ void xcd_barrier(const XcdBarrier& b) {
    asm volatile("s_waitcnt vmcnt(0)" ::: "memory");
    __syncthreads();
    if (b.w == 1 && __builtin_amdgcn_mbcnt_hi(~0u, __builtin_amdgcn_mbcnt_lo(~0u, 0u)) == 0u) asm volatile("buffer_inv sc1\n\ts_waitcnt vmcnt(0)" ::: "memory");
    if (b.w == 0 && __builtin_amdgcn_mbcnt_hi(~0u, __builtin_amdgcn_mbcnt_lo(~0u, 0u)) == 0u) {
        unsigned* bar = b.bar;
        __builtin_amdgcn_s_waitcnt(0);
        unsigned nloc = b.st[0], nx = b.st[1];
        if (nloc == 0u) { xcd_barrier_complete(bar, b.x, nloc, nx); b.st[0] = nloc; b.st[1] = nx; }
        const unsigned old = xb_add(&bar[XB_XSUB(b.x)], 1u);
        const unsigned gen = old / nloc;
        if (old + 1u == (gen + 1u) * nloc) {
            __builtin_amdgcn_fence(__ATOMIC_RELEASE, "agent");
            asm volatile("s_waitcnt vmcnt(0)" ::: "memory");
            const unsigned og = xb_add(&bar[XB_TOP], 1u);
            const unsigned tg = og / nx;
            if (og + 1u == (tg + 1u) * nx) xb_add(&bar[XB_TOPGEN], 1u);
            else XB_SPIN(xb_ld(&bar[XB_TOPGEN]) == tg, bar);
            xb_add(&bar[XB_XGEN(b.x)], 1u);
        } else {
            XB_SPIN(xb_ld(&bar[XB_XGEN(b.x)]) == gen, bar);
        }
    }
    __syncthreads();
}


constexpr int TS_A = -1, TS_B = -1, TS_T1 = 100, TS_T2 = 200;
constexpr int REP_GEMM1 = 1, REP_GMLP = 1, REP_DNPREP = 1, REP_SCAN = 1, REP_DNOUT = 1, REP_GEMM3 = 1, REP_ROUTE = 1, REP_PRE = 1, REP_CONV = 1, REP_P0 = 1, REP_P1 = 1, REP_OUT = 1, REP_P10 = 1, REP_BAR = 0, BARV = 0;
constexpr int SEQ = 16384, DM = 1024, DIN = 3080, NWAVES = 8, NT = 512;
constexpr size_t KiB = 1024, MiB = 1u << 20;
constexpr size_t WS_CTL = 0, CTL_ZERO_BYTES = 64 * KiB;
constexpr size_t WS_MOD = 64 * KiB, WS_A2 = 88 * KiB  , WS_BIAS1 = 96 * KiB, WS_BIAS3 = 112 * KiB, WS_R1 = 128 * KiB, WS_RSS2 = 192 * KiB  , WS_G = 1280 * KiB, WS_BETA = 1536 * KiB, WS_PAB = 1792 * KiB;
constexpr size_t WS_W1T = 3 * MiB, WS_W2T = 9 * MiB, WS_W3T = 11 * MiB, WS_K1B = 15 * MiB, WS_K2B = 15 * MiB + 256 * KiB, WS_GWB = 15 * MiB + 512 * KiB;
constexpr size_t WS_XB = 16 * MiB;
constexpr size_t WS_PGM = 48 * MiB;
constexpr size_t WS_PQKV = 80 * MiB;
constexpr size_t WS_PZ = 128 * MiB;
constexpr size_t WS_WC = 144 * MiB, WS_KDT = 160 * MiB, WS_UC = 176 * MiB, WS_QD = 192 * MiB, WS_AT = 208 * MiB;
constexpr size_t WS_UB = 96 * MiB, WS_VB = 112 * MiB;
constexpr size_t WS_SLAB = 128 * MiB, WS_X2 = 128 * MiB;
constexpr size_t WS_PHI = 216 * MiB, WS_SL = 220 * MiB, WS_SS = 224 * MiB;
constexpr size_t WS_SCU = 2304 * KiB, WS_SCV = 2368 * KiB;
constexpr size_t WS_IDS = 48 * MiB, WS_GATES = 56 * MiB, WS_COEF = 248 * MiB, WS_END = 256 * MiB;
constexpr int LDS_BYTES = 147456, LDSCTL_OFF = 146944, MISC_OFF = LDSCTL_OFF + 64;

struct Args {
    const float *x, *c, *w_ada, *b_ada, *norm1_w, *w_in, *gm_norm_w, *gm_ws, *gm_bs, *conv_w, *a_log, *dt_bias, *o_norm_w, *w_out, *norm2_w, *peer_wq, *keys1, *keys2, *peer_u, *peer_v, *final_w;
    float* out; unsigned char* ws;
};

template <int NC>
__device__ __forceinline__ void gemv_item(const LAS float* vec, const float* W, int ldw, int col0, int ncols, float* out, const float* addb, LAS float* part, int tid) {
    constexpr int KG = 512 / NC, KL = 1024 / KG;
    const int c = tid & (NC - 1), kg = tid / NC, col = col0 + c;
    float acc = 0.f;
    if (col < ncols) {
        const float* wp = W + (size_t)(kg * KL) * ldw + col;
#pragma unroll 32
        for (int k = 0; k < KL; ++k) acc += vec[kg * KL + k] * wp[(size_t)k * ldw];
    }
    part[kg * NC + c] = acc;
    __syncthreads();
    if (tid < NC && col < ncols) {
        float s = 0.f;
#pragma unroll
        for (int g = 0; g < KG; ++g) s += part[g * NC + c];
        out[col] = s + (addb ? addb[col] : 0.f);
    }
    __syncthreads();
}
__device__ __forceinline__ void transpose_item(const float* W, int ldw, int K, int nblk, bf16* WT, LAS float* scr, int item, int lane, const float* nw, const float* sc) {
    const int kb = item / nblk, nb = item % nblk, k0 = 64 * kb, n0 = 32 * nb;
#pragma unroll 16
    for (int i = 0; i < 32; ++i) {
        const int kk = 2 * i + (lane >> 5);
        float s = 1.f;
        if (nw) s = nw[k0 + kk] * (1.f + sc[k0 + kk]);
        scr[kk * 33 + (lane & 31)] = W[(size_t)(k0 + kk) * ldw + n0 + (lane & 31)] * s;
    }
    LDS_WAIT(); asm volatile("" ::: "memory");
    const int c = lane & 7;
#pragma unroll
    for (int j = 0; j < 4; ++j) {
        const int n = (lane >> 3) + 8 * j; const LAS float* s = scr + (8 * c) * 33 + n;
        v4u o; o.x = pk2(s[0 * 33], s[1 * 33]); o.y = pk2(s[2 * 33], s[3 * 33]); o.z = pk2(s[4 * 33], s[5 * 33]); o.w = pk2(s[6 * 33], s[7 * 33]);
        *(v4u*)(WT + (size_t)(n0 + n) * K + k0 + 8 * c) = o;
    }
    LDS_WAIT(); asm volatile("" ::: "memory");
}

typedef short s16x8 __attribute__((ext_vector_type(8)));
typedef unsigned short u16;
__device__ __forceinline__ unsigned cvtpk(float lo, float hi) { return pg8::cvt_pk_bf16(lo, hi); }
typedef float dn_f32x2 __attribute__((ext_vector_type(2)));
typedef __bf16 dn_bf16x2 __attribute__((ext_vector_type(2)));
__device__ __forceinline__ unsigned cvtpk_c(float lo, float hi) { const dn_f32x2 v = {lo, hi}; return __builtin_bit_cast(unsigned, __builtin_convertvector(v, dn_bf16x2)); }
__device__ __forceinline__ s16x8 pack8(const f32x4 a, const f32x4 b) {
    v4u w; w.x = cvtpk(a[0], a[1]); w.y = cvtpk(a[2], a[3]); w.z = cvtpk(b[0], b[1]); w.w = cvtpk(b[2], b[3]);
    return __builtin_bit_cast(s16x8, w);
}
#define MFMA16(a, b, c) __builtin_amdgcn_mfma_f32_16x16x32_bf16((a), (b), (c), 0, 0, 0)

constexpr int DNP_HALF_BYTES = 61440;
constexpr int DNP_QT = 0, DNP_KT = 17408, DNP_LM = 34816, DNP_AM = 51200, DNP_MISC = 60416, DNP_ROW = 272  , DNP_XROW = 528  ;

__device__ __forceinline__ void dn_prep(LAS unsigned char* lds, int bx, int G, int tid, const bf16* Pqkv, const float* pab, const float* conv_w, const float* a_log, const float* dt_bias,
                                        bf16* Wc, bf16* KdT, bf16* Uc, bf16* Qd, bf16* At, float* glb, unsigned long long* st) {
    const int lane0 = tid & 63, wave = tid >> 6, half = wave >> 2, hw = wave & 3, ht0 = tid & 255;
    const int niter = (1024 + 2 * G - 1) / (2 * G);
    for (int it = 0; it < niter; ++it) {
        int opq = 0; asm volatile("" : "+v"(opq));
        const int lane = lane0 + opq, ht = ht0 + opq;
        LAS unsigned char* L = lds + half * DNP_HALF_BYTES + opq;
        LAS float* Lm = (LAS float*)(L + DNP_LM);
        LAS float* gcs = (LAS float*)(L + DNP_MISC); LAS float* bts = gcs + 64; LAS float* egs = gcs + 128; LAS float* eks = gcs + 192;
        const int u = (it * G + bx) * 2 + half;
        const bool active = u < 1024;
        const int n = u >> 2, h = u & 3, t0 = n * 64, ui = h * 256 + n;
        float X[64]; float xm3 = 0.f, xm2 = 0.f, xm1 = 0.f;
        if (active) {
            const int i0 = 16 * hw;
            const int chq = h * 128 + 2 * lane, chk = 512 + h * 128 + 2 * lane;
            float wq0[4], wq1[4], wk0[4], wk1[4];
#pragma unroll
            for (int j = 0; j < 4; ++j) { wq0[j] = conv_w[j * 1536 + chq]; wq1[j] = conv_w[j * 1536 + chq + 1]; wk0[j] = conv_w[j * 1536 + chk]; wk1[j] = conv_w[j * 1536 + chk + 1]; }
            unsigned xq[19], xk[19];
#pragma unroll
            for (int r = 0; r < 19; ++r) {
                const int tt = t0 + i0 - 3 + r;
                xq[r] = 0u; xk[r] = 0u;
                if (tt >= 0) { xq[r] = *(const unsigned*)(Pqkv + (size_t)tt * 1536 + chq); xk[r] = *(const unsigned*)(Pqkv + (size_t)tt * 1536 + chk); }
            }
            if (ht < 128) {
                const int chv = 1024 + h * 128 + ht;
                xm3 = xm2 = xm1 = 0.f;
                if (t0 > 0) { xm3 = bf2f(Pqkv[(size_t)(t0 - 3) * 1536 + chv]); xm2 = bf2f(Pqkv[(size_t)(t0 - 2) * 1536 + chv]); xm1 = bf2f(Pqkv[(size_t)(t0 - 1) * 1536 + chv]); }
#pragma unroll
                for (int i = 0; i < 64; ++i) X[i] = bf2f(Pqkv[(size_t)(t0 + i) * 1536 + chv]);
            }
#pragma unroll
            for (int r = 0; r < 16; ++r) {
                float q0 = 0.f, q1 = 0.f, k0 = 0.f, k1 = 0.f;
#pragma unroll
                for (int j = 0; j < 4; ++j) { q0 += wq0[j] * bflo(xq[r + j]); q1 += wq1[j] * bfhi(xq[r + j]); k0 += wk0[j] * bflo(xk[r + j]); k1 += wk1[j] * bfhi(xk[r + j]); }
                q0 = silu_f(q0); q1 = silu_f(q1); k0 = silu_f(k0); k1 = silu_f(k1);
                *(LAS unsigned*)(L + DNP_QT + (i0 + r) * DNP_ROW + lane * 4) = cvtpk(q0, q1);
                *(LAS unsigned*)(L + DNP_KT + (i0 + r) * DNP_ROW + lane * 4) = cvtpk(k0, k1);
            }
            if (hw == 0) {
                const float a = pab[(size_t)(t0 + lane) * 8 + h], b = pab[(size_t)(t0 + lane) * 8 + 4 + h];
                const float xx = a + dt_bias[h];
                const float sp = xx > 20.f ? xx : log1pf(__expf(xx));
                const float g = -__expf(a_log[h]) * sp;
                float gc = g;
#pragma unroll
                for (int off = 1; off < 64; off <<= 1) { const float tq = __shfl_up(gc, off); if (lane >= off) gc += tq; }
                const float glast = __shfl(gc, 63);
                gcs[lane] = gc; bts[lane] = 1.f / (1.f + __expf(-b)); egs[lane] = __expf(gc); eks[lane] = __expf(glast - gc);
                if (lane == 63) glb[ui] = __expf(gc);
            }
        }
        if (st && it == 0 && bx == 0 && tid == 0) st[21] = __builtin_amdgcn_s_memrealtime();
        __syncthreads();
        LAS float* rks = (LAS float*)(lds + 131072 + half * 512); LAS float* rqs = rks + 64;
        if (active) {
            const int mt = hw, fr = lane & 15, g = lane >> 4;
            s16x8 Ka[4], Qa[4];
#pragma unroll
            for (int s = 0; s < 4; ++s) {
                Ka[s] = *(const LAS s16x8*)(L + DNP_KT + (16 * mt + fr) * DNP_ROW + (32 * s + 8 * g) * 2);
                Qa[s] = *(const LAS s16x8*)(L + DNP_QT + (16 * mt + fr) * DNP_ROW + (32 * s + 8 * g) * 2);
            }
            f32x4 dK = {0.f, 0.f, 0.f, 0.f}, dQ = {0.f, 0.f, 0.f, 0.f};
#pragma unroll
            for (int s = 0; s < 4; ++s) { dK = MFMA16(Ka[s], Ka[s], dK); dQ = MFMA16(Qa[s], Qa[s], dQ); }
            if ((fr >> 2) == g) {
                const int r = fr & 3;
                const float sk = r == 0 ? dK[0] : r == 1 ? dK[1] : r == 2 ? dK[2] : dK[3], sq = r == 0 ? dQ[0] : r == 1 ? dQ[1] : r == 2 ? dQ[2] : dQ[3];
                rks[16 * mt + fr] = __builtin_amdgcn_rsqf(sk + 1e-6f);
                rqs[16 * mt + fr] = __builtin_amdgcn_rsqf(sq + 1e-6f) * 0.08838834764831845f;
            }
        }
        __syncthreads();
        if (active) {
            const int mt = hw, fr = lane & 15, g = lane >> 4;
            s16x8 Ka[4], Qa[4];
#pragma unroll
            for (int s = 0; s < 4; ++s) {
                Ka[s] = *(const LAS s16x8*)(L + DNP_KT + (16 * mt + fr) * DNP_ROW + (32 * s + 8 * g) * 2);
                Qa[s] = *(const LAS s16x8*)(L + DNP_QT + (16 * mt + fr) * DNP_ROW + (32 * s + 8 * g) * 2);
            }
#pragma unroll
            for (int nt = 0; nt < 4; ++nt) {
                const int j = 16 * nt + fr;
                if (nt <= mt) {
                    f32x4 aK = {0.f, 0.f, 0.f, 0.f}, aA = {0.f, 0.f, 0.f, 0.f};
#pragma unroll
                    for (int s = 0; s < 4; ++s) {
                        const s16x8 Kb = *(const LAS s16x8*)(L + DNP_KT + (16 * nt + fr) * DNP_ROW + (32 * s + 8 * g) * 2);
                        aK = MFMA16(Ka[s], Kb, aK); aA = MFMA16(Qa[s], Kb, aA);
                    }
                    const float gj = gcs[j], rkj = rks[j];
#pragma unroll
                    for (int r = 0; r < 4; ++r) {
                        const int i = 16 * mt + 4 * g + r;
                        const float dec = __expf(fminf(gcs[i] - gj, 0.f)) * rkj;
                        Lm[i * 64 + j] = (i > j) ? -(bts[i] * rks[i] * aK[r] * dec) : 0.f;
                        *(LAS u16*)(L + DNP_AM + i * 144 + j * 2) = (u16)f2bf((i >= j) ? aA[r] * rqs[i] * dec : 0.f);
                    }
                } else {
#pragma unroll
                    for (int r = 0; r < 4; ++r) { const int i = 16 * mt + 4 * g + r; *(LAS u16*)(L + DNP_AM + i * 144 + j * 2) = (u16)0; }
                }
            }
#pragma unroll
            for (int k = 0; k < 4; ++k) {
                const int p = k * 256 + ht, f = p >> 6, lp = p & 63, pm = f >> 2, ps = f & 3, i = 16 * pm + (lp & 15), gp = lp >> 4;
                const LAS unsigned char* src = L + DNP_QT + i * DNP_ROW + (32 * ps + 4 * gp) * 2;
                const unsigned long long lo = *(const LAS unsigned long long*)src, hi = *(const LAS unsigned long long*)(src + 32);
                const float e = egs[i] * rqs[i];
                v4u o;
                o.x = cvtpk(bflo((unsigned)lo) * e, bfhi((unsigned)lo) * e); o.y = cvtpk(bflo((unsigned)(lo >> 32)) * e, bfhi((unsigned)(lo >> 32)) * e);
                o.z = cvtpk(bflo((unsigned)hi) * e, bfhi((unsigned)hi) * e); o.w = cvtpk(bflo((unsigned)(hi >> 32)) * e, bfhi((unsigned)(hi >> 32)) * e);
                *(v4u*)((unsigned char*)Qd + (size_t)ui * 16384 + (size_t)p * 16) = o;
            }
#pragma unroll
            for (int k = 0; k < 4; ++k) {
                const int p = k * 256 + ht, f = p >> 6, lp = p & 63, pm = f >> 1, ps = f & 1, dk = 16 * pm + (lp & 15), gp = lp >> 4;
                float vv[8];
#pragma unroll
                for (int jj = 0; jj < 8; ++jj) { const int i = 32 * ps + 16 * (jj >> 2) + 4 * gp + (jj & 3); vv[jj] = bf2f(*(const LAS u16*)(L + DNP_KT + i * DNP_ROW + dk * 2)) * (eks[i] * rks[i]); }
                v4u o; o.x = cvtpk(vv[0], vv[1]); o.y = cvtpk(vv[2], vv[3]); o.z = cvtpk(vv[4], vv[5]); o.w = cvtpk(vv[6], vv[7]);
                *(v4u*)((unsigned char*)KdT + (size_t)ui * 16384 + (size_t)p * 16) = o;
            }
        }
        if (st && it == 0 && bx == 0 && tid == 0) st[22] = __builtin_amdgcn_s_memrealtime();
        __syncthreads();
        if (active) {
            const int c = ht;
            if (c < 128) {
                const int ch = 1024 + h * 128 + c;
                float w0 = conv_w[ch], w1 = conv_w[1536 + ch], w2 = conv_w[2 * 1536 + ch], w3 = conv_w[3 * 1536 + ch];
#pragma unroll
                for (int i = 63; i >= 0; --i) {
                    const float a3 = X[i], a2 = (i >= 1) ? X[i - 1] : xm1, a1 = (i >= 2) ? X[i - 2] : ((i == 1) ? xm1 : xm2), a0 = (i >= 3) ? X[i - 3] : ((i == 2) ? xm1 : ((i == 1) ? xm2 : xm3));
                    X[i] = silu_f(w0 * a0 + w1 * a1 + w2 * a2 + w3 * a3) * bts[i];
                }
            } else {
                const int dk = c - 128;
#pragma unroll
                for (int i = 0; i < 64; ++i) X[i] = bf2f(*(const LAS u16*)(L + DNP_KT + i * DNP_ROW + dk * 2)) * (bts[i] * egs[i] * rks[i]);
            }
        }
        LAS float* Tm = (LAS float*)(lds + 2 * DNP_HALF_BYTES + half * 4096);
        if (active && ht < 64) {
            const int tb = ht >> 4, tc = ht & 15;
            float xt[16];
#pragma unroll
            for (int r = 0; r < 16; ++r) {
                float acc = (r == tc) ? 1.f : 0.f;
#pragma unroll
                for (int j = 0; j < r; ++j) acc += Lm[(16 * tb + r) * 64 + 16 * tb + j] * xt[j];
                xt[r] = acc;
            }
#pragma unroll
            for (int r = 0; r < 16; ++r) Tm[(tb * 16 + r) * 16 + tc] = xt[r];
        }
        if (st && it == 0 && bx == 0 && tid == 0) st[23] = __builtin_amdgcn_s_memrealtime();
        __syncthreads();
        if (active) {
            LAS unsigned char* rt = L + ht * 128;
#pragma unroll
            for (int q = 0; q < 8; ++q) {
                v4u o; o.x = cvtpk(X[8 * q], X[8 * q + 1]); o.y = cvtpk(X[8 * q + 2], X[8 * q + 3]); o.z = cvtpk(X[8 * q + 4], X[8 * q + 5]); o.w = cvtpk(X[8 * q + 6], X[8 * q + 7]);
                *(LAS v4u*)(rt + q * 16) = o;
            }
        }
        __syncthreads();
        f32x4 Xt[4][4];
        if (active) {
            const int fr = lane & 15, g = lane >> 4;
#pragma unroll
            for (int b4 = 0; b4 < 4; ++b4)
#pragma unroll
                for (int q = 0; q < 4; ++q) {
                    const unsigned long long w = *(const LAS unsigned long long*)(L + (64 * hw + 16 * q + fr) * 128 + (16 * b4 + 4 * g) * 2);
                    Xt[b4][q] = (f32x4){bflo((unsigned)w), bfhi((unsigned)w), bflo((unsigned)(w >> 32)), bfhi((unsigned)(w >> 32))};
                }
            typedef short s16x4 __attribute__((ext_vector_type(4)));
            s16x4 Xh[4][4], Xl[4][4];
#pragma unroll
            for (int b4 = 0; b4 < 4; ++b4) {
#pragma unroll
                for (int a4 = 0; a4 < b4; ++a4) {
                    float Lf[4];
#pragma unroll
                    for (int kk = 0; kk < 4; ++kk) Lf[kk] = Lm[(16 * b4 + fr) * 64 + 16 * a4 + 4 * g + kk];
                    const unsigned long long lw = (unsigned long long)cvtpk_c(Lf[0], Lf[1]) | ((unsigned long long)cvtpk_c(Lf[2], Lf[3]) << 32);
                    const s16x4 La = __builtin_bit_cast(s16x4, lw);
#pragma unroll
                    for (int q = 0; q < 4; ++q) {
                        Xt[b4][q] = __builtin_amdgcn_mfma_f32_16x16x16bf16_1k(La, Xh[a4][q], Xt[b4][q], 0, 0, 0);
                        Xt[b4][q] = __builtin_amdgcn_mfma_f32_16x16x16bf16_1k(La, Xl[a4][q], Xt[b4][q], 0, 0, 0);
                    }
                }
                float Tf[4];
#pragma unroll
                for (int kk = 0; kk < 4; ++kk) Tf[kk] = Tm[(b4 * 16 + fr) * 16 + 4 * g + kk];
                const unsigned long long tw = (unsigned long long)cvtpk_c(Tf[0], Tf[1]) | ((unsigned long long)cvtpk_c(Tf[2], Tf[3]) << 32);
                const s16x4 Ta = __builtin_bit_cast(s16x4, tw);
#pragma unroll
                for (int q = 0; q < 4; ++q) {
                    const f32x4 r = Xt[b4][q];
                    const unsigned h0 = cvtpk_c(r[0], r[1]), h1 = cvtpk_c(r[2], r[3]);
                    const unsigned l0 = cvtpk_c(r[0] - bflo(h0), r[1] - bfhi(h0)), l1 = cvtpk_c(r[2] - bflo(h1), r[3] - bfhi(h1));
                    const s16x4 rh = __builtin_bit_cast(s16x4, (unsigned long long)h0 | ((unsigned long long)h1 << 32)), rl = __builtin_bit_cast(s16x4, (unsigned long long)l0 | ((unsigned long long)l1 << 32));
                    f32x4 o = {0.f, 0.f, 0.f, 0.f};
                    o = __builtin_amdgcn_mfma_f32_16x16x16bf16_1k(Ta, rh, o, 0, 0, 0);
                    o = __builtin_amdgcn_mfma_f32_16x16x16bf16_1k(Ta, rl, o, 0, 0, 0);
                    Xt[b4][q] = o;
                    const unsigned g0 = cvtpk_c(o[0], o[1]), g1 = cvtpk_c(o[2], o[3]);
                    const unsigned m0 = cvtpk_c(o[0] - bflo(g0), o[1] - bfhi(g0)), m1 = cvtpk_c(o[2] - bflo(g1), o[3] - bfhi(g1));
                    Xh[b4][q] = __builtin_bit_cast(s16x4, (unsigned long long)g0 | ((unsigned long long)g1 << 32));
                    Xl[b4][q] = __builtin_bit_cast(s16x4, (unsigned long long)m0 | ((unsigned long long)m1 << 32));
                }
            }
        }
        __syncthreads();
        if (active) {
            const int fr = lane & 15, g = lane >> 4;
#pragma unroll
            for (int b4 = 0; b4 < 4; ++b4)
#pragma unroll
                for (int q = 0; q < 4; ++q)
#pragma unroll
                    for (int r = 0; r < 4; ++r) *(LAS u16*)(L + (16 * b4 + 4 * g + r) * DNP_XROW + (64 * hw + 16 * q + fr) * 2) = (u16)f2bf(Xt[b4][q][r]);
        }
        __syncthreads();
        if (active) {
#pragma unroll
            for (int k = 0; k < 4; ++k) {
                const int p = k * 256 + ht, f = p >> 6, lp = p & 63, pm = f >> 2, ps = f & 3, i = 16 * pm + (lp & 15), gp = lp >> 4;
                const LAS unsigned char* src = L + i * DNP_XROW + (128 + 32 * ps + 4 * gp) * 2;
                const unsigned long long lo = *(const LAS unsigned long long*)src, hi = *(const LAS unsigned long long*)(src + 32);
                v4u o; o.x = (unsigned)lo; o.y = (unsigned)(lo >> 32); o.z = (unsigned)hi; o.w = (unsigned)(hi >> 32);
                *(v4u*)((unsigned char*)Wc + (size_t)ui * 16384 + (size_t)p * 16) = o;
            }
#pragma unroll
            for (int k = 0; k < 4; ++k) {
                const int p = k * 256 + ht, sl = p >> 7, lp = (p >> 1) & 63, hh = p & 1, gp = lp >> 4, col = 16 * sl + (lp & 15);
                unsigned short e[8];
#pragma unroll
                for (int q = 0; q < 8; ++q) { const int i = 16 * (2 * hh + (q >> 2)) + 4 * gp + (q & 3); e[q] = *(const LAS u16*)(L + i * DNP_XROW + col * 2); }
                v4u o; o.x = e[0] | ((unsigned)e[1] << 16); o.y = e[2] | ((unsigned)e[3] << 16); o.z = e[4] | ((unsigned)e[5] << 16); o.w = e[6] | ((unsigned)e[7] << 16);
                *(v4u*)((unsigned char*)Uc + (size_t)ui * 16384 + (size_t)p * 16) = o;
            }
#pragma unroll
            for (int k = 0; k < 2; ++k) {
                const int p = k * 256 + ht, f = p >> 6, lp = p & 63, pm = f >> 1, ps = f & 1, i = 16 * pm + (lp & 15), gp = lp >> 4;
                const LAS unsigned char* src = L + DNP_AM + i * 144 + (32 * ps + 4 * gp) * 2;
                const unsigned long long lo = *(const LAS unsigned long long*)src, hi = *(const LAS unsigned long long*)(src + 32);
                v4u o; o.x = (unsigned)lo; o.y = (unsigned)(lo >> 32); o.z = (unsigned)hi; o.w = (unsigned)(hi >> 32);
                *(v4u*)((unsigned char*)At + (size_t)ui * 8192 + (size_t)p * 16) = o;
            }
        }
        __syncthreads();
        if (st && it == 0 && bx == 0 && tid == 0) st[15] = __builtin_amdgcn_s_memrealtime();
    }
}

#define DN_SYNC() do { asm volatile("s_waitcnt lgkmcnt(0)" ::: "memory"); __builtin_amdgcn_s_barrier(); asm volatile("" ::: "memory"); } while (0)
constexpr int DNS_BUF = 40960, DNS_GL = 2 * DNS_BUF, DN_L = 16  , DN_G = 16  ;
template <int MODE>
__device__ __forceinline__ void dn_seg(LAS unsigned char* lds, int tid, int h, int grp, int slice0, const bf16* Wc, const bf16* KdT, const bf16* Uc, const float* glb,
                                       bf16* Sbuf, bf16* Vbuf, unsigned char* phi, float* slocal, const float* sstart) {
    const int lane = tid & 63, wave = __builtin_amdgcn_readfirstlane(tid >> 6), n0 = grp * DN_L;
    __syncthreads();
    if (tid < DN_L) ((LAS float*)(lds + DNS_GL))[tid] = glb[h * 256 + n0 + tid];
    if (wave >= 4) {
        const int lt = tid - 256;
        const unsigned char* wsrc = (const unsigned char*)Wc + ((size_t)h * 256 + n0) * 16384 + (size_t)lt * 16;
        const unsigned char* ksrc = (const unsigned char*)KdT + ((size_t)h * 256 + n0) * 16384 + (size_t)lt * 16;
        const unsigned char* usrc = (const unsigned char*)Uc + ((size_t)h * 256 + n0) * 16384 + (size_t)slice0 * 2048 + (size_t)lt * 32;
        v4u R0[10], R1[10], R2[10], R3[10];
#define DN_LD(R, n) do { const int _n = ((n) < DN_L) ? (n) : DN_L - 1; { _Pragma("unroll") for (int _j = 0; _j < 4; ++_j) { R[_j] = *(const v4u*)(wsrc + (size_t)_n * 16384 + _j * 4096); R[4 + _j] = *(const v4u*)(ksrc + (size_t)_n * 16384 + _j * 4096); } \
        R[8] = *(const v4u*)(usrc + (size_t)_n * 16384); R[9] = *(const v4u*)(usrc + (size_t)_n * 16384 + 16); } } while (0)
#define DN_ST(R, n) do { const int _n = (n); { LAS unsigned char* _d = lds + (_n & 1) * DNS_BUF; _Pragma("unroll") for (int _j = 0; _j < 8; ++_j) *(LAS v4u*)(_d + _j * 4096 + lt * 16) = R[_j]; \
        *(LAS v4u*)(_d + 32768 + lt * 32) = R[8]; *(LAS v4u*)(_d + 32768 + lt * 32 + 16) = R[9]; } } while (0)
        DN_LD(R0, 0); DN_LD(R1, 1); DN_LD(R2, 2); DN_LD(R3, 3);
        DN_ST(R0, 0); DN_LD(R0, 4);
        DN_SYNC();
#pragma unroll
        for (int n = 0; n < DN_L; n += 4) {
            DN_ST(R1, n + 1); DN_LD(R1, n + 5); DN_SYNC();
            DN_ST(R2, n + 2); DN_LD(R2, n + 6); DN_SYNC();
            DN_ST(R3, n + 3); DN_LD(R3, n + 7); DN_SYNC();
            DN_ST(R0, n + 4); DN_LD(R0, n + 8); DN_SYNC();
        }
#undef DN_LD
#undef DN_ST
    } else {
        const int sl = slice0 + wave, fr = lane & 15, g = lane >> 4;
        f32x4 S[8];
        if (MODE == 2) {
            const f32x4* sp = (const f32x4*)(sstart + ((size_t)(h * DN_G + grp) * 8 + sl) * 2048) + lane;
#pragma unroll
            for (int m = 0; m < 8; ++m) S[m] = sp[64 * m];
        } else {
#pragma unroll
            for (int m = 0; m < 8; ++m)
#pragma unroll
                for (int r = 0; r < 4; ++r) S[m][r] = (MODE == 1 && (16 * m + 4 * g + r) == (16 * sl + fr)) ? 1.f : 0.f;
        }
        unsigned char* sdst = (unsigned char*)Sbuf + (((size_t)h * 256 + n0) * 8 + sl) * 4096 + (size_t)lane * 16;
        unsigned char* vdst = (unsigned char*)Vbuf + (((size_t)h * 256 + n0) * 8 + sl) * 2048 + (size_t)lane * 16;
        const LAS float* gls = (const LAS float*)(lds + DNS_GL);
        DN_SYNC();
        for (int n = 0; n < DN_L; ++n) {
            const LAS unsigned char* bufp = lds + (n & 1) * DNS_BUF;
            const LAS unsigned char* base = bufp + lane * 16;
            v4u u0 = {0u, 0u, 0u, 0u}, u1 = {0u, 0u, 0u, 0u};
            if (MODE != 1) { u0 = *(const LAS v4u*)(bufp + 32768 + (wave * 64 + lane) * 32); u1 = *(const LAS v4u*)(bufp + 32768 + (wave * 64 + lane) * 32 + 16); }
            const float glv = gls[n];
            s16x8 Sb[4];
#pragma unroll
            for (int s = 0; s < 4; ++s) { Sb[s] = pack8(S[2 * s], S[2 * s + 1]); if (MODE == 2) *(s16x8*)(sdst + (size_t)n * 32768 + s * 1024) = Sb[s]; }
            f32x4 acc[4];
#pragma unroll
            for (int m = 0; m < 4; ++m) {
                acc[m] = (f32x4){0.f, 0.f, 0.f, 0.f};
#pragma unroll
                for (int s = 0; s < 4; ++s) { const s16x8 a = *(const LAS s16x8*)(base + (m * 4 + s) * 1024); acc[m] = MFMA16(a, Sb[s], acc[m]); }
            }
            f32x4 vn[4];
            vn[0] = (f32x4){bflo(u0.x), bfhi(u0.x), bflo(u0.y), bfhi(u0.y)} - acc[0];
            vn[1] = (f32x4){bflo(u0.z), bfhi(u0.z), bflo(u0.w), bfhi(u0.w)} - acc[1];
            vn[2] = (f32x4){bflo(u1.x), bfhi(u1.x), bflo(u1.y), bfhi(u1.y)} - acc[2];
            vn[3] = (f32x4){bflo(u1.z), bfhi(u1.z), bflo(u1.w), bfhi(u1.w)} - acc[3];
            s16x8 Vb[2];
#pragma unroll
            for (int s = 0; s < 2; ++s) { Vb[s] = pack8(vn[2 * s], vn[2 * s + 1]); if (MODE == 2) *(s16x8*)(vdst + (size_t)n * 16384 + s * 1024) = Vb[s]; }
#pragma unroll
            for (int m = 0; m < 8; ++m) {
                S[m] = S[m] * glv;
#pragma unroll
                for (int s = 0; s < 2; ++s) { const s16x8 a = *(const LAS s16x8*)(base + 16384 + (m * 2 + s) * 1024); S[m] = MFMA16(a, Vb[s], S[m]); }
            }
            DN_SYNC();
        }
        if (MODE == 0) {
            f32x4* dp = (f32x4*)(slocal + ((size_t)(h * DN_G + grp) * 8 + sl) * 2048) + lane;
#pragma unroll
            for (int m = 0; m < 8; ++m) dp[64 * m] = S[m];
        }
        if (MODE == 1) {
            unsigned char* pp = phi + (size_t)(h * DN_G + grp) * 32768 + (size_t)(sl >> 1) * 1024 + (size_t)(fr >> 2) * 256 + (size_t)(4 * (sl & 1) + (fr & 3)) * 2;
#pragma unroll
            for (int m = 0; m < 8; ++m)
#pragma unroll
                for (int r = 0; r < 4; ++r) *(u16*)(pp + (size_t)m * 4096 + (size_t)(4 * g + r) * 16) = (u16)f2bf(S[m][r]);
        }
    }
}

constexpr int DNM_SLOT = 65536;
__device__ __forceinline__ void dn_mid2(LAS unsigned char* lds, int tid, int h, int hb, const unsigned char* phi, const float* slocal, float* sstart) {
    const int lane = tid & 63, wave = __builtin_amdgcn_readfirstlane(tid >> 6);
    __syncthreads();
    if (wave >= 4) {
        const int lt = tid - 256;
        const unsigned char* psrc = phi + (size_t)(h * DN_G) * 32768 + (size_t)lt * 16;
        const unsigned char* ssrc = (const unsigned char*)(slocal + ((size_t)(h * DN_G) * 8 + 4 * hb) * 2048) + (size_t)lt * 16;
        v4u R0[16], R1[16], R2[16];
#define DNM_LD(R, n) do { const int _n = ((n) < DN_G - 1) ? (n) : DN_G - 2; { _Pragma("unroll") for (int _j = 0; _j < 8; ++_j) { R[_j] = *(const v4u*)(psrc + (size_t)_n * 32768 + _j * 4096); R[8 + _j] = *(const v4u*)(ssrc + (size_t)_n * 65536 + _j * 4096); } } } while (0)
#define DNM_ST(R, n) do { LAS unsigned char* _d = lds + ((n) & 1) * DNM_SLOT + lt * 16; _Pragma("unroll") for (int _j = 0; _j < 16; ++_j) *(LAS v4u*)(_d + _j * 4096) = R[_j]; } while (0)
        DNM_LD(R0, 0); DNM_LD(R1, 1); DNM_LD(R2, 2);
        DNM_ST(R0, 0); DNM_LD(R0, 3);
        DN_SYNC();
#pragma unroll
        for (int n = 0; n < DN_G - 1; n += 3) {
            DNM_ST(R1, n + 1); DNM_LD(R1, n + 4); DN_SYNC();
            DNM_ST(R2, n + 2); DNM_LD(R2, n + 5); DN_SYNC();
            DNM_ST(R0, n + 3); DNM_LD(R0, n + 6); DN_SYNC();
        }
#undef DNM_LD
#undef DNM_ST
    } else {
        const int sl = 4 * hb + wave;
        f32x4 S[8];
#pragma unroll
        for (int m = 0; m < 8; ++m) S[m] = (f32x4){0.f, 0.f, 0.f, 0.f};
        {
            f32x4* dp = (f32x4*)(sstart + ((size_t)(h * DN_G) * 8 + sl) * 2048) + lane;
#pragma unroll
            for (int m = 0; m < 8; ++m) dp[64 * m] = S[m];
        }
        DN_SYNC();
        for (int n = 0; n < DN_G - 1; ++n) {
            const LAS unsigned char* buf = lds + (n & 1) * DNM_SLOT + lane * 16;
            s16x8 Sb[4];
#pragma unroll
            for (int s = 0; s < 4; ++s) {
                v4u w; w.x = cvtpk_c(S[2 * s][0], S[2 * s][1]); w.y = cvtpk_c(S[2 * s][2], S[2 * s][3]); w.z = cvtpk_c(S[2 * s + 1][0], S[2 * s + 1][1]); w.w = cvtpk_c(S[2 * s + 1][2], S[2 * s + 1][3]);
                Sb[s] = __builtin_bit_cast(s16x8, w);
            }
#pragma unroll
            for (int m = 0; m < 8; ++m) {
                f32x4 acc = *(const LAS f32x4*)(buf + 32768 + wave * 8192 + m * 1024);
#pragma unroll
                for (int s = 0; s < 4; ++s) { const s16x8 a = *(const LAS s16x8*)(buf + (m * 4 + s) * 1024); acc = MFMA16(a, Sb[s], acc); }
                S[m] = acc;
            }
            f32x4* dp = (f32x4*)(sstart + ((size_t)(h * DN_G + n + 1) * 8 + sl) * 2048) + lane;
#pragma unroll
            for (int m = 0; m < 8; ++m) dp[64 * m] = S[m];
            DN_SYNC();
        }
    }
    __syncthreads();
}

__device__ __forceinline__ void dn_mid(LAS unsigned char* lds, int tid, int h, const unsigned char* phi, const float* slocal, float* sstart) {
    const int lane = tid & 63, wave = tid >> 6;
    f32x4 S[8];
#pragma unroll
    for (int m = 0; m < 8; ++m) S[m] = (f32x4){0.f, 0.f, 0.f, 0.f};
    {
        f32x4* dp = (f32x4*)(sstart + ((size_t)(h * DN_G) * 8 + wave) * 2048) + lane;
#pragma unroll
        for (int m = 0; m < 8; ++m) dp[64 * m] = S[m];
    }
    v4u P[4]; f32x4 SLn[8];
    {
        const unsigned char* ps = phi + (size_t)(h * DN_G) * 32768 + (size_t)tid * 16;
#pragma unroll
        for (int j = 0; j < 4; ++j) P[j] = *(const v4u*)(ps + j * 8192);
        const f32x4* sp = (const f32x4*)(slocal + ((size_t)(h * DN_G) * 8 + wave) * 2048) + lane;
#pragma unroll
        for (int m = 0; m < 8; ++m) SLn[m] = sp[64 * m];
    }
    __syncthreads();
    for (int g = 0; g < DN_G - 1; ++g) {
        LAS unsigned char* buf = lds + (g & 1) * 32768;
#pragma unroll
        for (int j = 0; j < 4; ++j) *(LAS v4u*)(buf + j * 8192 + tid * 16) = P[j];
        f32x4 SLc[8];
#pragma unroll
        for (int m = 0; m < 8; ++m) SLc[m] = SLn[m];
        __syncthreads();
        {
            const int gn = (g + 1 < DN_G - 1) ? g + 1 : g;
            const unsigned char* ps = phi + (size_t)(h * DN_G + gn) * 32768 + (size_t)tid * 16;
#pragma unroll
            for (int j = 0; j < 4; ++j) P[j] = *(const v4u*)(ps + j * 8192);
            const f32x4* sp = (const f32x4*)(slocal + ((size_t)(h * DN_G + gn) * 8 + wave) * 2048) + lane;
#pragma unroll
            for (int m = 0; m < 8; ++m) SLn[m] = sp[64 * m];
        }
        s16x8 Sb[4];
#pragma unroll
        for (int s = 0; s < 4; ++s) Sb[s] = pack8(S[2 * s], S[2 * s + 1]);
#pragma unroll
        for (int m = 0; m < 8; ++m) {
            f32x4 acc = SLc[m];
#pragma unroll
            for (int s = 0; s < 4; ++s) { const s16x8 a = *(const LAS s16x8*)(buf + (m * 4 + s) * 1024 + lane * 16); acc = MFMA16(a, Sb[s], acc); }
            S[m] = acc;
        }
        f32x4* dp = (f32x4*)(sstart + ((size_t)(h * DN_G + g + 1) * 8 + wave) * 2048) + lane;
#pragma unroll
        for (int m = 0; m < 8; ++m) dp[64 * m] = S[m];
    }
    __syncthreads();
}

__device__ __forceinline__ void dn_out(LAS unsigned char* lds, int bx, int G, int tid, const bf16* Qd, const bf16* At, const bf16* Sbuf, const bf16* Vbuf, const bf16* Pz, const float* o_norm_w, bf16* mixb) {
    const int lane = tid & 63, wave = tid >> 6, fr = lane & 15, g = lane >> 4;
    LAS float* part = (LAS float*)lds;
    LAS float* rnorm = part + 512;
    for (int ui = bx; ui < 1024; ui += G) {
        const int h = ui >> 8, n = ui & 255;
        const unsigned char* qsrc = (const unsigned char*)Qd + (size_t)ui * 16384 + lane * 16;
        const unsigned char* asrc = (const unsigned char*)At + (size_t)ui * 8192 + lane * 16;
        const unsigned char* ssrc = (const unsigned char*)Sbuf + ((size_t)ui * 8 + wave) * 4096 + lane * 16;
        const unsigned char* vsrc = (const unsigned char*)Vbuf + ((size_t)ui * 8 + wave) * 2048 + lane * 16;
        s16x8 Sb[4], Vb[2];
#pragma unroll
        for (int s = 0; s < 4; ++s) Sb[s] = *(const s16x8*)(ssrc + s * 1024);
#pragma unroll
        for (int s = 0; s < 2; ++s) Vb[s] = *(const s16x8*)(vsrc + s * 1024);
        unsigned short zraw[4][4];
#pragma unroll
        for (int m = 0; m < 4; ++m)
#pragma unroll
            for (int r = 0; r < 4; ++r) zraw[m][r] = Pz[((size_t)n * 64 + 16 * m + 4 * g + r) * 512 + h * 128 + 16 * wave + fr];
        f32x4 o[4];
#pragma unroll
        for (int m = 0; m < 4; ++m) {
            o[m] = (f32x4){0.f, 0.f, 0.f, 0.f};
#pragma unroll
            for (int s = 0; s < 4; ++s) { const s16x8 a = *(const s16x8*)(qsrc + (m * 4 + s) * 1024); o[m] = MFMA16(a, Sb[s], o[m]); }
#pragma unroll
            for (int s = 0; s < 2; ++s) { const s16x8 a = *(const s16x8*)(asrc + (m * 2 + s) * 1024); o[m] = MFMA16(a, Vb[s], o[m]); }
        }
#pragma unroll
        for (int m = 0; m < 4; ++m)
#pragma unroll
            for (int r = 0; r < 4; ++r) {
                float q = o[m][r] * o[m][r];
                q += __shfl_xor(q, 1); q += __shfl_xor(q, 2); q += __shfl_xor(q, 4); q += __shfl_xor(q, 8);
                if (fr == 0) part[wave * 64 + 16 * m + 4 * g + r] = q;
            }
        __syncthreads();
        if (tid < 64) {
            float s = 0.f;
#pragma unroll
            for (int w = 0; w < 8; ++w) s += part[w * 64 + tid];
            rnorm[tid] = __builtin_amdgcn_rsqf(s * (1.f / 128.f) + 1e-6f);
        }
        __syncthreads();
        const int dv = 16 * wave + fr;
        const float ow = o_norm_w[dv];
#pragma unroll
        for (int m = 0; m < 4; ++m)
#pragma unroll
            for (int r = 0; r < 4; ++r) {
                const int i = 16 * m + 4 * g + r; const size_t t = (size_t)n * 64 + i;
                const float z = bf2f(zraw[m][r]);
                mixb[t * 1024 + 512 + h * 128 + dv] = (bf16)f2bf(o[m][r] * rnorm[i] * ow * z);
            }
        __syncthreads();
    }
}


typedef float f32x2 __attribute__((ext_vector_type(2)));
__device__ __forceinline__ f32x2 f8lo(unsigned w) { return __builtin_amdgcn_cvt_pk_f32_fp8((int)w, false); }
__device__ __forceinline__ f32x2 f8hi(unsigned w) { return __builtin_amdgcn_cvt_pk_f32_fp8((int)w, true); }

__device__ __forceinline__ void uv_convert_row(const f32x4 (&v)[4], unsigned char* dst, float* inv_scale, int e, int lane) {
    float am = 0.f;
#pragma unroll
    for (int j = 0; j < 4; ++j) am = fmaxf(am, fmaxf(fmaxf(fabsf(v[j].x), fabsf(v[j].y)), fmaxf(fabsf(v[j].z), fabsf(v[j].w))));
#pragma unroll
    for (int o = 32; o > 0; o >>= 1) am = fmaxf(am, __shfl_xor(am, o));
    const float sc = (am > 0.f) ? 400.f / am : 1.f;
    if (lane == 0) inv_scale[e] = (am > 0.f) ? am * (1.f / 400.f) : 1.f;
#pragma unroll
    for (int j = 0; j < 4; ++j) {
        const int c = 2 * j + (lane >> 5);
        int w = 0;
        w = __builtin_amdgcn_cvt_pk_fp8_f32(v[j].x * sc, v[j].y * sc, w, false);
        w = __builtin_amdgcn_cvt_pk_fp8_f32(v[j].z * sc, v[j].w * sc, w, true);
        *(unsigned*)(dst + ((size_t)c * 16384 + e) * 128 + (lane & 31) * 4) = (unsigned)w;
    }
}
__device__ __forceinline__ float* pre_slab(unsigned char* ws, int c) { return (float*)(ws + WS_SLAB + (size_t)c * 8 * MiB); }
__device__ __forceinline__ void uv_convert_table(const float* src, unsigned char* dst, float* inv_scale, int w0, int nw, int lane) {
    for (int e = 2 * w0; e < 16384; e += 2 * nw) {
        f32x4 va[4], vb[4];
        const f32x4* sa = (const f32x4*)(src + (size_t)e * 1024) + lane;
#pragma unroll
        for (int j = 0; j < 4; ++j) { va[j] = sa[64 * j]; vb[j] = sa[256 + 64 * j]; }
        uv_convert_row(va, dst, inv_scale, e, lane);
        uv_convert_row(vb, dst, inv_scale, e + 1, lane);
    }
}
__device__ __forceinline__ void uv_convert_table_dma(const float* src, unsigned char* dst, float* inv_scale, int w0, int nw, int lane, LAS unsigned char* ring) {
    const int nrows = (16384 - w0 + nw - 1) / nw;
    if (nrows <= 0) return;
    auto rowof = [&](int k) { return w0 + (k < nrows ? k : nrows - 1) * nw; };
    auto issue = [&](int k) {
        const unsigned char* s = (const unsigned char*)src + (size_t)rowof(k) * 4096 + lane * 16;
        LAS unsigned char* d = ring + (k & 3) * 4096;
#pragma unroll
        for (int j = 0; j < 4; ++j) __builtin_amdgcn_global_load_lds((const unsigned*)(s + j * 1024), (LAS unsigned*)(d + j * 1024), 16, 0, 0);
    };
    asm volatile("s_waitcnt vmcnt(0)" ::: "memory");
    issue(0); issue(1); issue(2);
    asm volatile("" ::: "memory");
    for (int k = 0; k < nrows; ++k) {
        issue(k + 3);
        asm volatile("s_waitcnt vmcnt(12)" ::: "memory");
        f32x4 v[4];
        const LAS unsigned char* sl = ring + (k & 3) * 4096 + lane * 64;
#pragma unroll
        for (int j = 0; j < 4; ++j) v[j] = *(const LAS f32x4*)(sl + j * 16);
        asm volatile("s_waitcnt lgkmcnt(0)" ::: "memory");
        {
            const int e = rowof(k);
            float am = 0.f;
#pragma unroll
            for (int j = 0; j < 4; ++j) am = fmaxf(am, fmaxf(fmaxf(fabsf(v[j].x), fabsf(v[j].y)), fmaxf(fabsf(v[j].z), fabsf(v[j].w))));
#pragma unroll
            for (int o = 32; o > 0; o >>= 1) am = fmaxf(am, __shfl_xor(am, o));
            const float sc = (am > 0.f) ? 400.f / am : 1.f;
            if (lane == 0) inv_scale[e] = (am > 0.f) ? am * (1.f / 400.f) : 1.f;
            v4u o;
            unsigned w[4];
#pragma unroll
            for (int j = 0; j < 4; ++j) { int q = 0; q = __builtin_amdgcn_cvt_pk_fp8_f32(v[j].x * sc, v[j].y * sc, q, false); q = __builtin_amdgcn_cvt_pk_fp8_f32(v[j].z * sc, v[j].w * sc, q, true); w[j] = (unsigned)q; }
            o.x = w[0]; o.y = w[1]; o.z = w[2]; o.w = w[3];
            unsigned char* dp = dst + ((size_t)(lane >> 3) * 16384 + e) * 128 + (lane & 7) * 16;
            asm volatile("global_store_dwordx4 %0, %1, off sc1" :: "v"(dp), "v"(o) : "memory");
        }
        asm volatile("" ::: "memory");
    }
    asm volatile("s_waitcnt vmcnt(0)" ::: "memory");
}
struct XcdMap { int rank, nloc, px, np; };

__device__ __forceinline__ void peer_pre(const XcdMap M, int tid, unsigned char* ws, const unsigned char* U8, const float* x1, const float* r2, const float* mod, const float* norm2_w, const int* ids) {
    const int lane = tid & 63, wave = tid >> 6, a = lane >> 3, b = lane & 7;
    const float* sh2 = mod + 3072; const float* sc2 = mod + 4096;
    for (int c = M.px; c < 8; c += M.np) {
        float a2[16], s2[16];
#pragma unroll
        for (int e = 0; e < 16; ++e) { const int k = 128 * c + 16 * b + e; a2[e] = norm2_w[k] * (1.f + sc2[k]); s2[e] = sh2[k]; }
        const unsigned char* ub = U8 + (size_t)c * 2 * MiB;
        unsigned char* slab = (unsigned char*)pre_slab(ws, c);
        const unsigned b16 = (unsigned)b * 16u;
        for (int q = M.rank; q < SEQ / 8; q += M.nloc) {
            const unsigned t = (unsigned)(q * 8 + wave);
            unsigned idv[16];
            const unsigned ido = (t * 128u + (unsigned)a) * 4u;
#pragma unroll
            for (int i = 0; i < 16; ++i) idv[i] = *(const unsigned*)((const unsigned char*)ids + ido + i * 32);
            const float rr = r2[t];
            f32x2 h[8];
            const unsigned xo = (t * 1024u + 128u * c + 16u * b) * 4u;
#pragma unroll
            for (int j = 0; j < 4; ++j) {
                const f32x4 xv = *(const f32x4*)((const unsigned char*)x1 + xo + j * 16);
                h[2 * j].x = xv[0] * rr * a2[4 * j] + s2[4 * j]; h[2 * j].y = xv[1] * rr * a2[4 * j + 1] + s2[4 * j + 1];
                h[2 * j + 1].x = xv[2] * rr * a2[4 * j + 2] + s2[4 * j + 2]; h[2 * j + 1].y = xv[3] * rr * a2[4 * j + 3] + s2[4 * j + 3];
            }
            v4u gq[16];
#pragma unroll
            for (int i = 0; i < 16; ++i) gq[i] = *(const v4u*)(ub + (idv[i] * 128u + b16));
            float p[16];
#pragma unroll
            for (int i = 0; i < 16; ++i) {
                const unsigned w[4] = {gq[i].x, gq[i].y, gq[i].z, gq[i].w};
                f32x2 s = {0.f, 0.f};
#pragma unroll
                for (int k = 0; k < 4; ++k) { s += f8lo(w[k]) * h[2 * k]; s += f8hi(w[k]) * h[2 * k + 1]; }
                p[i] = s.x + s.y;
            }
            const bool h4 = (b & 4) != 0, h2 = (b & 2) != 0, h1 = (b & 1) != 0;
            float q8[8], r4[4], s1[2];
#pragma unroll
            for (int i = 0; i < 8; ++i) { const float send = h4 ? p[i] : p[i + 8], keep = h4 ? p[i + 8] : p[i]; q8[i] = keep + __shfl_xor(send, 4); }
#pragma unroll
            for (int i = 0; i < 4; ++i) { const float send = h2 ? q8[i] : q8[i + 4], keep = h2 ? q8[i + 4] : q8[i]; r4[i] = keep + __shfl_xor(send, 2); }
#pragma unroll
            for (int i = 0; i < 2; ++i) { const float send = h1 ? r4[i] : r4[i + 2], keep = h1 ? r4[i + 2] : r4[i]; s1[i] = keep + __shfl_xor(send, 1); }
            const int slot = 8 * (b >> 2) + 4 * ((b >> 1) & 1) + 2 * (b & 1);
            const unsigned so = (t * 128u + (unsigned)(slot * 8 + a)) * 4u;
            *(float*)(slab + so) = s1[0];
            *(float*)(slab + so + 32) = s1[1];
        }
    }
}

#define PEER_DMA16(src, dst) __builtin_amdgcn_global_load_lds((const unsigned*)(src), (LAS unsigned*)(dst), 16, 0, 0)
#define PEER_DMA4(src, dst) __builtin_amdgcn_global_load_lds((const unsigned*)(src), (LAS unsigned*)(dst), 4, 0, 0)
#define PEER_VMWAIT(n) asm volatile("s_waitcnt vmcnt(" #n ")" ::: "memory")
#define PEER_FENCE() asm volatile("" ::: "memory")
__device__ __forceinline__ void peer_gather_quarter(const unsigned char* tb, const LAS unsigned short* idsl, LAS unsigned char* ringq, int a, unsigned soff0, unsigned soff1) {
    unsigned id[4];
#pragma unroll
    for (int i = 0; i < 4; ++i) id[i] = (unsigned)idsl[8 * i + a];
    asm volatile("s_waitcnt lgkmcnt(0)" : "+v"(id[0]), "+v"(id[1]), "+v"(id[2]), "+v"(id[3]) :: "memory");
#pragma unroll
    for (int i = 0; i < 4; ++i) PEER_DMA16(tb + (id[i] * 128u + ((i & 1) ? soff1 : soff0)), ringq + i * 1024);
}
__device__ __forceinline__ void peer_pre_dma(const XcdMap M, int tid, LAS unsigned char* lds, unsigned char* ws, const unsigned char* U8, const bf16* x1, const float* r2, const float* mod, const float* norm2_w, const unsigned short* ids) {
    const int lane = tid & 63, wave = __builtin_amdgcn_readfirstlane(tid >> 6), a = lane >> 3, b = lane & 7, m = lane & 15, g = lane >> 4;
    LAS unsigned char* ring = lds + wave * 16384;
    LAS unsigned char* misc = lds + 131072 + wave * 1984;
    LAS unsigned short* idsL = (LAS unsigned short*)misc;
    LAS unsigned char* xb8 = misc + 1024;
    LAS float* xsL = (LAS float*)(misc + 1408);
    LAS float* rrL = (LAS float*)(misc + 1920);
    const float* sh2 = mod + 3072; const float* sc2 = mod + 4096;
    const unsigned soff0 = 16u * (unsigned)(b ^ (a >> 1)), soff1 = 16u * (unsigned)(b ^ (4 + (a >> 1)));
    unsigned boff[4];
#pragma unroll
    for (int t = 0; t < 4; ++t) boff[t] = (unsigned)(m * 128 + 16 * (((2 * t + (g >> 1)) ^ (m >> 1)) & 7) + 8 * (g & 1));
    const unsigned aoffx = (unsigned)((m < 3 ? m : 2) * 128 + 8 * g);
    const int nIt = (SEQ / 8 - M.rank + M.nloc - 1) / M.nloc;
    for (int c = M.px; c < 8; c += M.np) {
        const unsigned char* ub = U8 + (size_t)c * 2 * MiB;
        float* slab = pre_slab(ws, c);
        const int k0 = 128 * c + 2 * lane;
        const float a20 = norm2_w[k0] * (1.f + sc2[k0]), a21 = norm2_w[k0 + 1] * (1.f + sc2[k0 + 1]), s20 = sh2[k0], s21 = sh2[k0 + 1];
        auto tokof = [&](int k) { const int kk = k < nIt ? k : nIt - 1; return (unsigned)((M.rank + kk * M.nloc) * 8 + wave); };
        auto dma_ids = [&](unsigned t, int slot) { PEER_DMA4(ids + (size_t)t * 128 + 2 * lane, idsL + slot * 128); };
        auto dma_x = [&](unsigned t) {
            PEER_DMA4(x1 + (size_t)t * 1024 + 128 * c + 2 * lane, xsL);
            if (lane < 16) PEER_DMA4(r2 + t, rrL);
        };
        unsigned tcur = tokof(0);
        __builtin_amdgcn_s_waitcnt(0);
        PEER_VMWAIT(0);
        dma_ids(tcur, 0); dma_ids(tokof(1), 1); dma_x(tcur);
        PEER_VMWAIT(0);
        peer_gather_quarter(ub, idsL + 0, ring + 0 * 4096, a, soff0, soff1);
        peer_gather_quarter(ub, idsL + 32, ring + 1 * 4096, a, soff0, soff1);
        peer_gather_quarter(ub, idsL + 64, ring + 2 * 4096, a, soff0, soff1);
        PEER_FENCE();
        for (int k = 0; k < nIt; ++k) {
            const int par = k & 1;
            const unsigned tn = tokof(k + 1);
            peer_gather_quarter(ub, idsL + par * 128 + 96, ring + 3 * 4096, a, soff0, soff1);
            PEER_FENCE();
            dma_ids(tokof(k + 2), par);
            PEER_VMWAIT(13);
            float inv;
            long Ax[4];
            {
                const unsigned xw = *(const LAS unsigned*)(xsL + lane); const f32x2 xv = {bflo(xw), bfhi(xw)}; const float rr = rrL[0];
                const float h0 = xv.x * rr * a20 + s20, h1 = xv.y * rr * a21 + s21;
                float am = fmaxf(fabsf(h0), fabsf(h1));
#pragma unroll
                for (int o = 32; o > 0; o >>= 1) am = fmaxf(am, __shfl_xor(am, o));
                const float S = am > 0.f ? 224.f / am : 1.f; inv = am > 0.f ? am * (1.f / 224.f) : 1.f;
                float v0 = h0 * S, v1 = h1 * S;
                const int p0 = __builtin_amdgcn_cvt_pk_fp8_f32(v0, v1, 0, false);
                const f32x2 f0 = __builtin_amdgcn_cvt_pk_f32_fp8(p0, false);
                v0 -= f0.x; v1 -= f0.y;
                const int p1 = __builtin_amdgcn_cvt_pk_fp8_f32(v0, v1, 0, false);
                const f32x2 f1 = __builtin_amdgcn_cvt_pk_f32_fp8(p1, false);
                v0 -= f1.x; v1 -= f1.y;
                const int p2 = __builtin_amdgcn_cvt_pk_fp8_f32(v0, v1, 0, false);
                *(LAS unsigned short*)(xb8 + 2 * lane) = (unsigned short)p0;
                *(LAS unsigned short*)(xb8 + 128 + 2 * lane) = (unsigned short)p1;
                *(LAS unsigned short*)(xb8 + 256 + 2 * lane) = (unsigned short)p2;
                PEER_FENCE();
#pragma unroll
                for (int t = 0; t < 4; ++t) Ax[t] = *(const LAS long*)(xb8 + aoffx + 32 * t);
                PEER_FENCE();
            }
#pragma unroll
            for (int q = 0; q < 4; ++q) {
                if (q > 0) PEER_VMWAIT(15);
#pragma unroll
                for (int bb = 0; bb < 2; ++bb) {
                    const int blk = 2 * q + bb;
                    f32x4 acc = {0.f, 0.f, 0.f, 0.f};
#pragma unroll
                    for (int t = 0; t < 4; ++t) {
                        const long Bv = *(const LAS long*)(ring + blk * 2048 + boff[t]);
                        acc = __builtin_amdgcn_mfma_f32_16x16x32_fp8_fp8(Ax[t], Bv, acc, 0, 0, 0);
                    }
                    const float val = (acc[0] + acc[1] + acc[2]) * inv;
                    if (lane < 16) slab[(size_t)tcur * 128 + 16 * blk + lane] = val;
                }
                PEER_FENCE();
                if (q < 3) { peer_gather_quarter(ub, idsL + (par ^ 1) * 128 + 32 * q, ring + q * 4096, a, soff0, soff1); PEER_FENCE(); }
                if (q == 0) { dma_x(tn); PEER_FENCE(); }
            }
            tcur = tn;
        }
        PEER_VMWAIT(0);
    }
}

__device__ __forceinline__ void peer_out(const XcdMap M, int tid, const unsigned char* V8, const bf16* x1, float* x2buf, const float* mod, const unsigned short* ids, const float* coef, float* rss3) {
    const int lane = tid & 63, wave = tid >> 6, a = lane >> 3, b = lane & 7;
    const float* gt2 = mod + 5120;
    const bool h32 = (a & 4) != 0, h16 = (a & 2) != 0, h8 = (a & 1) != 0;
    const int col = 16 * b + 8 * ((a >> 2) & 1) + 4 * ((a >> 1) & 1) + 2 * (a & 1);
    for (int c = M.px; c < 8; c += M.np) {
        const unsigned char* vb = V8 + (size_t)c * 2 * MiB;
        const unsigned b16 = (unsigned)b * 16u;
        const f32x2 g2 = *(const f32x2*)(gt2 + 128 * c + col);
        for (int q = M.rank; q < SEQ / 8; q += M.nloc) {
            const unsigned t = (unsigned)(q * 8 + wave);
            unsigned idv[16]; float cf[16];
            const unsigned ido = (t * 128u + (unsigned)a) * 4u;
#pragma unroll
            for (int i = 0; i < 16; ++i) { const unsigned pk = *(const unsigned*)((const unsigned char*)coef + ido + i * 32); idv[i] = pk & 0xffffu; cf[i] = bfhi(pk); }
            const unsigned xo = (t * 1024u + 128u * c + (unsigned)col) * 4u;
            const unsigned xw = *(const unsigned*)((const unsigned char*)x1 + (xo >> 1)); const f32x2 xv = {bflo(xw), bfhi(xw)};
            float acc[16];
#pragma unroll
            for (int e = 0; e < 16; ++e) acc[e] = 0.f;
#pragma unroll
            for (int hf = 0; hf < 2; ++hf) {
                v4u gq[8];
#pragma unroll
                for (int i = 0; i < 8; ++i) gq[i] = *(const v4u*)(vb + (idv[8 * hf + i] * 128u + b16));
                asm volatile("" ::: "memory");
#pragma unroll
                for (int i = 0; i < 8; ++i) {
                    const unsigned w[4] = {gq[i].x, gq[i].y, gq[i].z, gq[i].w}; const float cfi = cf[8 * hf + i];
#pragma unroll
                    for (int k = 0; k < 4; ++k) { const f32x2 lo = f8lo(w[k]), hi = f8hi(w[k]); acc[4 * k] += cfi * lo.x; acc[4 * k + 1] += cfi * lo.y; acc[4 * k + 2] += cfi * hi.x; acc[4 * k + 3] += cfi * hi.y; }
                }
            }
            float q8[8], q4[4], q2[2];
#pragma unroll
            for (int i = 0; i < 8; ++i) { const float send = h32 ? acc[i] : acc[i + 8], keep = h32 ? acc[i + 8] : acc[i]; q8[i] = keep + __shfl_xor(send, 32); }
#pragma unroll
            for (int i = 0; i < 4; ++i) { const float send = h16 ? q8[i] : q8[i + 4], keep = h16 ? q8[i + 4] : q8[i]; q4[i] = keep + __shfl_xor(send, 16); }
#pragma unroll
            for (int i = 0; i < 2; ++i) { const float send = h8 ? q4[i] : q4[i + 2], keep = h8 ? q4[i + 2] : q4[i]; q2[i] = keep + __shfl_xor(send, 8); }
            f32x2 x2; x2.x = xv.x + g2.x * q2[0]; x2.y = xv.y + g2.y * q2[1];
            *(unsigned*)((unsigned char*)x2buf + (xo >> 1)) = cvtpk_c(x2.x, x2.y);
            const float ss = wave_sum(x2.x * x2.x + x2.y * x2.y);
            if (lane == 0) rss3[(unsigned)c * SEQ + t] = ss;
        }
    }
}


__device__ __forceinline__ unsigned ord_key(float v) { const unsigned b = __builtin_bit_cast(unsigned, v); return (b & 0x80000000u) ? ~b : (b | 0x80000000u); }
__device__ __forceinline__ float ord_val(unsigned k, unsigned lowmask) {
    const unsigned b = (k & 0x80000000u) ? (k & 0x7fffffffu) : ~k;
    return __builtin_bit_cast(float, b & ~lowmask);
}
#define RT_CE(a, b) do { const unsigned _ceh = max(a, b), _cel = min(a, b); a = _ceh; b = _cel; } while (0)
#define RT_SORT16(S) do { _Pragma("unroll") for (int _k = 2; _k <= 16; _k <<= 1) _Pragma("unroll") for (int _j = _k >> 1; _j > 0; _j >>= 1) _Pragma("unroll") for (int _i = 0; _i < 16; ++_i) { \
        const int _l = _i ^ _j; if (_l > _i) { if ((_i & _k) == 0) RT_CE(S[_i], S[_l]); else RT_CE(S[_l], S[_i]); } } } while (0)
#define RT_MERGE16(T, S) do { _Pragma("unroll") for (int _i = 0; _i < 16; ++_i) T[_i] = max(T[_i], S[15 - _i]); \
        _Pragma("unroll") for (int _st = 8; _st >= 1; _st >>= 1) _Pragma("unroll") for (int _i = 0; _i < 16; ++_i) if ((_i & _st) == 0) RT_CE(T[_i], T[_i + _st]); } while (0)
#define RT_SORT8(S) do { _Pragma("unroll") for (int _k = 2; _k <= 8; _k <<= 1) _Pragma("unroll") for (int _j = _k >> 1; _j > 0; _j >>= 1) _Pragma("unroll") for (int _i = 0; _i < 8; ++_i) { \
        const int _l = _i ^ _j; if (_l > _i) { if ((_i & _k) == 0) RT_CE(S[_i], S[_l]); else RT_CE(S[_l], S[_i]); } } } while (0)
#define RT_MERGE8(T, S) do { _Pragma("unroll") for (int _i = 0; _i < 8; ++_i) T[8 + _i] = max(T[8 + _i], S[7 - _i]); \
        _Pragma("unroll") for (int _st = 8; _st >= 1; _st >>= 1) _Pragma("unroll") for (int _i = 0; _i < 16; ++_i) if ((_i & _st) == 0) RT_CE(T[_i], T[_i + _st]); } while (0)
#define RT_INS(T, key) do { unsigned _k = (key); _Pragma("unroll") for (int _i = 0; _i < 16; ++_i) { const unsigned _hi = max(T[_i], _k); _k = min(T[_i], _k); T[_i] = _hi; } } while (0)

__device__ __forceinline__ void route_phase(LAS unsigned char* lds, int bx, int G, int tid, const bf16* qq, const bf16* K1b, const bf16* K2b, unsigned short* ids, float* gates, unsigned long long* st) {
#define RSTAMP(k) do { if (st && bx == 0 && tid == 0 && u == bx) st[k] = __builtin_amdgcn_s_memrealtime(); } while (0)
    const int lane = tid & 63, wave = tid >> 6, fr = lane & 15, g = lane >> 4;
    LAS float* sc = (LAS float*)lds;
    LAS unsigned* scu = (LAS unsigned*)lds;
    const bool keep_keys = (G & 3) == 0;
    s16x8 Bk[8][4];
    if (keep_keys) {
        const int hh = wave >> 2, half = (wave >> 1) & 1, h = 2 * (bx & 3) + hh;
        const bf16* kb = (half ? K2b : K1b) + (size_t)h * 128 * 128;
#pragma unroll
        for (int nt = 0; nt < 8; ++nt)
#pragma unroll
            for (int s = 0; s < 4; ++s) Bk[nt][s] = *(const s16x8*)(kb + (size_t)(16 * nt + fr) * 128 + 32 * s + 8 * g);
    }
    s16x8 Aq[2][4];
    {
        const int hh = wave >> 2, half = (wave >> 1) & 1, th = wave & 1;
        const int u0 = (bx < 1024) ? bx : 0, h = 2 * (u0 & 3) + hh, t0 = (u0 >> 2) * 64;
#pragma unroll
        for (int mt = 0; mt < 2; ++mt)
#pragma unroll
            for (int s = 0; s < 4; ++s) Aq[mt][s] = *(const s16x8*)(qq + (size_t)(t0 + 32 * th + 16 * mt + fr) * 2048 + h * 256 + half * 128 + 32 * s + 8 * g);
    }
    for (int u = bx; u < 1024; u += G) {
        const int tile = u >> 2, hp = u & 3, t0 = tile * 64;
        {
            const int hh = wave >> 2, half = (wave >> 1) & 1, th = wave & 1, h = 2 * hp + hh;
            const bf16* kb = (half ? K2b : K1b) + (size_t)h * 128 * 128;
            if (!keep_keys) {
#pragma unroll
                for (int nt = 0; nt < 8; ++nt)
#pragma unroll
                    for (int s = 0; s < 4; ++s) Bk[nt][s] = *(const s16x8*)(kb + (size_t)(16 * nt + fr) * 128 + 32 * s + 8 * g);
            }
            const int lbase = (hh * 2 + half) * 64 + 32 * th;
#pragma unroll
            for (int nt = 0; nt < 8; ++nt) {
                f32x4 a0 = {0.f, 0.f, 0.f, 0.f}, a1 = {0.f, 0.f, 0.f, 0.f};
#pragma unroll
                for (int s = 0; s < 4; ++s) { a0 = MFMA16(Aq[0][s], Bk[nt][s], a0); a1 = MFMA16(Aq[1][s], Bk[nt][s], a1); }
#pragma unroll
                for (int r = 0; r < 4; ++r) { sc[(lbase + 4 * g + r) * 129 + 16 * nt + fr] = a0[r]; sc[(lbase + 16 + 4 * g + r) * 129 + 16 * nt + fr] = a1[r]; }
            }
            {
                const int un = (u + G < 1024) ? u + G : u, hn = 2 * (un & 3) + hh, tn = (un >> 2) * 64;
#pragma unroll
                for (int mt = 0; mt < 2; ++mt)
#pragma unroll
                    for (int s = 0; s < 4; ++s) Aq[mt][s] = *(const s16x8*)(qq + (size_t)(tn + 32 * th + 16 * mt + fr) * 2048 + hn * 256 + half * 128 + 32 * s + 8 * g);
            }
        }
        __syncthreads(); RSTAMP(16);
        unsigned T[16];
        const int li = tid & 255, part = tid >> 8;
        {
            const LAS float* src = sc + li * 129 + 64 * part;
#pragma unroll
            for (int k = 0; k < 16; ++k) T[k] = (ord_key(src[k]) & ~127u) | (unsigned)(127 - k);
            RT_SORT16(T);
#pragma unroll 1
            for (int b = 2; b < 8; ++b) {
                unsigned S[8];
#pragma unroll
                for (int k = 0; k < 8; ++k) S[k] = (ord_key(src[8 * b + k]) & ~127u) | (unsigned)(127 - (8 * b + k));
                RT_SORT8(S);
                RT_MERGE8(T, S);
            }
            if (part == 1) {
#pragma unroll
                for (int i = 0; i < 16; ++i) scu[li * 129 + 64 + i] = T[i] ^ 64u;
            }
        }
        __syncthreads(); RSTAMP(17);
        if (part == 0) {
#pragma unroll
            for (int i = 0; i < 16; ++i) T[i] = max(T[i], scu[li * 129 + 64 + 15 - i]);
#pragma unroll
            for (int st = 8; st >= 1; st >>= 1)
#pragma unroll
                for (int i = 0; i < 16; ++i) if ((i & st) == 0) { const unsigned hi = max(T[i], T[i + st]), lo = min(T[i], T[i + st]); T[i] = hi; T[i + st] = lo; }
#pragma unroll
            for (int i = 0; i < 16; ++i) scu[li * 129 + i] = T[i];
        }
        __syncthreads(); RSTAMP(18);
        if (tid < 128) {
            const int tok = tid & 63, hh = tid >> 6, h = 2 * hp + hh;
            const int l1 = (hh * 2 + 0) * 64 + tok, l2 = (hh * 2 + 1) * 64 + tok;
            float v1[16], v2[16];
#pragma unroll
            for (int i = 0; i < 16; ++i) { v1[i] = ord_val(scu[l1 * 129 + i], 127u); v2[i] = ord_val(scu[l2 * 129 + i], 127u); }
#define RT_CKEY(i, j) ((ord_key(v1[i] + v2[j]) & ~255u) | (unsigned)(255 - ((i) * 16 + (j))))
#pragma unroll
            for (int j = 0; j < 16; ++j) T[j] = RT_CKEY(0, j);
            { unsigned S[8];
#pragma unroll
              for (int j = 0; j < 8; ++j) S[j] = RT_CKEY(1, j);
              RT_MERGE8(T, S); }
            { unsigned S[8];
#pragma unroll
              for (int j = 0; j < 5; ++j) S[j] = RT_CKEY(2, j);
              S[5] = RT_CKEY(3, 0); S[6] = RT_CKEY(3, 1); S[7] = RT_CKEY(3, 2);
              RT_SORT8(S); RT_MERGE8(T, S); }
            { unsigned S[8];
              S[0] = RT_CKEY(3, 3); S[1] = RT_CKEY(4, 0); S[2] = RT_CKEY(4, 1); S[3] = RT_CKEY(4, 2); S[4] = RT_CKEY(5, 0); S[5] = RT_CKEY(5, 1); S[6] = RT_CKEY(6, 0); S[7] = RT_CKEY(6, 1);
              RT_SORT8(S); RT_MERGE8(T, S); }
            { unsigned S[8];
              S[0] = RT_CKEY(7, 0); S[1] = RT_CKEY(7, 1); S[2] = RT_CKEY(8, 0); S[3] = RT_CKEY(9, 0); S[4] = RT_CKEY(10, 0); S[5] = RT_CKEY(11, 0); S[6] = RT_CKEY(12, 0); S[7] = RT_CKEY(13, 0);
              RT_SORT8(S); RT_MERGE8(T, S); }
            { unsigned S[8];
              S[0] = RT_CKEY(14, 0); S[1] = RT_CKEY(15, 0);
#pragma unroll
              for (int j = 2; j < 8; ++j) S[j] = 0u;
              RT_MERGE8(T, S); }
            const float mx = ord_val(T[0], 255u);
            float e[16], se = 0.f;
#pragma unroll
            for (int r = 0; r < 16; ++r) { e[r] = __expf(ord_val(T[r], 255u) - mx); se += e[r]; }
            const float inv = 1.f / se;
            const size_t ob = (size_t)(t0 + tok) * 128 + h * 16;
#pragma unroll
            for (int r = 0; r < 16; ++r) {
                const int pos = 255 - (int)(T[r] & 255u), i = pos >> 4, j = pos & 15;
                const int i1 = 127 - (int)(scu[l1 * 129 + i] & 127u), i2 = 127 - (int)(scu[l2 * 129 + j] & 127u);
                ids[ob + r] = (unsigned short)(i1 * 128 + i2);
                gates[ob + r] = e[r] * inv;
            }
        }
        __syncthreads(); RSTAMP(19);
    }
}


__device__ __forceinline__ void gmlp_phase(LAS unsigned char* lds, int bx, int G, int tid, const bf16* Pgm, const bf16* GWb, const float* gm_norm_w, const float* gm_bs, bf16* mixb, const float* vss) {
    const int lane = tid & 63, wave = tid >> 6, fr = lane & 15, g = lane >> 4;
    LAS unsigned char* vnT = lds + 512;
    for (int u = bx; u < 1024; u += G) {
        const int n = u >> 3, hd = u & 7, t0 = n * 128;
        const int dg = tid & 7, sp = tid >> 3, s0 = 2 * sp;
        float pa = vss[(size_t)dg * SEQ + t0 + s0], pb = vss[(size_t)dg * SEQ + t0 + s0 + 1];
        const v4u qa = *(const v4u*)(Pgm + (size_t)(t0 + s0) * 1024 + 512 + hd * 64 + dg * 8);
        const v4u qb = *(const v4u*)(Pgm + (size_t)(t0 + s0 + 1) * 1024 + 512 + hd * 64 + dg * 8);
        unsigned short uraw[4][4];
#pragma unroll
        for (int r = 0; r < 4; ++r)
#pragma unroll
            for (int nt = 0; nt < 4; ++nt) uraw[r][nt] = Pgm[(size_t)(t0 + 16 * wave + 4 * g + r) * 1024 + hd * 64 + 16 * nt + fr];
        pa += __shfl_xor(pa, 1); pa += __shfl_xor(pa, 2); pa += __shfl_xor(pa, 4);
        pb += __shfl_xor(pb, 1); pb += __shfl_xor(pb, 2); pb += __shfl_xor(pb, 4);
        {
            const float ra = __builtin_amdgcn_rsqf(pa * (1.f / 512.f) + 1e-6f), rb = __builtin_amdgcn_rsqf(pb * (1.f / 512.f) + 1e-6f);
            const unsigned wa[4] = {qa.x, qa.y, qa.z, qa.w}, wb[4] = {qb.x, qb.y, qb.z, qb.w};
#pragma unroll
            for (int e = 0; e < 8; ++e) {
                const float nw = gm_norm_w[hd * 64 + dg * 8 + e];
                const float va = ((e & 1) ? bfhi(wa[e >> 1]) : bflo(wa[e >> 1])) * ra * nw, vb = ((e & 1) ? bfhi(wb[e >> 1]) : bflo(wb[e >> 1])) * rb * nw;
                *(LAS unsigned*)(vnT + (dg * 8 + e) * 272 + sp * 4) = cvtpk(va, vb);
            }
        }
        __syncthreads();
        {
            const int mt = wave, nks = (mt >> 1) + 1;
            f32x4 acc[4];
#pragma unroll
            for (int nt = 0; nt < 4; ++nt) acc[nt] = (f32x4){0.f, 0.f, 0.f, 0.f};
            const bf16* wrow = GWb + ((size_t)hd * 128 + 16 * mt + fr) * 128 + 8 * g;
#pragma unroll
            for (int ks = 0; ks < 4; ++ks) {
                if (ks < nks) {
                    const s16x8 a = *(const s16x8*)(wrow + 32 * ks);
#pragma unroll
                    for (int nt = 0; nt < 4; ++nt) { const s16x8 b = *(const LAS s16x8*)(vnT + (16 * nt + fr) * 272 + (32 * ks + 8 * g) * 2); acc[nt] = MFMA16(a, b, acc[nt]); }
                }
            }
#pragma unroll
            for (int r = 0; r < 4; ++r) {
                const int t = 16 * mt + 4 * g + r;
                const float bias = gm_bs[hd * 128 + t];
#pragma unroll
                for (int nt = 0; nt < 4; ++nt) {
                    const size_t o = (size_t)(t0 + t) * 1024 + hd * 64 + 16 * nt + fr;
                    mixb[o] = (bf16)f2bf(bf2f(uraw[r][nt]) * (acc[nt][r] + bias));
                }
            }
        }
        __syncthreads();
    }
}


__device__ __forceinline__ int otid_(int wave_s) { int t = wave_s * 64 + (int)__builtin_amdgcn_mbcnt_hi(~0u, __builtin_amdgcn_mbcnt_lo(~0u, 0u)); asm volatile("" : "+v"(t)); return t; }
#define otid() otid_(wave_s)
#define PH_IDS const int tid = otid(), lane = tid & 63, wave = wave_s, gw = bx * NWAVES + wave; (void)lane; (void)wave; (void)gw
__global__ void __launch_bounds__(NT, 2) fwd_kernel(Args A) {
    extern __shared__ __attribute__((aligned(16))) unsigned char lds_raw[];
    LAS unsigned char* lds = (LAS unsigned char*)lds_raw;
    LAS float* ldsf = (LAS float*)lds;
    const int G = gridDim.x, bx = blockIdx.x, NGW = G * NWAVES;
    const int wave_s = __builtin_amdgcn_readfirstlane((int)(threadIdx.x >> 6));
    unsigned char* ws = A.ws;
    float* mod = (float*)(ws + WS_MOD); float* a2g = (float*)(ws + WS_A2); float* bias1 = (float*)(ws + WS_BIAS1); float* bias3 = (float*)(ws + WS_BIAS3);
    float* r1 = (float*)(ws + WS_R1); float* rss2 = (float*)(ws + WS_RSS2); float* gbuf = (float*)(ws + WS_G); float* bbuf = (float*)(ws + WS_BETA); float* pab = (float*)(ws + WS_PAB);
    bf16* K1b = (bf16*)(ws + WS_K1B); bf16* K2b = (bf16*)(ws + WS_K2B); bf16* GWb = (bf16*)(ws + WS_GWB);
    bf16* W1T = (bf16*)(ws + WS_W1T); bf16* W2T = (bf16*)(ws + WS_W2T); bf16* W3T = (bf16*)(ws + WS_W3T);
    bf16* xb = (bf16*)(ws + WS_XB); bf16* mixb = (bf16*)(ws + WS_XB);
    bf16* Pgm = (bf16*)(ws + WS_PGM); bf16* x1b = (bf16*)(ws + WS_PGM);
    bf16* Pqkv = (bf16*)(ws + WS_PQKV); bf16* qq = (bf16*)(ws + WS_WC);
    bf16* Pz = (bf16*)(ws + WS_PZ);
    bf16* Wc = (bf16*)(ws + WS_WC); bf16* KdT = (bf16*)(ws + WS_KDT); bf16* Uc = (bf16*)(ws + WS_UC); bf16* Qd = (bf16*)(ws + WS_QD); bf16* At = (bf16*)(ws + WS_AT);
    bf16* Sbuf = (bf16*)(ws + WS_PGM); bf16* Vbuf = (bf16*)(ws + WS_PQKV); float* glb = gbuf;
    unsigned short* ids = (unsigned short*)(ws + WS_IDS); float* gates = (float*)(ws + WS_GATES);

    if (threadIdx.x < 128) ((LAS unsigned*)(lds + LDSCTL_OFF))[threadIdx.x] = 0u;
    __syncthreads();
    XcdBarrier bar; bar.bar = (unsigned*)(ws + WS_CTL) + 1024; bar.x = xb_xcc_id(); bar.w = wave_s; bar.st = (volatile LAS unsigned*)(lds + MISC_OFF);
    if (threadIdx.x == 0) bar.st[2] = xb_add(&bar.bar[XB_XCNT(bar.x)], 1u);

#define STAMP(k) do { if (TS_B >= 0 && bx == 0 && wave_s == 0 && __builtin_amdgcn_mbcnt_hi(~0u, __builtin_amdgcn_mbcnt_lo(~0u, 0u)) == 0u) ((unsigned long long*)(A.ws + WS_CTL + 32 * KiB))[k] = __builtin_amdgcn_s_memrealtime(); } while (0)
    STAMP(0);
    for (int rep_ = 0; rep_ < REP_P0; ++rep_) {
        PH_IDS;
        if (bx < 192) {
            for (int i = tid; i < 1024; i += NT) ldsf[i] = silu_f(A.c[i]);
            __syncthreads();
            for (int it = bx; it < 192; it += G) gemv_item<32>(ldsf, A.w_ada, 6144, it * 32, 6144, mod, A.b_ada, ldsf + 1024, tid);
        }
        {
            LAS float* scr = ldsf + 4096 + wave * 2176;
            int it0 = gw, its = NGW, itn = 3072;
            if (G == 256) { if (bx < 192) { it0 = gw; itn = gw + 1; its = 1; } else { it0 = 1536 + (bx - 192) * NWAVES + wave; its = 512; } }
            for (int it = it0; it < itn; it += its) {
                if (it < 512) transpose_item(A.w_out, 1024, 1024, 32, W2T, scr, it, lane, nullptr, nullptr);
                else if (it < 2048) transpose_item(A.w_in, DIN, 1024, 96, W1T, scr, it - 512, lane, nullptr, nullptr);
                else transpose_item(A.peer_wq, 2048, 1024, 64, W3T, scr, it - 2048, lane, nullptr, nullptr);
            }
        }
        for (int i = bx * NT + tid; i < 2 * 32768; i += G * NT) {
            const f32x4 v = (i < 32768) ? ((const f32x4*)A.keys1)[i] : ((const f32x4*)A.keys2)[i - 32768];
            unsigned long long* dst = (i < 32768) ? (unsigned long long*)K1b + i : (unsigned long long*)K2b + (i - 32768);
            *dst = (unsigned long long)pk2(v.x, v.y) | ((unsigned long long)pk2(v.z, v.w) << 32);
        }
        for (int i = bx * NT + tid; i < 32768; i += G * NT) {
            const f32x4 v = ((const f32x4*)A.gm_ws)[i]; const int t = (i >> 5) & 127, s0 = (i & 31) * 4;
            ((unsigned long long*)GWb)[i] = (unsigned long long)pk2(s0 <= t ? v.x : 0.f, s0 + 1 <= t ? v.y : 0.f) | ((unsigned long long)pk2(s0 + 2 <= t ? v.z : 0.f, s0 + 3 <= t ? v.w : 0.f) << 32);
        }
    }
    xcd_barrier(bar); STAMP(1);

    for (int rep_ = 0; rep_ < REP_P1; ++rep_) {
        PH_IDS;
        const float* sh1 = mod; const float* sc1 = mod + 1024; const float* sh2 = mod + 3072; const float* sc2 = mod + 4096;
        LAS float* vec1 = ldsf;
        LAS float* vec2 = ldsf + 1024;
        LAS float* part = ldsf + 2048;
        LAS float* wab = ldsf + 4096;
        LAS float* bab = ldsf + 12288;
        LAS float* sA = ldsf + 12544;
#pragma unroll
        for (int i = tid; i < 1024; i += NT) { vec1[i] = sh1[i]; vec2[i] = sh2[i]; sA[i] = A.norm1_w[i] * (1.f + sc1[i]); }
        {
            float wv[16], nv[16], sv[16];
#pragma unroll
            for (int q = 0; q < 16; ++q) { const int i = tid + q * NT, k = i >> 3, j = i & 7; wv[q] = A.w_in[(size_t)k * DIN + 3072 + j]; nv[q] = A.norm1_w[k]; sv[q] = sc1[k]; }
#pragma unroll
            for (int q = 0; q < 16; ++q) { const int i = tid + q * NT, k = i >> 3, j = i & 7; wab[j * 1024 + k] = nv[q] * (1.f + sv[q]) * wv[q]; }
        }
        if (bx == G - 1) for (int i = tid; i < 1024; i += NT) a2g[i] = A.norm2_w[i] * (1.f + sc2[i]);
        __syncthreads();
        {
            float s = 0.f, wv[16];
#pragma unroll
            for (int q = 0; q < 16; ++q) wv[q] = A.w_in[(size_t)(lane + 64 * q) * DIN + 3072 + wave];
#pragma unroll
            for (int q = 0; q < 16; ++q) s += vec1[lane + 64 * q] * wv[q];
            s = wave_sum(s);
            if (lane == 0) bab[wave] = s;
        }
        __syncthreads();
        for (int it = bx; it < 160; it += G) {
            if (it < 96) gemv_item<32>(vec1, A.w_in, DIN, it * 32, 3072, bias1, nullptr, part, tid);
            else gemv_item<32>(vec2, A.peer_wq, 2048, (it - 96) * 32, 2048, bias3, nullptr, part, tid);
        }
        int r0, nr;
        if (G == 256) { if (bx < 160) { r0 = 56 * bx; nr = 56; } else { const int j = bx - 160; r0 = 8960 + 77 * j + (j < 32 ? j : 32); nr = 77 + (j < 32 ? 1 : 0); } }
        else { r0 = (int)(((long long)SEQ * bx) / G); nr = (int)(((long long)SEQ * (bx + 1)) / G) - r0; }
        f32x4 sa[4];
#pragma unroll
        for (int j = 0; j < 4; ++j) sa[j] = ((const LAS f32x4*)sA)[j * 64 + lane];
        const bool b1 = (lane & 1) != 0, b2 = (lane & 2) != 0, b4 = (lane & 4) != 0;
        for (int i0 = wave; i0 < nr; i0 += 32) {
            int rows[4];
            f32x4 v[4][4];
#pragma unroll
            for (int r = 0; r < 4; ++r) {
                const int i = i0 + 8 * r;
                rows[r] = r0 + (i < nr ? i : nr - 1);
#pragma unroll
                for (int j = 0; j < 4; ++j) v[r][j] = ((const f32x4*)(A.x + (size_t)rows[r] * 1024))[j * 64 + lane];
            }
            float d[4][8], ss[4];
#pragma unroll
            for (int r = 0; r < 4; ++r) {
                float s = 0.f;
#pragma unroll
                for (int j = 0; j < 4; ++j) s += (v[r][j].x * v[r][j].x + v[r][j].y * v[r][j].y) + (v[r][j].z * v[r][j].z + v[r][j].w * v[r][j].w);
                ss[r] = s;
            }
#pragma unroll
            for (int jc = 0; jc < 8; ++jc) {
#pragma unroll
                for (int r = 0; r < 4; ++r) d[r][jc] = 0.f;
#pragma unroll
                for (int j = 0; j < 4; ++j) {
                    const f32x4 w = ((const LAS f32x4*)(wab + jc * 1024))[j * 64 + lane];
#pragma unroll
                    for (int r = 0; r < 4; ++r) d[r][jc] += (v[r][j].x * w.x + v[r][j].y * w.y) + (v[r][j].z * w.z + v[r][j].w * w.w);
                }
            }
#pragma unroll
            for (int r = 0; r < 4; ++r) {
#pragma unroll
                for (int j = 0; j < 4; ++j) {
                    const f32x4 y = v[r][j] * sa[j];
                    ((unsigned long long*)(xb + (size_t)rows[r] * 1024))[j * 64 + lane] = (unsigned long long)pk2(y.x, y.y) | ((unsigned long long)pk2(y.z, y.w) << 32);
                }
                float e4[4], e2[2];
#pragma unroll
                for (int i = 0; i < 4; ++i) { const float send = b4 ? d[r][i] : d[r][i + 4], keep = b4 ? d[r][i + 4] : d[r][i]; e4[i] = keep + __shfl_xor(send, 4); }
#pragma unroll
                for (int i = 0; i < 2; ++i) { const float send = b2 ? e4[i] : e4[i + 2], keep = b2 ? e4[i + 2] : e4[i]; e2[i] = keep + __shfl_xor(send, 2); }
                float e1 = (b1 ? e2[1] : e2[0]) + __shfl_xor(b1 ? e2[0] : e2[1], 1);
                e1 += __shfl_xor(e1, 8); e1 += __shfl_xor(e1, 16); e1 += __shfl_xor(e1, 32);
                const float rr = __builtin_amdgcn_rsqf(wave_sum(ss[r]) * (1.f / 1024.f) + 1e-6f);
                if (lane < 8) pab[(size_t)rows[r] * 8 + lane] = e1 * rr + bab[lane];
                if (lane == 0) r1[rows[r]] = rr;
            }
        }
    }
    xcd_barrier(bar); STAMP(2);

    {
        pg8::Gemm g{xb, W1T, SEQ, 3072, 1024}; pg8::StaticOrder S; S.init(SEQ, 3072, G, bx);
        pg8::Epi1 E{Pgm, Pqkv, Pz, r1, bias1, rss2, SEQ};
        pg8::gemm_phase<pg8::Epi1, pg8::StaticOrder, true, true>(lds, g, S, E, otid());
    }
    xcd_barrier(bar); STAMP(3);

    {
        PH_IDS;
        for (int rep_ = 0; rep_ < REP_GMLP; ++rep_) gmlp_phase(lds, bx, G, tid, Pgm, GWb, A.gm_norm_w, A.gm_bs, mixb, rss2);
        STAMP(14);
        for (int rep_ = 0; rep_ < REP_DNPREP; ++rep_) dn_prep(lds, bx, G, otid(), Pqkv, pab, A.conv_w, A.a_log, A.dt_bias, Wc, KdT, Uc, Qd, At, glb, TS_B >= 0 ? (unsigned long long*)(A.ws + WS_CTL + 32 * KiB) : nullptr);
    }
    xcd_barrier(bar); STAMP(4);

    int vbx = bx; bool xuni;
    {
        if (otid() == 0) {
            int np = 0, px = 0, nloc = 1; bool uni = (G == 256);
#pragma unroll
            for (int j = 0; j < 16; ++j) { const unsigned c = xb_ld(&bar.bar[XB_XCNT(j)]); if (c > 0u) { if (j < (int)bar.x) ++px; ++np; if (c != 32u) uni = false; } if (j == (int)bar.x) nloc = (int)c; }
            bar.st[4] = (unsigned)np; bar.st[5] = (unsigned)px; bar.st[6] = (unsigned)(nloc > 0 ? nloc : 1); bar.st[7] = (uni && np == 8) ? 1u : 0u;
        }
        __syncthreads();
        xuni = bar.st[7] != 0u;
        if (xuni) vbx = (int)bar.st[5] * 32 + (int)bar.st[2];
        vbx = __builtin_amdgcn_readfirstlane(vbx);
    }
    for (int rep_ = 0; rep_ < REP_SCAN; ++rep_)
    for (int u = vbx; u < 256; u += G) {
        const int h = u >> 6, grp = (u >> 2) & 15, p = u & 3;
        if (p < 2) dn_seg<1>(lds, otid(), h, grp, 4 * (p & 1), Wc, KdT, Uc, glb, Sbuf, Vbuf, ws + WS_PHI, (float*)(ws + WS_SL), (const float*)(ws + WS_SS));
        else       dn_seg<0>(lds, otid(), h, grp, 4 * (p & 1), Wc, KdT, Uc, glb, Sbuf, Vbuf, ws + WS_PHI, (float*)(ws + WS_SL), (const float*)(ws + WS_SS));
    }
    xcd_barrier(bar); STAMP(25);
    const int mu = xuni ? ((vbx & 63) < 2 ? (vbx >> 6) * 2 + (vbx & 63) : -1) : (bx < 8 ? bx : -1);
    if (mu >= 0) for (int rep_ = 0; rep_ < REP_SCAN; ++rep_) dn_mid2(lds, otid(), mu >> 1, mu & 1, ws + WS_PHI, (const float*)(ws + WS_SL), (float*)(ws + WS_SS));
    {
        PH_IDS;
        if (xuni && ((vbx >> 5) & 1) == 0 && mu < 0) {
            const int hh = vbx >> 6, L = ((vbx & 31) - 2) * NT + tid;
            if (L < 15 * 768) {
                const int gq = L / 768, r = L - gq * 768;
                const unsigned char* pa = (r < 256) ? (ws + WS_PHI) + (size_t)(hh * DN_G + gq) * 32768 + (size_t)r * 128
                                                    : (const unsigned char*)((const float*)(ws + WS_SL) + (size_t)(hh * DN_G + gq) * 8 * 2048) + (size_t)(r - 256) * 128;
                const unsigned tv = *(const unsigned*)pa;
                asm volatile("" :: "v"(tv));
            }
        }
        const int cb = xuni ? ((((vbx >> 5) & 1) == 1) ? (vbx >> 6) * 32 + (vbx & 31) : -1) : ((G > 8) ? bx - 8 : bx), ncb = xuni ? 128 : ((G > 8) ? G - 8 : G);
        if (cb >= 0) for (int rep_ = 0; rep_ < REP_CONV; ++rep_) uv_convert_table_dma(A.peer_u, ws + WS_UB, (float*)(ws + WS_SCU), cb * NWAVES + wave, ncb * NWAVES, lane, lds + wave * 16384);
    }
    xcd_barrier(bar); STAMP(5);

    {
    const int xr = vbx & 31, xp = vbx >> 5;
    const int u3 = xuni ? (xr < 16 ? xp * 16 + xr : 128) : bx, u3s = xuni ? 256 : G;
    const int cb = xuni ? (xr >= 16 ? xp * 16 + xr - 16 : -1) : ((G > 128) ? bx - 128 : bx), ncb = xuni ? 128 : ((G > 128) ? G - 128 : G);
    for (int rep_ = 0; rep_ < REP_SCAN; ++rep_)
    for (int u = u3; u < 128; u += u3s) {
        const int h = u >> 5, grp = (u >> 1) & 15, hb = u & 1;
        dn_seg<2>(lds, otid(), h, grp, 4 * hb, Wc, KdT, Uc, glb, Sbuf, Vbuf, ws + WS_PHI, (float*)(ws + WS_SL), (const float*)(ws + WS_SS));
    }
    {
        PH_IDS;
        if (cb >= 0) for (int rep_ = 0; rep_ < REP_CONV; ++rep_) uv_convert_table_dma(A.peer_v, ws + WS_VB, (float*)(ws + WS_SCV), cb * NWAVES + wave, ncb * NWAVES, lane, lds + wave * 16384);
    }
    }
    xcd_barrier(bar); STAMP(26);

    for (int rep_ = 0; rep_ < REP_DNOUT; ++rep_) dn_out(lds, bx, G, otid(), Qd, At, Sbuf, Vbuf, Pz, A.o_norm_w, mixb);
    xcd_barrier(bar); STAMP(6);

    {
        pg8::Gemm g{mixb, W2T, SEQ, 1024, 1024}; pg8::StaticOrder S; S.init(SEQ, 1024, G, bx);
        pg8::Epi2 E{A.x, (bf16*)A.out, x1b, mod + 2048, rss2, SEQ, a2g};
        pg8::gemm_phase<pg8::Epi2, pg8::StaticOrder, true, true>(lds, g, S, E, otid());
    }
    xcd_barrier(bar); STAMP(7);

    {
        pg8::Gemm g{x1b, W3T, SEQ, 2048, 1024}; pg8::StaticOrder S; S.init(SEQ, 2048, G, bx);
        pg8::Epi3 E{qq, rss2, bias3, SEQ};
        pg8::gemm_phase<pg8::Epi3, pg8::StaticOrder, true, true>(lds, g, S, E, otid());
    }
    xcd_barrier(bar); STAMP(8);

    {
        PH_IDS;
        for (int row = gw; row < SEQ; row += NGW) {
            const float rs = (lane < 16) ? rss2[(size_t)lane * SEQ + row] : 0.f;
            const float r = __builtin_amdgcn_rsqf(wave_sum(rs) * (1.f / 1024.f) + 1e-6f);
            if (lane == 0) r1[row] = r;
        }
        STAMP(20);
        for (int rep_ = 0; rep_ < REP_ROUTE; ++rep_) route_phase(lds, bx, G, tid, qq, K1b, K2b, ids, gates, nullptr);
    }
    xcd_barrier(bar); STAMP(9);

    {
    PH_IDS;
    XcdMap XM;
    { const int np = (int)bar.st[4]; XM.rank = (int)bar.st[2]; XM.nloc = (int)bar.st[6]; XM.px = (int)bar.st[5]; XM.np = np > 0 ? np : 1; }
    for (int rep_ = 0; rep_ < REP_PRE; ++rep_) peer_pre_dma(XM, tid, lds, ws, ws + WS_UB, (const bf16*)A.out, r1, mod, A.norm2_w, ids);
    xcd_barrier(bar); STAMP(10);

    for (int rep_ = 0; rep_ < REP_P10; ++rep_)
    for (int idx = bx * NT + tid; idx < SEQ * 128 / 4; idx += G * NT) {
        f32x4 sacc = {0.f, 0.f, 0.f, 0.f};
#pragma unroll
        for (int c = 0; c < 8; ++c) sacc += *(const f32x4*)(pre_slab(ws, c) + (size_t)idx * 4);
        const f32x4 gt = *(const f32x4*)(gates + (size_t)idx * 4);
        const unsigned long long idw = *(const unsigned long long*)(ids + (size_t)idx * 4);
        int4 id4; id4.x = (int)(idw & 0xffffu); id4.y = (int)((idw >> 16) & 0xffffu); id4.z = (int)((idw >> 32) & 0xffffu); id4.w = (int)(idw >> 48);
        const float* scu = (const float*)(ws + WS_SCU); const float* scv = (const float*)(ws + WS_SCV);
        f32x4 o; o.x = gt.x * gelu_f(sacc.x * scu[id4.x]) * scv[id4.x]; o.y = gt.y * gelu_f(sacc.y * scu[id4.y]) * scv[id4.y];
        o.z = gt.z * gelu_f(sacc.z * scu[id4.z]) * scv[id4.z]; o.w = gt.w * gelu_f(sacc.w * scu[id4.w]) * scv[id4.w];
        v4u opk; opk.x = (f2bf(o.x) << 16) | (unsigned)id4.x; opk.y = (f2bf(o.y) << 16) | (unsigned)id4.y; opk.z = (f2bf(o.z) << 16) | (unsigned)id4.z; opk.w = (f2bf(o.w) << 16) | (unsigned)id4.w;
        *(v4u*)((unsigned*)(ws + WS_COEF) + (size_t)idx * 4) = opk;
    }
    xcd_barrier(bar); STAMP(11);

    for (int rep_ = 0; rep_ < REP_OUT; ++rep_) peer_out(XM, tid, ws + WS_VB, (const bf16*)A.out, (float*)(ws + WS_X2), mod, ids, (const float*)(ws + WS_COEF), rss2);
    xcd_barrier(bar); STAMP(12);

    for (int row = gw; row < SEQ; row += NGW) {
        const float rs = (lane < 8) ? rss2[(size_t)lane * SEQ + row] : 0.f;
        const float rn = __builtin_amdgcn_rsqf(wave_sum(rs) * (1.f / 1024.f) + 1e-6f);
        f32x4* o = (f32x4*)(A.out + (size_t)row * 1024) + lane; const f32x4* fw = (const f32x4*)A.final_w + lane;
        const unsigned long long* xi = (const unsigned long long*)((const unsigned short*)(ws + WS_X2) + (size_t)row * 1024) + lane;
        unsigned long long q[4];
#pragma unroll
        for (int j = 0; j < 4; ++j) q[j] = xi[64 * j];
#pragma unroll
        for (int j = 0; j < 4; ++j) o[64 * j] = (f32x4){bflo((unsigned)q[j]), bfhi((unsigned)q[j]), bflo((unsigned)(q[j] >> 32)), bfhi((unsigned)(q[j] >> 32))} * rn * fw[64 * j];
    }
    }
    for (int rep_ = 0; rep_ < REP_BAR; ++rep_) xcd_barrier(bar);
    if (TS_B >= 0) {
        xcd_barrier(bar); STAMP(13);
        xcd_barrier(bar);
        const unsigned long long* stamps = (const unsigned long long*)(A.ws + WS_CTL + 32 * KiB);
        const unsigned long long ta = __hip_atomic_load(&stamps[TS_A >= 0 ? TS_A : 0], __ATOMIC_RELAXED, __HIP_MEMORY_SCOPE_AGENT), tb = __hip_atomic_load(&stamps[TS_B >= 0 ? TS_B : 0], __ATOMIC_RELAXED, __HIP_MEMORY_SCOPE_AGENT);
        const float dtus = (float)(tb - ta) * 0.01f;
        const float scale = 1.f + 0.01f * floorf((dtus + (float)TS_T1) / (float)TS_T2);
        for (size_t i = (size_t)bx * NT + otid(); i < (size_t)SEQ * 1024; i += (size_t)G * NT) A.out[i] *= scale;
    }
}

extern "C" void kernel_launch(void* const* d_in, const int* in_sizes, int n_in, void* d_out, int out_size, void* d_ws, size_t ws_size, hipStream_t stream) {
    static int grid = 0;
    if (grid == 0) {
        if (n_in != 21 || in_sizes[0] != SEQ * DM || out_size != SEQ * DM || ws_size < WS_END) { fprintf(stderr, "kernel_launch: unexpected shapes (n_in %d, ws %zu); nothing launched\n", n_in, ws_size); grid = -1; return; }
        int dev = 0, cus = 0, per_cu = 0;
        if (hipGetDevice(&dev) != hipSuccess || hipDeviceGetAttribute(&cus, hipDeviceAttributeMultiprocessorCount, dev) != hipSuccess) { grid = -1; return; }
        if (hipFuncSetAttribute((const void*)fwd_kernel, hipFuncAttributeMaxDynamicSharedMemorySize, LDS_BYTES) != hipSuccess) { fprintf(stderr, "kernel_launch: hipFuncSetAttribute failed\n"); grid = -1; return; }
        if (hipOccupancyMaxActiveBlocksPerMultiprocessor(&per_cu, (const void*)fwd_kernel, NT, LDS_BYTES) != hipSuccess || per_cu < 1) { fprintf(stderr, "kernel_launch: occupancy query says %d blocks per CU\n", per_cu); }
        (void)hipGetLastError();
        grid = cus;
    }
    if (grid < 0) return;
    (void)hipMemsetAsync((char*)d_ws + WS_CTL, 0, CTL_ZERO_BYTES, stream);
    Args a{};
    a.x = (const float*)d_in[0]; a.c = (const float*)d_in[1]; a.w_ada = (const float*)d_in[2]; a.b_ada = (const float*)d_in[3]; a.norm1_w = (const float*)d_in[4];
    a.w_in = (const float*)d_in[5]; a.gm_norm_w = (const float*)d_in[6]; a.gm_ws = (const float*)d_in[7]; a.gm_bs = (const float*)d_in[8]; a.conv_w = (const float*)d_in[9];
    a.a_log = (const float*)d_in[10]; a.dt_bias = (const float*)d_in[11]; a.o_norm_w = (const float*)d_in[12]; a.w_out = (const float*)d_in[13]; a.norm2_w = (const float*)d_in[14];
    a.peer_wq = (const float*)d_in[15]; a.keys1 = (const float*)d_in[16]; a.keys2 = (const float*)d_in[17]; a.peer_u = (const float*)d_in[18]; a.peer_v = (const float*)d_in[19];
    a.final_w = (const float*)d_in[20]; a.out = (float*)d_out; a.ws = (unsigned char*)d_ws;
    hipLaunchKernelGGL(fwd_kernel, dim3(grid), dim3(NT), LDS_BYTES, stream, a);
}
```

```cpp
#include <hip/hip_runtime.h>
#include <cstdio>
#include <cstdint>

namespace pg8 {
#define PG8_LAS __attribute__((address_space(3)))
typedef unsigned short bf16_t;
typedef short bf16x8 __attribute__((ext_vector_type(8)));
typedef float f32x4 __attribute__((ext_vector_type(4)));
typedef unsigned u32x4 __attribute__((ext_vector_type(4)));
constexpr int BM = 256, BK = 64, HALF = 128, HTB = HALF * BK * 2  , STAGE_BYTES = 8 * HTB, NXCD = 8, WGM = 8;

__host__ __device__ __forceinline__ int lds_byte(int r, int c) { const int st = (r >> 4) * 2 + (c >> 5), rr = r & 15, cc = c & 31, ob = rr * 64 + cc * 2; return st * 1024 + (ob ^ (((ob >> 9) & 1) << 5)); }
__host__ __device__ __forceinline__ void stage_rc(int b, int& R, int& C) { const int st = b / 1024, sb = b % 1024, swz = sb ^ (((sb >> 9) & 1) << 5); R = (st >> 1) * 16 + swz / 64; C = (st & 1) * 32 + (swz % 64) / 2; }
__host__ __device__ __forceinline__ int perm32(int rho) { const int n = rho >> 4, i = rho & 15; return 8 * (i >> 2) + 4 * n + (i & 3); }

struct Unit { int pm, pn; };
struct Gemm { const bf16_t* A; const bf16_t* Bt; int M, N, K; };

struct StaticOrder {
    int nM, nN, nwg, G, c;
    __host__ __device__ void init(int M, int N, int G_, int c_) { nM = M / BM; nN = N / BM; nwg = nM * nN; G = G_; c = c_; }
    __host__ __device__ bool next(int i, Unit& u) const {
        const long L = (long)i * G + c; if (L >= nwg) return false;
        int wgid = (int)L; { const int q = nwg / NXCD, r = nwg % NXCD, xcd = wgid % NXCD, off = wgid / NXCD; wgid = (xcd < r ? xcd * (q + 1) : r * (q + 1) + (xcd - r) * q) + off; }
        const int nig = WGM * nN, gid = wgid / nig, fm = gid * WGM, gsz = (nM - fm) < WGM ? (nM - fm) : WGM;
        u.pm = fm + ((wgid % nig) % gsz); u.pn = (wgid % nig) / gsz; return true;
    }
    __device__ __forceinline__ void a_ready(const Unit&) const {}
    __device__ __forceinline__ void done(const Unit&) const {}
};

__device__ __forceinline__ unsigned cvt_pk_bf16(float lo, float hi) { unsigned r; asm volatile("v_cvt_pk_bf16_f32 %0, %1, %2" : "=v"(r) : "v"(lo), "v"(hi)); return r; }


__device__ __forceinline__ float gelu_fast(float x) {
    const float y = x * (1.5957691216f + 0.0713548163f * x * x);
    return x * __builtin_amdgcn_rcpf(1.f + __builtin_amdgcn_exp2f(-1.4426950409f * y));
}
__device__ __forceinline__ float silu_fast(float x) { return x * __builtin_amdgcn_rcpf(1.f + __builtin_amdgcn_exp2f(-1.4426950409f * x)); }

struct Epi1 {
    static constexpr bool PERM = true, AFTER_DRAIN = false;
    bf16_t* Pgm; bf16_t* Pqkv; bf16_t* Pz; const float* r1; const float* bias1; float* vss; int M;
    __device__ __forceinline__ void operator()(const f32x4 (&acc)[2][2][4][2], const Unit& u, int wr, int wc, int fr, int fq) const {
        const int row0 = u.pm * BM + wr * 64 + fr, colt = u.pn * BM, cl = wc * 32 + 8 * fq;
        f32x4 bv[2][2];
#pragma unroll
        for (int bj = 0; bj < 2; ++bj)
#pragma unroll
            for (int n = 0; n < 2; ++n) bv[bj][n] = *(const f32x4*)(bias1 + colt + cl + bj * HALF + 4 * n);
        float rrv[2][4];
#pragma unroll
        for (int ai = 0; ai < 2; ++ai)
#pragma unroll
            for (int m = 0; m < 4; ++m) rrv[ai][m] = r1[row0 + ai * HALF + m * 16];
#pragma unroll
        for (int ai = 0; ai < 2; ++ai)
#pragma unroll
            for (int m = 0; m < 4; ++m) {
                const int row = row0 + ai * HALF + m * 16;
                const float rr = rrv[ai][m];
                float ssq = 0.f;
#pragma unroll
                for (int bj = 0; bj < 2; ++bj) {
                    f32x4 v0 = acc[ai][bj][m][0] * rr + bv[bj][0], v1 = acc[ai][bj][m][1] * rr + bv[bj][1];
                    const int col = colt + cl + bj * HALF;
                    bf16_t* dst;
                    if (u.pn < 4) {
#pragma unroll
                        for (int e = 0; e < 4; ++e) { v0[e] = gelu_fast(v0[e]); v1[e] = gelu_fast(v1[e]); }
                        ssq += (v0[0] * v0[0] + v0[1] * v0[1]) + (v0[2] * v0[2] + v0[3] * v0[3]) + (v1[0] * v1[0] + v1[1] * v1[1]) + (v1[2] * v1[2] + v1[3] * v1[3]);
                        dst = Pgm + (size_t)row * 1024 + col;
                    } else if (u.pn < 10) {
                        dst = Pqkv + (size_t)row * 1536 + (col - 1024);
                    } else {
#pragma unroll
                        for (int e = 0; e < 4; ++e) { v0[e] = silu_fast(v0[e]); v1[e] = silu_fast(v1[e]); }
                        dst = Pz + (size_t)row * 512 + (col - 2560);
                    }
                    u32x4 w; w.x = cvt_pk_bf16(v0[0], v0[1]); w.y = cvt_pk_bf16(v0[2], v0[3]); w.z = cvt_pk_bf16(v1[0], v1[1]); w.w = cvt_pk_bf16(v1[2], v1[3]);
                    *(u32x4*)dst = w;
                }
                if (u.pn == 2 || u.pn == 3) {
                    ssq += __shfl_xor(ssq, 16); ssq += __shfl_xor(ssq, 32);
                    if (fq == 0) vss[(size_t)((u.pn - 2) * 4 + wc) * M + row] = ssq;
                }
            }
    }
};

struct Epi2 {
    static constexpr bool PERM = true, AFTER_DRAIN = false;
    const float* x; bf16_t* x1u; bf16_t* x1b; const float* gt1; float* rss; int M; const float* a2;
    __device__ __forceinline__ void operator()(const f32x4 (&acc)[2][2][4][2], const Unit& u, int wr, int wc, int fr, int fq) const {
        const int row0 = u.pm * BM + wr * 64 + fr, colt = u.pn * BM, cl = wc * 32 + 8 * fq;
        f32x4 gv[2][2], av[2][2];
#pragma unroll
        for (int bj = 0; bj < 2; ++bj)
#pragma unroll
            for (int n = 0; n < 2; ++n) { gv[bj][n] = *(const f32x4*)(gt1 + colt + cl + bj * HALF + 4 * n); av[bj][n] = *(const f32x4*)(a2 + colt + cl + bj * HALF + 4 * n); }
#pragma unroll
        for (int aim = 0; aim < 4; ++aim) {
            const int ai = aim >> 1;
            f32x4 xin[2][2][2];
#pragma unroll
            for (int mm = 0; mm < 2; ++mm)
#pragma unroll
                for (int bj = 0; bj < 2; ++bj) { const float* xp = x + (size_t)(row0 + ai * HALF + ((aim & 1) * 2 + mm) * 16) * 1024 + colt + cl + bj * HALF; xin[mm][bj][0] = *(const f32x4*)xp; xin[mm][bj][1] = *(const f32x4*)(xp + 4); }
#pragma unroll
            for (int mm = 0; mm < 2; ++mm) {
                const int m = (aim & 1) * 2 + mm;
                const int row = row0 + ai * HALF + m * 16;
                float ssq = 0.f;
#pragma unroll
                for (int bj = 0; bj < 2; ++bj) {
                    const int col = colt + cl + bj * HALF;
                    const f32x4 x0 = xin[mm][bj][0], x1v = xin[mm][bj][1];
                    const f32x4 v0 = x0 + gv[bj][0] * acc[ai][bj][m][0], v1 = x1v + gv[bj][1] * acc[ai][bj][m][1];
                    { u32x4 wu; wu.x = cvt_pk_bf16(v0[0], v0[1]); wu.y = cvt_pk_bf16(v0[2], v0[3]); wu.z = cvt_pk_bf16(v1[0], v1[1]); wu.w = cvt_pk_bf16(v1[2], v1[3]); *(u32x4*)(x1u + (size_t)row * 1024 + col) = wu; }
                    const f32x4 s0 = v0 * av[bj][0], s1 = v1 * av[bj][1];
                    u32x4 w; w.x = cvt_pk_bf16(s0[0], s0[1]); w.y = cvt_pk_bf16(s0[2], s0[3]); w.z = cvt_pk_bf16(s1[0], s1[1]); w.w = cvt_pk_bf16(s1[2], s1[3]);
                    *(u32x4*)(x1b + (size_t)row * 1024 + col) = w;
                    ssq += (v0[0] * v0[0] + v0[1] * v0[1]) + (v0[2] * v0[2] + v0[3] * v0[3]) + (v1[0] * v1[0] + v1[1] * v1[1]) + (v1[2] * v1[2] + v1[3] * v1[3]);
                }
                ssq += __shfl_xor(ssq, 16); ssq += __shfl_xor(ssq, 32);
                if (fq == 0) rss[(size_t)(u.pn * 4 + wc) * M + row] = ssq;
            }
        }
    }
};

struct Epi3 {
    static constexpr bool PERM = true, AFTER_DRAIN = false;
    bf16_t* qq; const float* rss; const float* bias3; int M;
    __device__ __forceinline__ void operator()(const f32x4 (&acc)[2][2][4][2], const Unit& u, int wr, int wc, int fr, int fq) const {
        const int row0 = u.pm * BM + wr * 64 + fr, colt = u.pn * BM, cl = wc * 32 + 8 * fq;
        f32x4 bv[2][2];
#pragma unroll
        for (int bj = 0; bj < 2; ++bj)
#pragma unroll
            for (int n = 0; n < 2; ++n) bv[bj][n] = *(const f32x4*)(bias3 + colt + cl + bj * HALF + 4 * n);
        float rrv[2][4];
#pragma unroll
        for (int ai = 0; ai < 2; ++ai)
#pragma unroll
            for (int m = 0; m < 4; ++m) {
                const int row = row0 + ai * HALF + m * 16;
                float s = 0.f;
#pragma unroll
                for (int i = 0; i < 4; ++i) s += rss[(size_t)(fq * 4 + i) * M + row];
                rrv[ai][m] = s;
            }
#pragma unroll
        for (int ai = 0; ai < 2; ++ai)
#pragma unroll
            for (int m = 0; m < 4; ++m) {
                const int row = row0 + ai * HALF + m * 16;
                float s = rrv[ai][m];
                s += __shfl_xor(s, 16); s += __shfl_xor(s, 32);
                const float rr = __builtin_amdgcn_rsqf(s * (1.f / 1024.f) + 1e-6f);
#pragma unroll
                for (int bj = 0; bj < 2; ++bj) {
                    const f32x4 v0 = acc[ai][bj][m][0] * rr + bv[bj][0], v1 = acc[ai][bj][m][1] * rr + bv[bj][1];
                    const int col = colt + cl + bj * HALF;
                    u32x4 w; w.x = cvt_pk_bf16(v0[0], v0[1]); w.y = cvt_pk_bf16(v0[2], v0[3]); w.z = cvt_pk_bf16(v1[0], v1[1]); w.w = cvt_pk_bf16(v1[2], v1[3]);
                    *(u32x4*)(qq + (size_t)row * 2048 + col) = w;
                }
            }
    }
};

template <class Epi, class Sched, bool ALIGN_EPI = false, bool SP2 = false>
__device__ __forceinline__ void gemm_phase(PG8_LAS unsigned char* lds, const Gemm g, const Sched& S, const Epi& E, const int tid_in) {
    const int tid = tid_in, wid = __builtin_amdgcn_readfirstlane(tid >> 6), lane = tid & 63, wr = wid >> 2, wc = wid & 3, fr = lane & 15, fq = lane >> 4;
    const int K = g.K, nt = K / BK;
    unsigned voffA[2], voffB[2];
#pragma unroll
    for (int i = 0; i < 2; ++i) { int R, C; stage_rc(tid * 16 + i * 8192, R, C); const int Rb = Epi::PERM ? ((R & ~31) + perm32(R & 31)) : R;
        voffA[i] = (unsigned)(R * K + C) * 2u; voffB[i] = (unsigned)(Rb * K + C) * 2u; }
    const size_t kstep = (size_t)(BK * 2);
    const size_t hstep = (size_t)HALF * K * 2;
    const size_t tstep = 2 * hstep;
    const unsigned ldsw = (unsigned)wid * 1024u;
    const int aoff = lds_byte(wr * 64 + fr, fq * 8), boff = lds_byte(wc * 32 + fr, fq * 8);
#define PG8_SA(b, h) (((b) * 2 + (h)) * HTB)
#define PG8_SB(b, h) ((4 + (b) * 2 + (h)) * HTB)
#define PG8_STAGE(bufoff, gbase, voff) do { _Pragma("unroll") for (int _i = 0; _i < 2; ++_i) \
        __builtin_amdgcn_global_load_lds((const unsigned*)((const char*)(gbase) + (voff)[_i]), (PG8_LAS unsigned*)(lds + (bufoff) + ldsw + _i * 8192), 16, 0, 0); } while (0)
#define PG8_LDA(dst, b, h) do { _Pragma("unroll") for (int m = 0; m < 4; ++m) _Pragma("unroll") for (int k = 0; k < 2; ++k) dst[m][k] = *(const PG8_LAS bf16x8*)(lds + PG8_SA(b, h) + aoff + m * 2048 + k * 1024); } while (0)
#define PG8_LDB(dst, b, h) do { _Pragma("unroll") for (int n = 0; n < 2; ++n) _Pragma("unroll") for (int k = 0; k < 2; ++k) dst[n][k] = *(const PG8_LAS bf16x8*)(lds + PG8_SB(b, h) + boff + n * 2048 + k * 1024); } while (0)
#define PG8_MMA(ai, bj, At, Bt) do { __builtin_amdgcn_s_setprio(1); _Pragma("unroll") for (int m = 0; m < 4; ++m) _Pragma("unroll") for (int n = 0; n < 2; ++n) _Pragma("unroll") for (int k = 0; k < 2; ++k) \
        acc[ai][bj][m][n] = __builtin_amdgcn_mfma_f32_16x16x32_bf16(Bt[n][k], At[m][k], acc[ai][bj][m][n], 0, 0, 0); __builtin_amdgcn_s_setprio(0); } while (0)
#define PG8_WAIT_V(n) asm volatile("s_waitcnt vmcnt(" #n ")" ::: "memory")
#define PG8_WAIT_L(n) asm volatile("s_waitcnt lgkmcnt(" #n ")" ::: "memory")
#define PG8_BAR __builtin_amdgcn_s_barrier()
#define PG8_SCHED __builtin_amdgcn_sched_barrier(0)
    Unit cur, nxt; int ui = 0;
    if (!S.next(0, cur)) return;
    f32x4 acc[2][2][4][2];
#pragma unroll
    for (int a = 0; a < 2; ++a)
#pragma unroll
        for (int b = 0; b < 2; ++b)
#pragma unroll
            for (int m = 0; m < 4; ++m)
#pragma unroll
                for (int n = 0; n < 2; ++n) acc[a][b][m][n] = (f32x4){0.f, 0.f, 0.f, 0.f};
    bf16x8 At[4][2], B0[2][2], B1[2][2];
    const char* cA = (const char*)g.A + (size_t)cur.pm * tstep; const char* cB = (const char*)g.Bt + (size_t)cur.pn * tstep;
    S.a_ready(cur);
    if constexpr (SP2) {
        PG8_STAGE(PG8_SB(0, 0), cB, voffB); PG8_STAGE(PG8_SB(0, 1), cB + hstep, voffB); PG8_STAGE(PG8_SA(0, 0), cA, voffA); PG8_STAGE(PG8_SA(0, 1), cA + hstep, voffA);
        if (wr == 1) PG8_BAR;
        PG8_WAIT_V(2); PG8_BAR;
        PG8_STAGE(PG8_SB(1, 0), cB + kstep, voffB); PG8_STAGE(PG8_SA(1, 0), cA + kstep, voffA); PG8_STAGE(PG8_SB(1, 1), cB + hstep + kstep, voffB);
        PG8_WAIT_V(6); PG8_BAR;
    } else {
        PG8_STAGE(PG8_SB(0, 0), cB, voffB); PG8_STAGE(PG8_SA(0, 0), cA, voffA); PG8_STAGE(PG8_SB(0, 1), cB + hstep, voffB); PG8_STAGE(PG8_SA(0, 1), cA + hstep, voffA);
        if (wr == 1) PG8_BAR;
        PG8_WAIT_V(4); PG8_BAR;
        PG8_STAGE(PG8_SB(1, 0), cB + kstep, voffB); PG8_STAGE(PG8_SA(1, 0), cA + kstep, voffA); PG8_STAGE(PG8_SB(1, 1), cB + hstep + kstep, voffB);
        PG8_WAIT_V(6); PG8_BAR;
    }
    for (;;) {
        const bool has_next = S.next(ui + 1, nxt);
        const char* nA = has_next ? (const char*)g.A + (size_t)nxt.pm * tstep : cA; const char* nB = has_next ? (const char*)g.Bt + (size_t)nxt.pn * tstep : cB;
        for (int t = 0; t < nt; t += 2) {
            const bool last = (t == nt - 2);
            const char* a1 = cA + (size_t)(t + 1) * kstep;
            const char* a2 = last ? nA : cA + (size_t)(t + 2) * kstep; const char* b2 = last ? nB : cB + (size_t)(t + 2) * kstep;
            const char* a3 = a2 + kstep; const char* b3 = b2 + kstep;
            if (last && has_next) S.a_ready(nxt);
            if constexpr (SP2) {
            PG8_LDB(B0, 0, 0); PG8_LDB(B1, 0, 1); PG8_SCHED; PG8_LDA(At, 0, 0); PG8_STAGE(PG8_SA(1, 1), a1 + hstep, voffA);
            PG8_WAIT_V(8); PG8_WAIT_L(0); PG8_BAR; PG8_MMA(0, 0, At, B0); PG8_MMA(0, 1, At, B1); PG8_BAR; PG8_SCHED;
            PG8_LDA(At, 0, 1); PG8_STAGE(PG8_SB(0, 0), b2, voffB); PG8_STAGE(PG8_SB(0, 1), b2 + hstep, voffB); PG8_STAGE(PG8_SA(0, 0), a2, voffA);
            PG8_WAIT_V(8); PG8_WAIT_L(0); PG8_BAR; PG8_MMA(1, 0, At, B0); PG8_MMA(1, 1, At, B1); PG8_BAR; PG8_SCHED;
            PG8_LDB(B0, 1, 0); PG8_LDB(B1, 1, 1); PG8_SCHED; PG8_LDA(At, 1, 0); PG8_STAGE(PG8_SA(0, 1), a2 + hstep, voffA);
            PG8_WAIT_V(8); PG8_WAIT_L(0); PG8_BAR; PG8_MMA(0, 0, At, B0); PG8_MMA(0, 1, At, B1); PG8_BAR; PG8_SCHED;
            PG8_LDA(At, 1, 1); PG8_STAGE(PG8_SB(1, 0), b3, voffB); PG8_STAGE(PG8_SB(1, 1), b3 + hstep, voffB); PG8_STAGE(PG8_SA(1, 0), a3, voffA);
            PG8_WAIT_V(8); PG8_WAIT_L(0); PG8_BAR; PG8_MMA(1, 0, At, B0); PG8_MMA(1, 1, At, B1); PG8_BAR; PG8_SCHED;
            } else {
            PG8_LDB(B0, 0, 0); PG8_SCHED; PG8_LDA(At, 0, 0); PG8_STAGE(PG8_SA(1, 1), a1 + hstep, voffA);
            PG8_WAIT_L(8); PG8_BAR; PG8_WAIT_L(0); PG8_MMA(0, 0, At, B0); PG8_BAR; PG8_SCHED;
            PG8_LDB(B1, 0, 1); PG8_STAGE(PG8_SB(0, 0), b2, voffB);
            PG8_BAR; PG8_WAIT_L(0); PG8_MMA(0, 1, At, B1); PG8_BAR;
            PG8_LDA(At, 0, 1); PG8_STAGE(PG8_SA(0, 0), a2, voffA);
            PG8_BAR; PG8_WAIT_L(0); PG8_MMA(1, 0, At, B0); PG8_BAR; PG8_SCHED;
            PG8_STAGE(PG8_SB(0, 1), b2 + hstep, voffB);
            PG8_WAIT_V(6); PG8_BAR; PG8_MMA(1, 1, At, B1); PG8_BAR;
            PG8_LDB(B0, 1, 0); PG8_SCHED; PG8_LDA(At, 1, 0); PG8_STAGE(PG8_SA(0, 1), a2 + hstep, voffA);
            PG8_WAIT_L(8); PG8_BAR; PG8_WAIT_L(0); PG8_MMA(0, 0, At, B0); PG8_BAR; PG8_SCHED;
            PG8_LDB(B1, 1, 1); PG8_STAGE(PG8_SB(1, 0), b3, voffB);
            PG8_BAR; PG8_WAIT_L(0); PG8_MMA(0, 1, At, B1); PG8_BAR;
            PG8_LDA(At, 1, 1); PG8_STAGE(PG8_SA(1, 0), a3, voffA);
            PG8_BAR; PG8_WAIT_L(0); PG8_MMA(1, 0, At, B0); PG8_BAR; PG8_SCHED;
            PG8_STAGE(PG8_SB(1, 1), b3 + hstep, voffB);
            PG8_WAIT_V(6); PG8_BAR; PG8_MMA(1, 1, At, B1); PG8_BAR;
            }
        }
        if constexpr (ALIGN_EPI) { if (wr == 0) PG8_BAR; }
        if constexpr (!Epi::AFTER_DRAIN) { E(acc, cur, wr, wc, fr, fq); S.done(cur); }
        if (!has_next) break;
#pragma unroll
        for (int a = 0; a < 2; ++a)
#pragma unroll
            for (int b = 0; b < 2; ++b)
#pragma unroll
                for (int m = 0; m < 4; ++m)
#pragma unroll
                    for (int n = 0; n < 2; ++n) acc[a][b][m][n] = (f32x4){0.f, 0.f, 0.f, 0.f};
        cur = nxt; cA = nA; cB = nB; ++ui;
        if constexpr (ALIGN_EPI) { if (wr == 1) PG8_BAR; }
    }
    PG8_WAIT_V(0);
    if constexpr (!ALIGN_EPI) { if (wr == 0) PG8_BAR; }
    PG8_BAR;
    if constexpr (Epi::AFTER_DRAIN) { E.fused(acc, cur, wr, wc, fr, fq, lds, wid, lane); S.done(cur); }
#undef PG8_SA
#undef PG8_SB
#undef PG8_STAGE
#undef PG8_LDA
#undef PG8_LDB
#undef PG8_MMA
#undef PG8_WAIT_V
#undef PG8_WAIT_L
#undef PG8_BAR
#undef PG8_SCHED
}
}


#define GAS __attribute__((address_space(1)))
#define LAS __attribute__((address_space(3)))
typedef unsigned short bf16;
typedef unsigned v4u __attribute__((ext_vector_type(4)));
typedef float f32x4 __attribute__((ext_vector_type(4)));
#define LDS_WAIT() asm volatile("s_waitcnt lgkmcnt(0)" ::: "memory")
#define VM_WAIT() asm volatile("s_waitcnt vmcnt(0)" ::: "memory")
__device__ __forceinline__ unsigned f2bf(float f) { unsigned u = __builtin_bit_cast(unsigned, f); return (u + 0x7fffu + ((u >> 16) & 1u)) >> 16; }
__device__ __forceinline__ unsigned pk2(float lo, float hi) { return f2bf(lo) | (f2bf(hi) << 16); }
__device__ __forceinline__ float bf2f(unsigned h) { return __builtin_bit_cast(float, h << 16); }
__device__ __forceinline__ float bflo(unsigned w) { return __builtin_bit_cast(float, w << 16); }
__device__ __forceinline__ float bfhi(unsigned w) { return __builtin_bit_cast(float, w & 0xffff0000u); }
__device__ __forceinline__ float wave_sum(float v) {
#pragma unroll
    for (int o = 32; o > 0; o >>= 1) v += __shfl_xor(v, o);
    return v;
}
__device__ __forceinline__ float gelu_f(float x) { return pg8::gelu_fast(x); }
__device__ __forceinline__ float silu_f(float x) { return x / (1.f + __expf(-x)); }

#define XB_TMO      128
#define XB_XCNT(j)  (256  + 64 * (j))
#define XB_XSUB(j)  (1280 + 64 * (j))
#define XB_XGEN(j)  (2304 + 64 * (j))
#define XB_TOP      3328
#define XB_TOPGEN   3392
#define XCD_BAR_WORDS 3456
#define XB_SPIN_CAP (1u << 24)

__device__ __forceinline__ unsigned xb_ld(unsigned* p)              { return __hip_atomic_load(p, __ATOMIC_RELAXED, __HIP_MEMORY_SCOPE_AGENT); }
__device__ __forceinline__ unsigned xb_add(unsigned* p, unsigned v) { return __hip_atomic_fetch_add(p, v, __ATOMIC_RELAXED, __HIP_MEMORY_SCOPE_AGENT); }
__device__ __forceinline__ unsigned xb_xcc_id() { return (unsigned)__builtin_amdgcn_s_getreg((3 << 11) | 20) & 0xFu; }
#define XB_SPIN(cond, bar) do { unsigned _sp = 0; while (cond) { __builtin_amdgcn_s_sleep(1); \
    if ((++_sp & 255u) == 0u) { if (xb_ld(&(bar)[XB_TMO])) break; if (_sp > XB_SPIN_CAP) { atomicAdd(&(bar)[XB_TMO], 1u); break; } } } } while (0)

struct XcdBarrier {
    unsigned* bar; unsigned x; int w;
    volatile LAS unsigned* st;
};

__device__ __forceinline__ XcdBarrier xcd_barrier_post(unsigned* bar, volatile LAS unsigned* st) {
    XcdBarrier b; b.bar = bar; b.x = xb_xcc_id(); b.st = st;
    if (threadIdx.x == 0) (void)xb_add(&bar[XB_XCNT(b.x)], 1u);
    return b;
}
__device__ __forceinline__ void xcd_barrier_complete(unsigned* bar, unsigned x, unsigned& nloc, unsigned& nx) {
    const unsigned G = gridDim.x * gridDim.y * gridDim.z;
    unsigned sum, cnt, mine, sp = 0u;
    for (;;) {
        sum = 0u; cnt = 0u; mine = 0u;
#pragma unroll
        for (unsigned j = 0; j < 16; ++j) { const unsigned c = xb_ld(&bar[XB_XCNT(j)]); sum += c; cnt += (c > 0u) ? 1u : 0u; mine = (j == x) ? c : mine; }
        if (sum == G) break;
        __builtin_amdgcn_s_sleep(1);
        if ((++sp & 255u) == 0u) { if (xb_ld(&bar[XB_TMO])) break; if (sp > XB_SPIN_CAP) { atomicAdd(&bar[XB_TMO], 1u); break; } }
    }
    nloc = mine > 0u ? mine : 1u; nx = cnt > 0u ? cnt : 1u;
}

__device__ __forceinline__ void xcd_barrier(const XcdBarrier& b) {
    asm volatile("s_waitcnt vmcnt(0)" ::: "memory");
    __syncthreads();
    if (b.w == 1 && __builtin_amdgcn_mbcnt_hi(~0u, __builtin_amdgcn_mbcnt_lo(~0u, 0u)) == 0u) asm volatile("buffer_inv sc1\n\ts_waitcnt vmcnt(0)" ::: "memory");
    if (b.w == 0 && __builtin_amdgcn_mbcnt_hi(~0u, __builtin_amdgcn_mbcnt_lo(~0u, 0u)) == 0u) {
        unsigned* bar = b.bar;
        __builtin_amdgcn_s_waitcnt(0);
        unsigned nloc = b.st[0], nx = b.st[1];
        if (nloc == 0u) { xcd_barrier_complete(bar, b.x, nloc, nx); b.st[0] = nloc; b.st[1] = nx; }
        const unsigned old = xb_add(&bar[XB_XSUB(b.x)], 1u);
        const unsigned gen = old / nloc;
        if (old + 1u == (gen + 1u) * nloc) {
            __builtin_amdgcn_fence(__ATOMIC_RELEASE, "agent");
            asm volatile("s_waitcnt vmcnt(0)" ::: "memory");
            const unsigned og = xb_add(&bar[XB_TOP], 1u);
            const unsigned tg = og / nx;
            if (og + 1u == (tg + 1u) * nx) xb_add(&bar[XB_TOPGEN], 1u);
            else XB_SPIN(xb_ld(&bar[XB_TOPGEN]) == tg, bar);
            xb_add(&bar[XB_XGEN(b.x)], 1u);
        } else {
            XB_SPIN(xb_ld(&bar[XB_XGEN(b.x)]) == gen, bar);
        }
    }
    __syncthreads();
}


constexpr int TS_A = -1, TS_B = -1, TS_T1 = 100, TS_T2 = 200;
constexpr int REP_GEMM1 = 1, REP_GMLP = 1, REP_DNPREP = 1, REP_SCAN = 1, REP_DNOUT = 1, REP_GEMM3 = 1, REP_ROUTE = 1, REP_PRE = 1, REP_CONV = 1, REP_P0 = 1, REP_P1 = 1, REP_OUT = 1, REP_P10 = 1, REP_BAR = 0, BARV = 0;
constexpr int SEQ = 16384, DM = 1024, DIN = 3080, NWAVES = 8, NT = 512;
constexpr size_t KiB = 1024, MiB = 1u << 20;
constexpr size_t WS_CTL = 0, CTL_ZERO_BYTES = 64 * KiB;
constexpr size_t WS_MOD = 64 * KiB, WS_A2 = 88 * KiB  , WS_BIAS1 = 96 * KiB, WS_BIAS3 = 112 * KiB, WS_R1 = 128 * KiB, WS_RSS2 = 192 * KiB  , WS_G = 1280 * KiB, WS_BETA = 1536 * KiB, WS_PAB = 1792 * KiB;
constexpr size_t WS_W1T = 3 * MiB, WS_W2T = 9 * MiB, WS_W3T = 11 * MiB, WS_K1B = 15 * MiB, WS_K2B = 15 * MiB + 256 * KiB, WS_GWB = 15 * MiB + 512 * KiB;
constexpr size_t WS_XB = 16 * MiB;
constexpr size_t WS_PGM = 48 * MiB;
constexpr size_t WS_PQKV = 80 * MiB;
constexpr size_t WS_PZ = 128 * MiB;
constexpr size_t WS_WC = 144 * MiB, WS_KDT = 160 * MiB, WS_UC = 176 * MiB, WS_QD = 192 * MiB, WS_AT = 208 * MiB;
constexpr size_t WS_UB = 96 * MiB, WS_VB = 112 * MiB;
constexpr size_t WS_SLAB = 128 * MiB, WS_X2 = 128 * MiB;
constexpr size_t WS_PHI = 216 * MiB, WS_SL = 220 * MiB, WS_SS = 224 * MiB;
constexpr size_t WS_SCU = 2304 * KiB, WS_SCV = 2368 * KiB;
constexpr size_t WS_IDS = 48 * MiB, WS_GATES = 56 * MiB, WS_COEF = 248 * MiB, WS_END = 256 * MiB;
constexpr int LDS_BYTES = 147456, LDSCTL_OFF = 146944, MISC_OFF = LDSCTL_OFF + 64;

struct Args {
    const float *x, *c, *w_ada, *b_ada, *norm1_w, *w_in, *gm_norm_w, *gm_ws, *gm_bs, *conv_w, *a_log, *dt_bias, *o_norm_w, *w_out, *norm2_w, *peer_wq, *keys1, *keys2, *peer_u, *peer_v, *final_w;
    float* out; unsigned char* ws;
};

template <int NC>
__device__ __forceinline__ void gemv_item(const LAS float* vec, const float* W, int ldw, int col0, int ncols, float* out, const float* addb, LAS float* part, int tid) {
    constexpr int KG = 512 / NC, KL = 1024 / KG;
    const int c = tid & (NC - 1), kg = tid / NC, col = col0 + c;
    float acc = 0.f;
    if (col < ncols) {
        const float* wp = W + (size_t)(kg * KL) * ldw + col;
#pragma unroll 32
        for (int k = 0; k < KL; ++k) acc += vec[kg * KL + k] * wp[(size_t)k * ldw];
    }
    part[kg * NC + c] = acc;
    __syncthreads();
    if (tid < NC && col < ncols) {
        float s = 0.f;
#pragma unroll
        for (int g = 0; g < KG; ++g) s += part[g * NC + c];
        out[col] = s + (addb ? addb[col] : 0.f);
    }
    __syncthreads();
}
__device__ __forceinline__ void transpose_item(const float* W, int ldw, int K, int nblk, bf16* WT, LAS float* scr, int item, int lane, const float* nw, const float* sc) {
    const int kb = item / nblk, nb = item % nblk, k0 = 64 * kb, n0 = 32 * nb;
#pragma unroll 16
    for (int i = 0; i < 32; ++i) {
        const int kk = 2 * i + (lane >> 5);
        float s = 1.f;
        if (nw) s = nw[k0 + kk] * (1.f + sc[k0 + kk]);
        scr[kk * 33 + (lane & 31)] = W[(size_t)(k0 + kk) * ldw + n0 + (lane & 31)] * s;
    }
    LDS_WAIT(); asm volatile("" ::: "memory");
    const int c = lane & 7;
#pragma unroll
    for (int j = 0; j < 4; ++j) {
        const int n = (lane >> 3) + 8 * j; const LAS float* s = scr + (8 * c) * 33 + n;
        v4u o; o.x = pk2(s[0 * 33], s[1 * 33]); o.y = pk2(s[2 * 33], s[3 * 33]); o.z = pk2(s[4 * 33], s[5 * 33]); o.w = pk2(s[6 * 33], s[7 * 33]);
        *(v4u*)(WT + (size_t)(n0 + n) * K + k0 + 8 * c) = o;
    }
    LDS_WAIT(); asm volatile("" ::: "memory");
}

typedef short s16x8 __attribute__((ext_vector_type(8)));
typedef unsigned short u16;
__device__ __forceinline__ unsigned cvtpk(float lo, float hi) { return pg8::cvt_pk_bf16(lo, hi); }
typedef float dn_f32x2 __attribute__((ext_vector_type(2)));
typedef __bf16 dn_bf16x2 __attribute__((ext_vector_type(2)));
__device__ __forceinline__ unsigned cvtpk_c(float lo, float hi) { const dn_f32x2 v = {lo, hi}; return __builtin_bit_cast(unsigned, __builtin_convertvector(v, dn_bf16x2)); }
__device__ __forceinline__ s16x8 pack8(const f32x4 a, const f32x4 b) {
    v4u w; w.x = cvtpk(a[0], a[1]); w.y = cvtpk(a[2], a[3]); w.z = cvtpk(b[0], b[1]); w.w = cvtpk(b[2], b[3]);
    return __builtin_bit_cast(s16x8, w);
}
#define MFMA16(a, b, c) __builtin_amdgcn_mfma_f32_16x16x32_bf16((a), (b), (c), 0, 0, 0)

constexpr int DNP_HALF_BYTES = 61440;
constexpr int DNP_QT = 0, DNP_KT = 17408, DNP_LM = 34816, DNP_AM = 51200, DNP_MISC = 60416, DNP_ROW = 272  , DNP_XROW = 528  ;

__device__ __forceinline__ void dn_prep(LAS unsigned char* lds, int bx, int G, int tid, const bf16* Pqkv, const float* pab, const float* conv_w, const float* a_log, const float* dt_bias,
                                        bf16* Wc, bf16* KdT, bf16* Uc, bf16* Qd, bf16* At, float* glb, unsigned long long* st) {
    const int lane0 = tid & 63, wave = tid >> 6, half = wave >> 2, hw = wave & 3, ht0 = tid & 255;
    const int niter = (1024 + 2 * G - 1) / (2 * G);
    for (int it = 0; it < niter; ++it) {
        int opq = 0; asm volatile("" : "+v"(opq));
        const int lane = lane0 + opq, ht = ht0 + opq;
        LAS unsigned char* L = lds + half * DNP_HALF_BYTES + opq;
        LAS float* Lm = (LAS float*)(L + DNP_LM);
        LAS float* gcs = (LAS float*)(L + DNP_MISC); LAS float* bts = gcs + 64; LAS float* egs = gcs + 128; LAS float* eks = gcs + 192;
        const int u = (it * G + bx) * 2 + half;
        const bool active = u < 1024;
        const int n = u >> 2, h = u & 3, t0 = n * 64, ui = h * 256 + n;
        float X[64]; float xm3 = 0.f, xm2 = 0.f, xm1 = 0.f;
        if (active) {
            const int i0 = 16 * hw;
            const int chq = h * 128 + 2 * lane, chk = 512 + h * 128 + 2 * lane;
            float wq0[4], wq1[4], wk0[4], wk1[4];
#pragma unroll
            for (int j = 0; j < 4; ++j) { wq0[j] = conv_w[j * 1536 + chq]; wq1[j] = conv_w[j * 1536 + chq + 1]; wk0[j] = conv_w[j * 1536 + chk]; wk1[j] = conv_w[j * 1536 + chk + 1]; }
            unsigned xq[19], xk[19];
#pragma unroll
            for (int r = 0; r < 19; ++r) {
                const int tt = t0 + i0 - 3 + r;
                xq[r] = 0u; xk[r] = 0u;
                if (tt >= 0) { xq[r] = *(const unsigned*)(Pqkv + (size_t)tt * 1536 + chq); xk[r] = *(const unsigned*)(Pqkv + (size_t)tt * 1536 + chk); }
            }
            if (ht < 128) {
                const int chv = 1024 + h * 128 + ht;
                xm3 = xm2 = xm1 = 0.f;
                if (t0 > 0) { xm3 = bf2f(Pqkv[(size_t)(t0 - 3) * 1536 + chv]); xm2 = bf2f(Pqkv[(size_t)(t0 - 2) * 1536 + chv]); xm1 = bf2f(Pqkv[(size_t)(t0 - 1) * 1536 + chv]); }
#pragma unroll
                for (int i = 0; i < 64; ++i) X[i] = bf2f(Pqkv[(size_t)(t0 + i) * 1536 + chv]);
            }
#pragma unroll
            for (int r = 0; r < 16; ++r) {
                float q0 = 0.f, q1 = 0.f, k0 = 0.f, k1 = 0.f;
#pragma unroll
                for (int j = 0; j < 4; ++j) { q0 += wq0[j] * bflo(xq[r + j]); q1 += wq1[j] * bfhi(xq[r + j]); k0 += wk0[j] * bflo(xk[r + j]); k1 += wk1[j] * bfhi(xk[r + j]); }
                q0 = silu_f(q0); q1 = silu_f(q1); k0 = silu_f(k0); k1 = silu_f(k1);
                *(LAS unsigned*)(L + DNP_QT + (i0 + r) * DNP_ROW + lane * 4) = cvtpk(q0, q1);
                *(LAS unsigned*)(L + DNP_KT + (i0 + r) * DNP_ROW + lane * 4) = cvtpk(k0, k1);
            }
            if (hw == 0) {
                const float a = pab[(size_t)(t0 + lane) * 8 + h], b = pab[(size_t)(t0 + lane) * 8 + 4 + h];
                const float xx = a + dt_bias[h];
                const float sp = xx > 20.f ? xx : log1pf(__expf(xx));
                const float g = -__expf(a_log[h]) * sp;
                float gc = g;
#pragma unroll
                for (int off = 1; off < 64; off <<= 1) { const float tq = __shfl_up(gc, off); if (lane >= off) gc += tq; }
                const float glast = __shfl(gc, 63);
                gcs[lane] = gc; bts[lane] = 1.f / (1.f + __expf(-b)); egs[lane] = __expf(gc); eks[lane] = __expf(glast - gc);
                if (lane == 63) glb[ui] = __expf(gc);
            }
        }
        if (st && it == 0 && bx == 0 && tid == 0) st[21] = __builtin_amdgcn_s_memrealtime();
        __syncthreads();
        LAS float* rks = (LAS float*)(lds + 131072 + half * 512); LAS float* rqs = rks + 64;
        if (active) {
            const int mt = hw, fr = lane & 15, g = lane >> 4;
            s16x8 Ka[4], Qa[4];
#pragma unroll
            for (int s = 0; s < 4; ++s) {
                Ka[s] = *(const LAS s16x8*)(L + DNP_KT + (16 * mt + fr) * DNP_ROW + (32 * s + 8 * g) * 2);
                Qa[s] = *(const LAS s16x8*)(L + DNP_QT + (16 * mt + fr) * DNP_ROW + (32 * s + 8 * g) * 2);
            }
            f32x4 dK = {0.f, 0.f, 0.f, 0.f}, dQ = {0.f, 0.f, 0.f, 0.f};
#pragma unroll
            for (int s = 0; s < 4; ++s) { dK = MFMA16(Ka[s], Ka[s], dK); dQ = MFMA16(Qa[s], Qa[s], dQ); }
            if ((fr >> 2) == g) {
                const int r = fr & 3;
                const float sk = r == 0 ? dK[0] : r == 1 ? dK[1] : r == 2 ? dK[2] : dK[3], sq = r == 0 ? dQ[0] : r == 1 ? dQ[1] : r == 2 ? dQ[2] : dQ[3];
                rks[16 * mt + fr] = __builtin_amdgcn_rsqf(sk + 1e-6f);
                rqs[16 * mt + fr] = __builtin_amdgcn_rsqf(sq + 1e-6f) * 0.08838834764831845f;
            }
        }
        __syncthreads();
        if (active) {
            const int mt = hw, fr = lane & 15, g = lane >> 4;
            s16x8 Ka[4], Qa[4];
#pragma unroll
            for (int s = 0; s < 4; ++s) {
                Ka[s] = *(const LAS s16x8*)(L + DNP_KT + (16 * mt + fr) * DNP_ROW + (32 * s + 8 * g) * 2);
                Qa[s] = *(const LAS s16x8*)(L + DNP_QT + (16 * mt + fr) * DNP_ROW + (32 * s + 8 * g) * 2);
            }
#pragma unroll
            for (int nt = 0; nt < 4; ++nt) {
                const int j = 16 * nt + fr;
                if (nt <= mt) {
                    f32x4 aK = {0.f, 0.f, 0.f, 0.f}, aA = {0.f, 0.f, 0.f, 0.f};
#pragma unroll
                    for (int s = 0; s < 4; ++s) {
                        const s16x8 Kb = *(const LAS s16x8*)(L + DNP_KT + (16 * nt + fr) * DNP_ROW + (32 * s + 8 * g) * 2);
                        aK = MFMA16(Ka[s], Kb, aK); aA = MFMA16(Qa[s], Kb, aA);
                    }
                    const float gj = gcs[j], rkj = rks[j];
#pragma unroll
                    for (int r = 0; r < 4; ++r) {
                        const int i = 16 * mt + 4 * g + r;
                        const float dec = __expf(fminf(gcs[i] - gj, 0.f)) * rkj;
                        Lm[i * 64 + j] = (i > j) ? -(bts[i] * rks[i] * aK[r] * dec) : 0.f;
                        *(LAS u16*)(L + DNP_AM + i * 144 + j * 2) = (u16)f2bf((i >= j) ? aA[r] * rqs[i] * dec : 0.f);
                    }
                } else {
#pragma unroll
                    for (int r = 0; r < 4; ++r) { const int i = 16 * mt + 4 * g + r; *(LAS u16*)(L + DNP_AM + i * 144 + j * 2) = (u16)0; }
                }
            }
#pragma unroll
            for (int k = 0; k < 4; ++k) {
                const int p = k * 256 + ht, f = p >> 6, lp = p & 63, pm = f >> 2, ps = f & 3, i = 16 * pm + (lp & 15), gp = lp >> 4;
                const LAS unsigned char* src = L + DNP_QT + i * DNP_ROW + (32 * ps + 4 * gp) * 2;
                const unsigned long long lo = *(const LAS unsigned long long*)src, hi = *(const LAS unsigned long long*)(src + 32);
                const float e = egs[i] * rqs[i];
                v4u o;
                o.x = cvtpk(bflo((unsigned)lo) * e, bfhi((unsigned)lo) * e); o.y = cvtpk(bflo((unsigned)(lo >> 32)) * e, bfhi((unsigned)(lo >> 32)) * e);
                o.z = cvtpk(bflo((unsigned)hi) * e, bfhi((unsigned)hi) * e); o.w = cvtpk(bflo((unsigned)(hi >> 32)) * e, bfhi((unsigned)(hi >> 32)) * e);
                *(v4u*)((unsigned char*)Qd + (size_t)ui * 16384 + (size_t)p * 16) = o;
            }
#pragma unroll
            for (int k = 0; k < 4; ++k) {
                const int p = k * 256 + ht, f = p >> 6, lp = p & 63, pm = f >> 1, ps = f & 1, dk = 16 * pm + (lp & 15), gp = lp >> 4;
                float vv[8];
#pragma unroll
                for (int jj = 0; jj < 8; ++jj) { const int i = 32 * ps + 16 * (jj >> 2) + 4 * gp + (jj & 3); vv[jj] = bf2f(*(const LAS u16*)(L + DNP_KT + i * DNP_ROW + dk * 2)) * (eks[i] * rks[i]); }
                v4u o; o.x = cvtpk(vv[0], vv[1]); o.y = cvtpk(vv[2], vv[3]); o.z = cvtpk(vv[4], vv[5]); o.w = cvtpk(vv[6], vv[7]);
                *(v4u*)((unsigned char*)KdT + (size_t)ui * 16384 + (size_t)p * 16) = o;
            }
        }
        if (st && it == 0 && bx == 0 && tid == 0) st[22] = __builtin_amdgcn_s_memrealtime();
        __syncthreads();
        if (active) {
            const int c = ht;
            if (c < 128) {
                const int ch = 1024 + h * 128 + c;
                float w0 = conv_w[ch], w1 = conv_w[1536 + ch], w2 = conv_w[2 * 1536 + ch], w3 = conv_w[3 * 1536 + ch];
#pragma unroll
                for (int i = 63; i >= 0; --i) {
                    const float a3 = X[i], a2 = (i >= 1) ? X[i - 1] : xm1, a1 = (i >= 2) ? X[i - 2] : ((i == 1) ? xm1 : xm2), a0 = (i >= 3) ? X[i - 3] : ((i == 2) ? xm1 : ((i == 1) ? xm2 : xm3));
                    X[i] = silu_f(w0 * a0 + w1 * a1 + w2 * a2 + w3 * a3) * bts[i];
                }
            } else {
                const int dk = c - 128;
#pragma unroll
                for (int i = 0; i < 64; ++i) X[i] = bf2f(*(const LAS u16*)(L + DNP_KT + i * DNP_ROW + dk * 2)) * (bts[i] * egs[i] * rks[i]);
            }
        }
        LAS float* Tm = (LAS float*)(lds + 2 * DNP_HALF_BYTES + half * 4096);
        if (active && ht < 64) {
            const int tb = ht >> 4, tc = ht & 15;
            float xt[16];
#pragma unroll
            for (int r = 0; r < 16; ++r) {
                float acc = (r == tc) ? 1.f : 0.f;
#pragma unroll
                for (int j = 0; j < r; ++j) acc += Lm[(16 * tb + r) * 64 + 16 * tb + j] * xt[j];
                xt[r] = acc;
            }
#pragma unroll
            for (int r = 0; r < 16; ++r) Tm[(tb * 16 + r) * 16 + tc] = xt[r];
        }
        if (st && it == 0 && bx == 0 && tid == 0) st[23] = __builtin_amdgcn_s_memrealtime();
        __syncthreads();
        if (active) {
            LAS unsigned char* rt = L + ht * 128;
#pragma unroll
            for (int q = 0; q < 8; ++q) {
                v4u o; o.x = cvtpk(X[8 * q], X[8 * q + 1]); o.y = cvtpk(X[8 * q + 2], X[8 * q + 3]); o.z = cvtpk(X[8 * q + 4], X[8 * q + 5]); o.w = cvtpk(X[8 * q + 6], X[8 * q + 7]);
                *(LAS v4u*)(rt + q * 16) = o;
            }
        }
        __syncthreads();
        f32x4 Xt[4][4];
        if (active) {
            const int fr = lane & 15, g = lane >> 4;
#pragma unroll
            for (int b4 = 0; b4 < 4; ++b4)
#pragma unroll
                for (int q = 0; q < 4; ++q) {
                    const unsigned long long w = *(const LAS unsigned long long*)(L + (64 * hw + 16 * q + fr) * 128 + (16 * b4 + 4 * g) * 2);
                    Xt[b4][q] = (f32x4){bflo((unsigned)w), bfhi((unsigned)w), bflo((unsigned)(w >> 32)), bfhi((unsigned)(w >> 32))};
                }
            typedef short s16x4 __attribute__((ext_vector_type(4)));
            s16x4 Xh[4][4], Xl[4][4];
#pragma unroll
            for (int b4 = 0; b4 < 4; ++b4) {
#pragma unroll
                for (int a4 = 0; a4 < b4; ++a4) {
                    float Lf[4];
#pragma unroll
                    for (int kk = 0; kk < 4; ++kk) Lf[kk] = Lm[(16 * b4 + fr) * 64 + 16 * a4 + 4 * g + kk];
                    const unsigned long long lw = (unsigned long long)cvtpk_c(Lf[0], Lf[1]) | ((unsigned long long)cvtpk_c(Lf[2], Lf[3]) << 32);
                    const s16x4 La = __builtin_bit_cast(s16x4, lw);
#pragma unroll
                    for (int q = 0; q < 4; ++q) {
                        Xt[b4][q] = __builtin_amdgcn_mfma_f32_16x16x16bf16_1k(La, Xh[a4][q], Xt[b4][q], 0, 0, 0);
                        Xt[b4][q] = __builtin_amdgcn_mfma_f32_16x16x16bf16_1k(La, Xl[a4][q], Xt[b4][q], 0, 0, 0);
                    }
                }
                float Tf[4];
#pragma unroll
                for (int kk = 0; kk < 4; ++kk) Tf[kk] = Tm[(b4 * 16 + fr) * 16 + 4 * g + kk];
                const unsigned long long tw = (unsigned long long)cvtpk_c(Tf[0], Tf[1]) | ((unsigned long long)cvtpk_c(Tf[2], Tf[3]) << 32);
                const s16x4 Ta = __builtin_bit_cast(s16x4, tw);
#pragma unroll
                for (int q = 0; q < 4; ++q) {
                    const f32x4 r = Xt[b4][q];
                    const unsigned h0 = cvtpk_c(r[0], r[1]), h1 = cvtpk_c(r[2], r[3]);
                    const unsigned l0 = cvtpk_c(r[0] - bflo(h0), r[1] - bfhi(h0)), l1 = cvtpk_c(r[2] - bflo(h1), r[3] - bfhi(h1));
                    const s16x4 rh = __builtin_bit_cast(s16x4, (unsigned long long)h0 | ((unsigned long long)h1 << 32)), rl = __builtin_bit_cast(s16x4, (unsigned long long)l0 | ((unsigned long long)l1 << 32));
                    f32x4 o = {0.f, 0.f, 0.f, 0.f};
                    o = __builtin_amdgcn_mfma_f32_16x16x16bf16_1k(Ta, rh, o, 0, 0, 0);
                    o = __builtin_amdgcn_mfma_f32_16x16x16bf16_1k(Ta, rl, o, 0, 0, 0);
                    Xt[b4][q] = o;
                    const unsigned g0 = cvtpk_c(o[0], o[1]), g1 = cvtpk_c(o[2], o[3]);
                    const unsigned m0 = cvtpk_c(o[0] - bflo(g0), o[1] - bfhi(g0)), m1 = cvtpk_c(o[2] - bflo(g1), o[3] - bfhi(g1));
                    Xh[b4][q] = __builtin_bit_cast(s16x4, (unsigned long long)g0 | ((unsigned long long)g1 << 32));
                    Xl[b4][q] = __builtin_bit_cast(s16x4, (unsigned long long)m0 | ((unsigned long long)m1 << 32));
                }
            }
        }
        __syncthreads();
        if (active) {
            const int fr = lane & 15, g = lane >> 4;
#pragma unroll
            for (int b4 = 0; b4 < 4; ++b4)
#pragma unroll
                for (int q = 0; q < 4; ++q)
#pragma unroll
                    for (int r = 0; r < 4; ++r) *(LAS u16*)(L + (16 * b4 + 4 * g + r) * DNP_XROW + (64 * hw + 16 * q + fr) * 2) = (u16)f2bf(Xt[b4][q][r]);
        }
        __syncthreads();
        if (active) {
#pragma unroll
            for (int k = 0; k < 4; ++k) {
                const int p = k * 256 + ht, f = p >> 6, lp = p & 63, pm = f >> 2, ps = f & 3, i = 16 * pm + (lp & 15), gp = lp >> 4;
                const LAS unsigned char* src = L + i * DNP_XROW + (128 + 32 * ps + 4 * gp) * 2;
                const unsigned long long lo = *(const LAS unsigned long long*)src, hi = *(const LAS unsigned long long*)(src + 32);
                v4u o; o.x = (unsigned)lo; o.y = (unsigned)(lo >> 32); o.z = (unsigned)hi; o.w = (unsigned)(hi >> 32);
                *(v4u*)((unsigned char*)Wc + (size_t)ui * 16384 + (size_t)p * 16) = o;
            }
#pragma unroll
            for (int k = 0; k < 4; ++k) {
                const int p = k * 256 + ht, sl = p >> 7, lp = (p >> 1) & 63, hh = p & 1, gp = lp >> 4, col = 16 * sl + (lp & 15);
                unsigned short e[8];
#pragma unroll
                for (int q = 0; q < 8; ++q) { const int i = 16 * (2 * hh + (q >> 2)) + 4 * gp + (q & 3); e[q] = *(const LAS u16*)(L + i * DNP_XROW + col * 2); }
                v4u o; o.x = e[0] | ((unsigned)e[1] << 16); o.y = e[2] | ((unsigned)e[3] << 16); o.z = e[4] | ((unsigned)e[5] << 16); o.w = e[6] | ((unsigned)e[7] << 16);
                *(v4u*)((unsigned char*)Uc + (size_t)ui * 16384 + (size_t)p * 16) = o;
            }
#pragma unroll
            for (int k = 0; k < 2; ++k) {
                const int p = k * 256 + ht, f = p >> 6, lp = p & 63, pm = f >> 1, ps = f & 1, i = 16 * pm + (lp & 15), gp = lp >> 4;
                const LAS unsigned char* src = L + DNP_AM + i * 144 + (32 * ps + 4 * gp) * 2;
                const unsigned long long lo = *(const LAS unsigned long long*)src, hi = *(const LAS unsigned long long*)(src + 32);
                v4u o; o.x = (unsigned)lo; o.y = (unsigned)(lo >> 32); o.z = (unsigned)hi; o.w = (unsigned)(hi >> 32);
                *(v4u*)((unsigned char*)At + (size_t)ui * 8192 + (size_t)p * 16) = o;
            }
        }
        __syncthreads();
        if (st && it == 0 && bx == 0 && tid == 0) st[15] = __builtin_amdgcn_s_memrealtime();
    }
}

#define DN_SYNC() do { asm volatile("s_waitcnt lgkmcnt(0)" ::: "memory"); __builtin_amdgcn_s_barrier(); asm volatile("" ::: "memory"); } while (0)
constexpr int DNS_BUF = 40960, DNS_GL = 2 * DNS_BUF, DN_L = 16  , DN_G = 16  ;
template <int MODE>
__device__ __forceinline__ void dn_seg(LAS unsigned char* lds, int tid, int h, int grp, int slice0, const bf16* Wc, const bf16* KdT, const bf16* Uc, const float* glb,
                                       bf16* Sbuf, bf16* Vbuf, unsigned char* phi, float* slocal, const float* sstart) {
    const int lane = tid & 63, wave = __builtin_amdgcn_readfirstlane(tid >> 6), n0 = grp * DN_L;
    __syncthreads();
    if (tid < DN_L) ((LAS float*)(lds + DNS_GL))[tid] = glb[h * 256 + n0 + tid];
    if (wave >= 4) {
        const int lt = tid - 256;
        const unsigned char* wsrc = (const unsigned char*)Wc + ((size_t)h * 256 + n0) * 16384 + (size_t)lt * 16;
        const unsigned char* ksrc = (const unsigned char*)KdT + ((size_t)h * 256 + n0) * 16384 + (size_t)lt * 16;
        const unsigned char* usrc = (const unsigned char*)Uc + ((size_t)h * 256 + n0) * 16384 + (size_t)slice0 * 2048 + (size_t)lt * 32;
        v4u R0[10], R1[10], R2[10], R3[10];
#define DN_LD(R, n) do { const int _n = ((n) < DN_L) ? (n) : DN_L - 1; { _Pragma("unroll") for (int _j = 0; _j < 4; ++_j) { R[_j] = *(const v4u*)(wsrc + (size_t)_n * 16384 + _j * 4096); R[4 + _j] = *(const v4u*)(ksrc + (size_t)_n * 16384 + _j * 4096); } \
        R[8] = *(const v4u*)(usrc + (size_t)_n * 16384); R[9] = *(const v4u*)(usrc + (size_t)_n * 16384 + 16); } } while (0)
#define DN_ST(R, n) do { const int _n = (n); { LAS unsigned char* _d = lds + (_n & 1) * DNS_BUF; _Pragma("unroll") for (int _j = 0; _j < 8; ++_j) *(LAS v4u*)(_d + _j * 4096 + lt * 16) = R[_j]; \
        *(LAS v4u*)(_d + 32768 + lt * 32) = R[8]; *(LAS v4u*)(_d + 32768 + lt * 32 + 16) = R[9]; } } while (0)
        DN_LD(R0, 0); DN_LD(R1, 1); DN_LD(R2, 2); DN_LD(R3, 3);
        DN_ST(R0, 0); DN_LD(R0, 4);
        DN_SYNC();
#pragma unroll
        for (int n = 0; n < DN_L; n += 4) {
            DN_ST(R1, n + 1); DN_LD(R1, n + 5); DN_SYNC();
            DN_ST(R2, n + 2); DN_LD(R2, n + 6); DN_SYNC();
            DN_ST(R3, n + 3); DN_LD(R3, n + 7); DN_SYNC();
            DN_ST(R0, n + 4); DN_LD(R0, n + 8); DN_SYNC();
        }
#undef DN_LD
#undef DN_ST
    } else {
        const int sl = slice0 + wave, fr = lane & 15, g = lane >> 4;
        f32x4 S[8];
        if (MODE == 2) {
            const f32x4* sp = (const f32x4*)(sstart + ((size_t)(h * DN_G + grp) * 8 + sl) * 2048) + lane;
#pragma unroll
            for (int m = 0; m < 8; ++m) S[m] = sp[64 * m];
        } else {
#pragma unroll
            for (int m = 0; m < 8; ++m)
#pragma unroll
                for (int r = 0; r < 4; ++r) S[m][r] = (MODE == 1 && (16 * m + 4 * g + r) == (16 * sl + fr)) ? 1.f : 0.f;
        }
        unsigned char* sdst = (unsigned char*)Sbuf + (((size_t)h * 256 + n0) * 8 + sl) * 4096 + (size_t)lane * 16;
        unsigned char* vdst = (unsigned char*)Vbuf + (((size_t)h * 256 + n0) * 8 + sl) * 2048 + (size_t)lane * 16;
        const LAS float* gls = (const LAS float*)(lds + DNS_GL);
        DN_SYNC();
        for (int n = 0; n < DN_L; ++n) {
            const LAS unsigned char* bufp = lds + (n & 1) * DNS_BUF;
            const LAS unsigned char* base = bufp + lane * 16;
            v4u u0 = {0u, 0u, 0u, 0u}, u1 = {0u, 0u, 0u, 0u};
            if (MODE != 1) { u0 = *(const LAS v4u*)(bufp + 32768 + (wave * 64 + lane) * 32); u1 = *(const LAS v4u*)(bufp + 32768 + (wave * 64 + lane) * 32 + 16); }
            const float glv = gls[n];
            s16x8 Sb[4];
#pragma unroll
            for (int s = 0; s < 4; ++s) { Sb[s] = pack8(S[2 * s], S[2 * s + 1]); if (MODE == 2) *(s16x8*)(sdst + (size_t)n * 32768 + s * 1024) = Sb[s]; }
            f32x4 acc[4];
#pragma unroll
            for (int m = 0; m < 4; ++m) {
                acc[m] = (f32x4){0.f, 0.f, 0.f, 0.f};
#pragma unroll
                for (int s = 0; s < 4; ++s) { const s16x8 a = *(const LAS s16x8*)(base + (m * 4 + s) * 1024); acc[m] = MFMA16(a, Sb[s], acc[m]); }
            }
            f32x4 vn[4];
            vn[0] = (f32x4){bflo(u0.x), bfhi(u0.x), bflo(u0.y), bfhi(u0.y)} - acc[0];
            vn[1] = (f32x4){bflo(u0.z), bfhi(u0.z), bflo(u0.w), bfhi(u0.w)} - acc[1];
            vn[2] = (f32x4){bflo(u1.x), bfhi(u1.x), bflo(u1.y), bfhi(u1.y)} - acc[2];
            vn[3] = (f32x4){bflo(u1.z), bfhi(u1.z), bflo(u1.w), bfhi(u1.w)} - acc[3];
            s16x8 Vb[2];
#pragma unroll
            for (int s = 0; s < 2; ++s) { Vb[s] = pack8(vn[2 * s], vn[2 * s + 1]); if (MODE == 2) *(s16x8*)(vdst + (size_t)n * 16384 + s * 1024) = Vb[s]; }
#pragma unroll
            for (int m = 0; m < 8; ++m) {
                S[m] = S[m] * glv;
#pragma unroll
                for (int s = 0; s < 2; ++s) { const s16x8 a = *(const LAS s16x8*)(base + 16384 + (m * 2 + s) * 1024); S[m] = MFMA16(a, Vb[s], S[m]); }
            }
            DN_SYNC();
        }
        if (MODE == 0) {
            f32x4* dp = (f32x4*)(slocal + ((size_t)(h * DN_G + grp) * 8 + sl) * 2048) + lane;
#pragma unroll
            for (int m = 0; m < 8; ++m) dp[64 * m] = S[m];
        }
        if (MODE == 1) {
            unsigned char* pp = phi + (size_t)(h * DN_G + grp) * 32768 + (size_t)(sl >> 1) * 1024 + (size_t)(fr >> 2) * 256 + (size_t)(4 * (sl & 1) + (fr & 3)) * 2;
#pragma unroll
            for (int m = 0; m < 8; ++m)
#pragma unroll
                for (int r = 0; r < 4; ++r) *(u16*)(pp + (size_t)m * 4096 + (size_t)(4 * g + r) * 16) = (u16)f2bf(S[m][r]);
        }
    }
}

constexpr int DNM_SLOT = 65536;
__device__ __forceinline__ void dn_mid2(LAS unsigned char* lds, int tid, int h, int hb, const unsigned char* phi, const float* slocal, float* sstart) {
    const int lane = tid & 63, wave = __builtin_amdgcn_readfirstlane(tid >> 6);
    __syncthreads();
    if (wave >= 4) {
        const int lt = tid - 256;
        const unsigned char* psrc = phi + (size_t)(h * DN_G) * 32768 + (size_t)lt * 16;
        const unsigned char* ssrc = (const unsigned char*)(slocal + ((size_t)(h * DN_G) * 8 + 4 * hb) * 2048) + (size_t)lt * 16;
        v4u R0[16], R1[16], R2[16];
#define DNM_LD(R, n) do { const int _n = ((n) < DN_G - 1) ? (n) : DN_G - 2; { _Pragma("unroll") for (int _j = 0; _j < 8; ++_j) { R[_j] = *(const v4u*)(psrc + (size_t)_n * 32768 + _j * 4096); R[8 + _j] = *(const v4u*)(ssrc + (size_t)_n * 65536 + _j * 4096); } } } while (0)
#define DNM_ST(R, n) do { LAS unsigned char* _d = lds + ((n) & 1) * DNM_SLOT + lt * 16; _Pragma("unroll") for (int _j = 0; _j < 16; ++_j) *(LAS v4u*)(_d + _j * 4096) = R[_j]; } while (0)
        DNM_LD(R0, 0); DNM_LD(R1, 1); DNM_LD(R2, 2);
        DNM_ST(R0, 0); DNM_LD(R0, 3);
        DN_SYNC();
#pragma unroll
        for (int n = 0; n < DN_G - 1; n += 3) {
            DNM_ST(R1, n + 1); DNM_LD(R1, n + 4); DN_SYNC();
            DNM_ST(R2, n + 2); DNM_LD(R2, n + 5); DN_SYNC();
            DNM_ST(R0, n + 3); DNM_LD(R0, n + 6); DN_SYNC();
        }
#undef DNM_LD
#undef DNM_ST
    } else {
        const int sl = 4 * hb + wave;
        f32x4 S[8];
#pragma unroll
        for (int m = 0; m < 8; ++m) S[m] = (f32x4){0.f, 0.f, 0.f, 0.f};
        {
            f32x4* dp = (f32x4*)(sstart + ((size_t)(h * DN_G) * 8 + sl) * 2048) + lane;
#pragma unroll
            for (int m = 0; m < 8; ++m) dp[64 * m] = S[m];
        }
        DN_SYNC();
        for (int n = 0; n < DN_G - 1; ++n) {
            const LAS unsigned char* buf = lds + (n & 1) * DNM_SLOT + lane * 16;
            s16x8 Sb[4];
#pragma unroll
            for (int s = 0; s < 4; ++s) {
                v4u w; w.x = cvtpk_c(S[2 * s][0], S[2 * s][1]); w.y = cvtpk_c(S[2 * s][2], S[2 * s][3]); w.z = cvtpk_c(S[2 * s + 1][0], S[2 * s + 1][1]); w.w = cvtpk_c(S[2 * s + 1][2], S[2 * s + 1][3]);
                Sb[s] = __builtin_bit_cast(s16x8, w);
            }
#pragma unroll
            for (int m = 0; m < 8; ++m) {
                f32x4 acc = *(const LAS f32x4*)(buf + 32768 + wave * 8192 + m * 1024);
#pragma unroll
                for (int s = 0; s < 4; ++s) { const s16x8 a = *(const LAS s16x8*)(buf + (m * 4 + s) * 1024); acc = MFMA16(a, Sb[s], acc); }
                S[m] = acc;
            }
            f32x4* dp = (f32x4*)(sstart + ((size_t)(h * DN_G + n + 1) * 8 + sl) * 2048) + lane;
#pragma unroll
            for (int m = 0; m < 8; ++m) dp[64 * m] = S[m];
            DN_SYNC();
        }
    }
    __syncthreads();
}

__device__ __forceinline__ void dn_mid(LAS unsigned char* lds, int tid, int h, const unsigned char* phi, const float* slocal, float* sstart) {
    const int lane = tid & 63, wave = tid >> 6;
    f32x4 S[8];
#pragma unroll
    for (int m = 0; m < 8; ++m) S[m] = (f32x4){0.f, 0.f, 0.f, 0.f};
    {
        f32x4* dp = (f32x4*)(sstart + ((size_t)(h * DN_G) * 8 + wave) * 2048) + lane;
#pragma unroll
        for (int m = 0; m < 8; ++m) dp[64 * m] = S[m];
    }
    v4u P[4]; f32x4 SLn[8];
    {
        const unsigned char* ps = phi + (size_t)(h * DN_G) * 32768 + (size_t)tid * 16;
#pragma unroll
        for (int j = 0; j < 4; ++j) P[j] = *(const v4u*)(ps + j * 8192);
        const f32x4* sp = (const f32x4*)(slocal + ((size_t)(h * DN_G) * 8 + wave) * 2048) + lane;
#pragma unroll
        for (int m = 0; m < 8; ++m) SLn[m] = sp[64 * m];
    }
    __syncthreads();
    for (int g = 0; g < DN_G - 1; ++g) {
        LAS unsigned char* buf = lds + (g & 1) * 32768;
#pragma unroll
        for (int j = 0; j < 4; ++j) *(LAS v4u*)(buf + j * 8192 + tid * 16) = P[j];
        f32x4 SLc[8];
#pragma unroll
        for (int m = 0; m < 8; ++m) SLc[m] = SLn[m];
        __syncthreads();
        {
            const int gn = (g + 1 < DN_G - 1) ? g + 1 : g;
            const unsigned char* ps = phi + (size_t)(h * DN_G + gn) * 32768 + (size_t)tid * 16;
#pragma unroll
            for (int j = 0; j < 4; ++j) P[j] = *(const v4u*)(ps + j * 8192);
            const f32x4* sp = (const f32x4*)(slocal + ((size_t)(h * DN_G + gn) * 8 + wave) * 2048) + lane;
#pragma unroll
            for (int m = 0; m < 8; ++m) SLn[m] = sp[64 * m];
        }
        s16x8 Sb[4];
#pragma unroll
        for (int s = 0; s < 4; ++s) Sb[s] = pack8(S[2 * s], S[2 * s + 1]);
#pragma unroll
        for (int m = 0; m < 8; ++m) {
            f32x4 acc = SLc[m];
#pragma unroll
            for (int s = 0; s < 4; ++s) { const s16x8 a = *(const LAS s16x8*)(buf + (m * 4 + s) * 1024 + lane * 16); acc = MFMA16(a, Sb[s], acc); }
            S[m] = acc;
        }
        f32x4* dp = (f32x4*)(sstart + ((size_t)(h * DN_G + g + 1) * 8 + wave) * 2048) + lane;
#pragma unroll
        for (int m = 0; m < 8; ++m) dp[64 * m] = S[m];
    }
    __syncthreads();
}

__device__ __forceinline__ void dn_out(LAS unsigned char* lds, int bx, int G, int tid, const bf16* Qd, const bf16* At, const bf16* Sbuf, const bf16* Vbuf, const bf16* Pz, const float* o_norm_w, bf16* mixb) {
    const int lane = tid & 63, wave = tid >> 6, fr = lane & 15, g = lane >> 4;
    LAS float* part = (LAS float*)lds;
    LAS float* rnorm = part + 512;
    for (int ui = bx; ui < 1024; ui += G) {
        const int h = ui >> 8, n = ui & 255;
        const unsigned char* qsrc = (const unsigned char*)Qd + (size_t)ui * 16384 + lane * 16;
        const unsigned char* asrc = (const unsigned char*)At + (size_t)ui * 8192 + lane * 16;
        const unsigned char* ssrc = (const unsigned char*)Sbuf + ((size_t)ui * 8 + wave) * 4096 + lane * 16;
        const unsigned char* vsrc = (const unsigned char*)Vbuf + ((size_t)ui * 8 + wave) * 2048 + lane * 16;
        s16x8 Sb[4], Vb[2];
#pragma unroll
        for (int s = 0; s < 4; ++s) Sb[s] = *(const s16x8*)(ssrc + s * 1024);
#pragma unroll
        for (int s = 0; s < 2; ++s) Vb[s] = *(const s16x8*)(vsrc + s * 1024);
        unsigned short zraw[4][4];
#pragma unroll
        for (int m = 0; m < 4; ++m)
#pragma unroll
            for (int r = 0; r < 4; ++r) zraw[m][r] = Pz[((size_t)n * 64 + 16 * m + 4 * g + r) * 512 + h * 128 + 16 * wave + fr];
        f32x4 o[4];
#pragma unroll
        for (int m = 0; m < 4; ++m) {
            o[m] = (f32x4){0.f, 0.f, 0.f, 0.f};
#pragma unroll
            for (int s = 0; s < 4; ++s) { const s16x8 a = *(const s16x8*)(qsrc + (m * 4 + s) * 1024); o[m] = MFMA16(a, Sb[s], o[m]); }
#pragma unroll
            for (int s = 0; s < 2; ++s) { const s16x8 a = *(const s16x8*)(asrc + (m * 2 + s) * 1024); o[m] = MFMA16(a, Vb[s], o[m]); }
        }
#pragma unroll
        for (int m = 0; m < 4; ++m)
#pragma unroll
            for (int r = 0; r < 4; ++r) {
                float q = o[m][r] * o[m][r];
                q += __shfl_xor(q, 1); q += __shfl_xor(q, 2); q += __shfl_xor(q, 4); q += __shfl_xor(q, 8);
                if (fr == 0) part[wave * 64 + 16 * m + 4 * g + r] = q;
            }
        __syncthreads();
        if (tid < 64) {
            float s = 0.f;
#pragma unroll
            for (int w = 0; w < 8; ++w) s += part[w * 64 + tid];
            rnorm[tid] = __builtin_amdgcn_rsqf(s * (1.f / 128.f) + 1e-6f);
        }
        __syncthreads();
        const int dv = 16 * wave + fr;
        const float ow = o_norm_w[dv];
#pragma unroll
        for (int m = 0; m < 4; ++m)
#pragma unroll
            for (int r = 0; r < 4; ++r) {
                const int i = 16 * m + 4 * g + r; const size_t t = (size_t)n * 64 + i;
                const float z = bf2f(zraw[m][r]);
                mixb[t * 1024 + 512 + h * 128 + dv] = (bf16)f2bf(o[m][r] * rnorm[i] * ow * z);
            }
        __syncthreads();
    }
}


typedef float f32x2 __attribute__((ext_vector_type(2)));
__device__ __forceinline__ f32x2 f8lo(unsigned w) { return __builtin_amdgcn_cvt_pk_f32_fp8((int)w, false); }
__device__ __forceinline__ f32x2 f8hi(unsigned w) { return __builtin_amdgcn_cvt_pk_f32_fp8((int)w, true); }

__device__ __forceinline__ void uv_convert_row(const f32x4 (&v)[4], unsigned char* dst, float* inv_scale, int e, int lane) {
    float am = 0.f;
#pragma unroll
    for (int j = 0; j < 4; ++j) am = fmaxf(am, fmaxf(fmaxf(fabsf(v[j].x), fabsf(v[j].y)), fmaxf(fabsf(v[j].z), fabsf(v[j].w))));
#pragma unroll
    for (int o = 32; o > 0; o >>= 1) am = fmaxf(am, __shfl_xor(am, o));
    const float sc = (am > 0.f) ? 400.f / am : 1.f;
    if (lane == 0) inv_scale[e] = (am > 0.f) ? am * (1.f / 400.f) : 1.f;
#pragma unroll
    for (int j = 0; j < 4; ++j) {
        const int c = 2 * j + (lane >> 5);
        int w = 0;
        w = __builtin_amdgcn_cvt_pk_fp8_f32(v[j].x * sc, v[j].y * sc, w, false);
        w = __builtin_amdgcn_cvt_pk_fp8_f32(v[j].z * sc, v[j].w * sc, w, true);
        *(unsigned*)(dst + ((size_t)c * 16384 + e) * 128 + (lane & 31) * 4) = (unsigned)w;
    }
}
__device__ __forceinline__ float* pre_slab(unsigned char* ws, int c) { return (float*)(ws + WS_SLAB + (size_t)c * 8 * MiB); }
__device__ __forceinline__ void uv_convert_table(const float* src, unsigned char* dst, float* inv_scale, int w0, int nw, int lane) {
    for (int e = 2 * w0; e < 16384; e += 2 * nw) {
        f32x4 va[4], vb[4];
        const f32x4* sa = (const f32x4*)(src + (size_t)e * 1024) + lane;
#pragma unroll
        for (int j = 0; j < 4; ++j) { va[j] = sa[64 * j]; vb[j] = sa[256 + 64 * j]; }
        uv_convert_row(va, dst, inv_scale, e, lane);
        uv_convert_row(vb, dst, inv_scale, e + 1, lane);
    }
}
__device__ __forceinline__ void uv_convert_table_dma(const float* src, unsigned char* dst, float* inv_scale, int w0, int nw, int lane, LAS unsigned char* ring) {
    const int nrows = (16384 - w0 + nw - 1) / nw;
    if (nrows <= 0) return;
    auto rowof = [&](int k) { return w0 + (k < nrows ? k : nrows - 1) * nw; };
    auto issue = [&](int k) {
        const unsigned char* s = (const unsigned char*)src + (size_t)rowof(k) * 4096 + lane * 16;
        LAS unsigned char* d = ring + (k & 3) * 4096;
#pragma unroll
        for (int j = 0; j < 4; ++j) __builtin_amdgcn_global_load_lds((const unsigned*)(s + j * 1024), (LAS unsigned*)(d + j * 1024), 16, 0, 0);
    };
    asm volatile("s_waitcnt vmcnt(0)" ::: "memory");
    issue(0); issue(1); issue(2);
    asm volatile("" ::: "memory");
    for (int k = 0; k < nrows; ++k) {
        issue(k + 3);
        asm volatile("s_waitcnt vmcnt(12)" ::: "memory");
        f32x4 v[4];
        const LAS unsigned char* sl = ring + (k & 3) * 4096 + lane * 64;
#pragma unroll
        for (int j = 0; j < 4; ++j) v[j] = *(const LAS f32x4*)(sl + j * 16);
        asm volatile("s_waitcnt lgkmcnt(0)" ::: "memory");
        {
            const int e = rowof(k);
            float am = 0.f;
#pragma unroll
            for (int j = 0; j < 4; ++j) am = fmaxf(am, fmaxf(fmaxf(fabsf(v[j].x), fabsf(v[j].y)), fmaxf(fabsf(v[j].z), fabsf(v[j].w))));
#pragma unroll
            for (int o = 32; o > 0; o >>= 1) am = fmaxf(am, __shfl_xor(am, o));
            const float sc = (am > 0.f) ? 400.f / am : 1.f;
            if (lane == 0) inv_scale[e] = (am > 0.f) ? am * (1.f / 400.f) : 1.f;
            v4u o;
            unsigned w[4];
#pragma unroll
            for (int j = 0; j < 4; ++j) { int q = 0; q = __builtin_amdgcn_cvt_pk_fp8_f32(v[j].x * sc, v[j].y * sc, q, false); q = __builtin_amdgcn_cvt_pk_fp8_f32(v[j].z * sc, v[j].w * sc, q, true); w[j] = (unsigned)q; }
            o.x = w[0]; o.y = w[1]; o.z = w[2]; o.w = w[3];
            unsigned char* dp = dst + ((size_t)(lane >> 3) * 16384 + e) * 128 + (lane & 7) * 16;
            asm volatile("global_store_dwordx4 %0, %1, off sc1" :: "v"(dp), "v"(o) : "memory");
        }
        asm volatile("" ::: "memory");
    }
    asm volatile("s_waitcnt vmcnt(0)" ::: "memory");
}
struct XcdMap { int rank, nloc, px, np; };

__device__ __forceinline__ void peer_pre(const XcdMap M, int tid, unsigned char* ws, const unsigned char* U8, const float* x1, const float* r2, const float* mod, const float* norm2_w, const int* ids) {
    const int lane = tid & 63, wave = tid >> 6, a = lane >> 3, b = lane & 7;
    const float* sh2 = mod + 3072; const float* sc2 = mod + 4096;
    for (int c = M.px; c < 8; c += M.np) {
        float a2[16], s2[16];
#pragma unroll
        for (int e = 0; e < 16; ++e) { const int k = 128 * c + 16 * b + e; a2[e] = norm2_w[k] * (1.f + sc2[k]); s2[e] = sh2[k]; }
        const unsigned char* ub = U8 + (size_t)c * 2 * MiB;
        unsigned char* slab = (unsigned char*)pre_slab(ws, c);
        const unsigned b16 = (unsigned)b * 16u;
        for (int q = M.rank; q < SEQ / 8; q += M.nloc) {
            const unsigned t = (unsigned)(q * 8 + wave);
            unsigned idv[16];
            const unsigned ido = (t * 128u + (unsigned)a) * 4u;
#pragma unroll
            for (int i = 0; i < 16; ++i) idv[i] = *(const unsigned*)((const unsigned char*)ids + ido + i * 32);
            const float rr = r2[t];
            f32x2 h[8];
            const unsigned xo = (t * 1024u + 128u * c + 16u * b) * 4u;
#pragma unroll
            for (int j = 0; j < 4; ++j) {
                const f32x4 xv = *(const f32x4*)((const unsigned char*)x1 + xo + j * 16);
                h[2 * j].x = xv[0] * rr * a2[4 * j] + s2[4 * j]; h[2 * j].y = xv[1] * rr * a2[4 * j + 1] + s2[4 * j + 1];
                h[2 * j + 1].x = xv[2] * rr * a2[4 * j + 2] + s2[4 * j + 2]; h[2 * j + 1].y = xv[3] * rr * a2[4 * j + 3] + s2[4 * j + 3];
            }
            v4u gq[16];
#pragma unroll
            for (int i = 0; i < 16; ++i) gq[i] = *(const v4u*)(ub + (idv[i] * 128u + b16));
            float p[16];
#pragma unroll
            for (int i = 0; i < 16; ++i) {
                const unsigned w[4] = {gq[i].x, gq[i].y, gq[i].z, gq[i].w};
                f32x2 s = {0.f, 0.f};
#pragma unroll
                for (int k = 0; k < 4; ++k) { s += f8lo(w[k]) * h[2 * k]; s += f8hi(w[k]) * h[2 * k + 1]; }
                p[i] = s.x + s.y;
            }
            const bool h4 = (b & 4) != 0, h2 = (b & 2) != 0, h1 = (b & 1) != 0;
            float q8[8], r4[4], s1[2];
#pragma unroll
            for (int i = 0; i < 8; ++i) { const float send = h4 ? p[i] : p[i + 8], keep = h4 ? p[i + 8] : p[i]; q8[i] = keep + __shfl_xor(send, 4); }
#pragma unroll
            for (int i = 0; i < 4; ++i) { const float send = h2 ? q8[i] : q8[i + 4], keep = h2 ? q8[i + 4] : q8[i]; r4[i] = keep + __shfl_xor(send, 2); }
#pragma unroll
            for (int i = 0; i < 2; ++i) { const float send = h1 ? r4[i] : r4[i + 2], keep = h1 ? r4[i + 2] : r4[i]; s1[i] = keep + __shfl_xor(send, 1); }
            const int slot = 8 * (b >> 2) + 4 * ((b >> 1) & 1) + 2 * (b & 1);
            const unsigned so = (t * 128u + (unsigned)(slot * 8 + a)) * 4u;
            *(float*)(slab + so) = s1[0];
            *(float*)(slab + so + 32) = s1[1];
        }
    }
}

#define PEER_DMA16(src, dst) __builtin_amdgcn_global_load_lds((const unsigned*)(src), (LAS unsigned*)(dst), 16, 0, 0)
#define PEER_DMA4(src, dst) __builtin_amdgcn_global_load_lds((const unsigned*)(src), (LAS unsigned*)(dst), 4, 0, 0)
#define PEER_VMWAIT(n) asm volatile("s_waitcnt vmcnt(" #n ")" ::: "memory")
#define PEER_FENCE() asm volatile("" ::: "memory")
__device__ __forceinline__ void peer_gather_quarter(const unsigned char* tb, const LAS int* idsl, LAS unsigned char* ringq, int a, unsigned soff0, unsigned soff1) {
    unsigned id[4];
#pragma unroll
    for (int i = 0; i < 4; ++i) id[i] = (unsigned)idsl[8 * i + a];
    asm volatile("s_waitcnt lgkmcnt(0)" : "+v"(id[0]), "+v"(id[1]), "+v"(id[2]), "+v"(id[3]) :: "memory");
#pragma unroll
    for (int i = 0; i < 4; ++i) PEER_DMA16(tb + (id[i] * 128u + ((i & 1) ? soff1 : soff0)), ringq + i * 1024);
}
__device__ __forceinline__ void peer_pre_dma(const XcdMap M, int tid, LAS unsigned char* lds, unsigned char* ws, const unsigned char* U8, const bf16* x1, const float* r2, const float* mod, const float* norm2_w, const int* ids) {
    const int lane = tid & 63, wave = __builtin_amdgcn_readfirstlane(tid >> 6), a = lane >> 3, b = lane & 7, m = lane & 15, g = lane >> 4;
    LAS unsigned char* ring = lds + wave * 16384;
    LAS unsigned char* misc = lds + 131072 + wave * 1984;
    LAS int* idsL = (LAS int*)misc;
    LAS unsigned char* xb8 = misc + 1024;
    LAS float* xsL = (LAS float*)(misc + 1408);
    LAS float* rrL = (LAS float*)(misc + 1920);
    const float* sh2 = mod + 3072; const float* sc2 = mod + 4096;
    const unsigned soff0 = 16u * (unsigned)(b ^ (a >> 1)), soff1 = 16u * (unsigned)(b ^ (4 + (a >> 1)));
    unsigned boff[4];
#pragma unroll
    for (int t = 0; t < 4; ++t) boff[t] = (unsigned)(m * 128 + 16 * (((2 * t + (g >> 1)) ^ (m >> 1)) & 7) + 8 * (g & 1));
    const unsigned aoffx = (unsigned)((m < 3 ? m : 2) * 128 + 8 * g);
    const int nIt = (SEQ / 8 - M.rank + M.nloc - 1) / M.nloc;
    for (int c = M.px; c < 8; c += M.np) {
        const unsigned char* ub = U8 + (size_t)c * 2 * MiB;
        float* slab = pre_slab(ws, c);
        const int k0 = 128 * c + 2 * lane;
        const float a20 = norm2_w[k0] * (1.f + sc2[k0]), a21 = norm2_w[k0 + 1] * (1.f + sc2[k0 + 1]), s20 = sh2[k0], s21 = sh2[k0 + 1];
        auto tokof = [&](int k) { const int kk = k < nIt ? k : nIt - 1; return (unsigned)((M.rank + kk * M.nloc) * 8 + wave); };
        auto dma_ids = [&](unsigned t, int slot) { PEER_DMA4(ids + (size_t)t * 128 + lane, idsL + slot * 128); PEER_DMA4(ids + (size_t)t * 128 + 64 + lane, idsL + slot * 128 + 64); };
        auto dma_x = [&](unsigned t) {
            PEER_DMA4(x1 + (size_t)t * 1024 + 128 * c + 2 * lane, xsL);
            if (lane < 16) PEER_DMA4(r2 + t, rrL);
        };
        unsigned tcur = tokof(0);
        __builtin_amdgcn_s_waitcnt(0);
        PEER_VMWAIT(0);
        dma_ids(tcur, 0); dma_ids(tokof(1), 1); dma_x(tcur);
        PEER_VMWAIT(0);
        peer_gather_quarter(ub, idsL + 0, ring + 0 * 4096, a, soff0, soff1);
        peer_gather_quarter(ub, idsL + 32, ring + 1 * 4096, a, soff0, soff1);
        peer_gather_quarter(ub, idsL + 64, ring + 2 * 4096, a, soff0, soff1);
        PEER_FENCE();
        for (int k = 0; k < nIt; ++k) {
            const int par = k & 1;
            const unsigned tn = tokof(k + 1);
            peer_gather_quarter(ub, idsL + par * 128 + 96, ring + 3 * 4096, a, soff0, soff1);
            PEER_FENCE();
            dma_ids(tokof(k + 2), par);
            PEER_VMWAIT(14);
            float inv;
            long Ax[4];
            {
                const unsigned xw = *(const LAS unsigned*)(xsL + lane); const f32x2 xv = {bflo(xw), bfhi(xw)}; const float rr = rrL[0];
                const float h0 = xv.x * rr * a20 + s20, h1 = xv.y * rr * a21 + s21;
                float am = fmaxf(fabsf(h0), fabsf(h1));
#pragma unroll
                for (int o = 32; o > 0; o >>= 1) am = fmaxf(am, __shfl_xor(am, o));
                const float S = am > 0.f ? 224.f / am : 1.f; inv = am > 0.f ? am * (1.f / 224.f) : 1.f;
                float v0 = h0 * S, v1 = h1 * S;
                const int p0 = __builtin_amdgcn_cvt_pk_fp8_f32(v0, v1, 0, false);
                const f32x2 f0 = __builtin_amdgcn_cvt_pk_f32_fp8(p0, false);
                v0 -= f0.x; v1 -= f0.y;
                const int p1 = __builtin_amdgcn_cvt_pk_fp8_f32(v0, v1, 0, false);
                const f32x2 f1 = __builtin_amdgcn_cvt_pk_f32_fp8(p1, false);
                v0 -= f1.x; v1 -= f1.y;
                const int p2 = __builtin_amdgcn_cvt_pk_fp8_f32(v0, v1, 0, false);
                *(LAS unsigned short*)(xb8 + 2 * lane) = (unsigned short)p0;
                *(LAS unsigned short*)(xb8 + 128 + 2 * lane) = (unsigned short)p1;
                *(LAS unsigned short*)(xb8 + 256 + 2 * lane) = (unsigned short)p2;
                PEER_FENCE();
#pragma unroll
                for (int t = 0; t < 4; ++t) Ax[t] = *(const LAS long*)(xb8 + aoffx + 32 * t);
                PEER_FENCE();
            }
#pragma unroll
            for (int q = 0; q < 4; ++q) {
                if (q > 0) PEER_VMWAIT(16);
#pragma unroll
                for (int bb = 0; bb < 2; ++bb) {
                    const int blk = 2 * q + bb;
                    f32x4 acc = {0.f, 0.f, 0.f, 0.f};
#pragma unroll
                    for (int t = 0; t < 4; ++t) {
                        const long Bv = *(const LAS long*)(ring + blk * 2048 + boff[t]);
                        acc = __builtin_amdgcn_mfma_f32_16x16x32_fp8_fp8(Ax[t], Bv, acc, 0, 0, 0);
                    }
                    const float val = (acc[0] + acc[1] + acc[2]) * inv;
                    if (lane < 16) slab[(size_t)tcur * 128 + 16 * blk + lane] = val;
                }
                PEER_FENCE();
                if (q < 3) { peer_gather_quarter(ub, idsL + (par ^ 1) * 128 + 32 * q, ring + q * 4096, a, soff0, soff1); PEER_FENCE(); }
                if (q == 0) { dma_x(tn); PEER_FENCE(); }
            }
            tcur = tn;
        }
        PEER_VMWAIT(0);
    }
}

__device__ __forceinline__ void peer_out(const XcdMap M, int tid, const unsigned char* V8, const bf16* x1, float* x2buf, const float* mod, const int* ids, const float* coef, float* rss3) {
    const int lane = tid & 63, wave = tid >> 6, a = lane >> 3, b = lane & 7;
    const float* gt2 = mod + 5120;
    const bool h32 = (a & 4) != 0, h16 = (a & 2) != 0, h8 = (a & 1) != 0;
    const int col = 16 * b + 8 * ((a >> 2) & 1) + 4 * ((a >> 1) & 1) + 2 * (a & 1);
    for (int c = M.px; c < 8; c += M.np) {
        const unsigned char* vb = V8 + (size_t)c * 2 * MiB;
        const unsigned b16 = (unsigned)b * 16u;
        const f32x2 g2 = *(const f32x2*)(gt2 + 128 * c + col);
        for (int q = M.rank; q < SEQ / 8; q += M.nloc) {
            const unsigned t = (unsigned)(q * 8 + wave);
            unsigned idv[16]; float cf[16];
            const unsigned ido = (t * 128u + (unsigned)a) * 4u;
#pragma unroll
            for (int i = 0; i < 16; ++i) { const unsigned pk = *(const unsigned*)((const unsigned char*)coef + ido + i * 32); idv[i] = pk & 0xffffu; cf[i] = bfhi(pk); }
            const unsigned xo = (t * 1024u + 128u * c + (unsigned)col) * 4u;
            const unsigned xw = *(const unsigned*)((const unsigned char*)x1 + (xo >> 1)); const f32x2 xv = {bflo(xw), bfhi(xw)};
            float acc[16];
#pragma unroll
            for (int e = 0; e < 16; ++e) acc[e] = 0.f;
#pragma unroll
            for (int hf = 0; hf < 2; ++hf) {
                v4u gq[8];
#pragma unroll
                for (int i = 0; i < 8; ++i) gq[i] = *(const v4u*)(vb + (idv[8 * hf + i] * 128u + b16));
                asm volatile("" ::: "memory");
#pragma unroll
                for (int i = 0; i < 8; ++i) {
                    const unsigned w[4] = {gq[i].x, gq[i].y, gq[i].z, gq[i].w}; const float cfi = cf[8 * hf + i];
#pragma unroll
                    for (int k = 0; k < 4; ++k) { const f32x2 lo = f8lo(w[k]), hi = f8hi(w[k]); acc[4 * k] += cfi * lo.x; acc[4 * k + 1] += cfi * lo.y; acc[4 * k + 2] += cfi * hi.x; acc[4 * k + 3] += cfi * hi.y; }
                }
            }
            float q8[8], q4[4], q2[2];
#pragma unroll
            for (int i = 0; i < 8; ++i) { const float send = h32 ? acc[i] : acc[i + 8], keep = h32 ? acc[i + 8] : acc[i]; q8[i] = keep + __shfl_xor(send, 32); }
#pragma unroll
            for (int i = 0; i < 4; ++i) { const float send = h16 ? q8[i] : q8[i + 4], keep = h16 ? q8[i + 4] : q8[i]; q4[i] = keep + __shfl_xor(send, 16); }
#pragma unroll
            for (int i = 0; i < 2; ++i) { const float send = h8 ? q4[i] : q4[i + 2], keep = h8 ? q4[i + 2] : q4[i]; q2[i] = keep + __shfl_xor(send, 8); }
            f32x2 x2; x2.x = xv.x + g2.x * q2[0]; x2.y = xv.y + g2.y * q2[1];
            *(unsigned*)((unsigned char*)x2buf + (xo >> 1)) = cvtpk_c(x2.x, x2.y);
            const float ss = wave_sum(x2.x * x2.x + x2.y * x2.y);
            if (lane == 0) rss3[(unsigned)c * SEQ + t] = ss;
        }
    }
}


__device__ __forceinline__ unsigned ord_key(float v) { const unsigned b = __builtin_bit_cast(unsigned, v); return (b & 0x80000000u) ? ~b : (b | 0x80000000u); }
__device__ __forceinline__ float ord_val(unsigned k, unsigned lowmask) {
    const unsigned b = (k & 0x80000000u) ? (k & 0x7fffffffu) : ~k;
    return __builtin_bit_cast(float, b & ~lowmask);
}
#define RT_CE(a, b) do { const unsigned _ceh = max(a, b), _cel = min(a, b); a = _ceh; b = _cel; } while (0)
#define RT_SORT16(S) do { _Pragma("unroll") for (int _k = 2; _k <= 16; _k <<= 1) _Pragma("unroll") for (int _j = _k >> 1; _j > 0; _j >>= 1) _Pragma("unroll") for (int _i = 0; _i < 16; ++_i) { \
        const int _l = _i ^ _j; if (_l > _i) { if ((_i & _k) == 0) RT_CE(S[_i], S[_l]); else RT_CE(S[_l], S[_i]); } } } while (0)
#define RT_MERGE16(T, S) do { _Pragma("unroll") for (int _i = 0; _i < 16; ++_i) T[_i] = max(T[_i], S[15 - _i]); \
        _Pragma("unroll") for (int _st = 8; _st >= 1; _st >>= 1) _Pragma("unroll") for (int _i = 0; _i < 16; ++_i) if ((_i & _st) == 0) RT_CE(T[_i], T[_i + _st]); } while (0)
#define RT_SORT8(S) do { _Pragma("unroll") for (int _k = 2; _k <= 8; _k <<= 1) _Pragma("unroll") for (int _j = _k >> 1; _j > 0; _j >>= 1) _Pragma("unroll") for (int _i = 0; _i < 8; ++_i) { \
        const int _l = _i ^ _j; if (_l > _i) { if ((_i & _k) == 0) RT_CE(S[_i], S[_l]); else RT_CE(S[_l], S[_i]); } } } while (0)
#define RT_MERGE8(T, S) do { _Pragma("unroll") for (int _i = 0; _i < 8; ++_i) T[8 + _i] = max(T[8 + _i], S[7 - _i]); \
        _Pragma("unroll") for (int _st = 8; _st >= 1; _st >>= 1) _Pragma("unroll") for (int _i = 0; _i < 16; ++_i) if ((_i & _st) == 0) RT_CE(T[_i], T[_i + _st]); } while (0)
#define RT_INS(T, key) do { unsigned _k = (key); _Pragma("unroll") for (int _i = 0; _i < 16; ++_i) { const unsigned _hi = max(T[_i], _k); _k = min(T[_i], _k); T[_i] = _hi; } } while (0)

__device__ __forceinline__ void route_phase(LAS unsigned char* lds, int bx, int G, int tid, const bf16* qq, const bf16* K1b, const bf16* K2b, int* ids, float* gates, unsigned long long* st) {
#define RSTAMP(k) do { if (st && bx == 0 && tid == 0 && u == bx) st[k] = __builtin_amdgcn_s_memrealtime(); } while (0)
    const int lane = tid & 63, wave = tid >> 6, fr = lane & 15, g = lane >> 4;
    LAS float* sc = (LAS float*)lds;
    LAS unsigned* scu = (LAS unsigned*)lds;
    const bool keep_keys = (G & 3) == 0;
    s16x8 Bk[8][4];
    if (keep_keys) {
        const int hh = wave >> 2, half = (wave >> 1) & 1, h = 2 * (bx & 3) + hh;
        const bf16* kb = (half ? K2b : K1b) + (size_t)h * 128 * 128;
#pragma unroll
        for (int nt = 0; nt < 8; ++nt)
#pragma unroll
            for (int s = 0; s < 4; ++s) Bk[nt][s] = *(const s16x8*)(kb + (size_t)(16 * nt + fr) * 128 + 32 * s + 8 * g);
    }
    s16x8 Aq[2][4];
    {
        const int hh = wave >> 2, half = (wave >> 1) & 1, th = wave & 1;
        const int u0 = (bx < 1024) ? bx : 0, h = 2 * (u0 & 3) + hh, t0 = (u0 >> 2) * 64;
#pragma unroll
        for (int mt = 0; mt < 2; ++mt)
#pragma unroll
            for (int s = 0; s < 4; ++s) Aq[mt][s] = *(const s16x8*)(qq + (size_t)(t0 + 32 * th + 16 * mt + fr) * 2048 + h * 256 + half * 128 + 32 * s + 8 * g);
    }
    for (int u = bx; u < 1024; u += G) {
        const int tile = u >> 2, hp = u & 3, t0 = tile * 64;
        {
            const int hh = wave >> 2, half = (wave >> 1) & 1, th = wave & 1, h = 2 * hp + hh;
            const bf16* kb = (half ? K2b : K1b) + (size_t)h * 128 * 128;
            if (!keep_keys) {
#pragma unroll
                for (int nt = 0; nt < 8; ++nt)
#pragma unroll
                    for (int s = 0; s < 4; ++s) Bk[nt][s] = *(const s16x8*)(kb + (size_t)(16 * nt + fr) * 128 + 32 * s + 8 * g);
            }
            const int lbase = (hh * 2 + half) * 64 + 32 * th;
#pragma unroll
            for (int nt = 0; nt < 8; ++nt) {
                f32x4 a0 = {0.f, 0.f, 0.f, 0.f}, a1 = {0.f, 0.f, 0.f, 0.f};
#pragma unroll
                for (int s = 0; s < 4; ++s) { a0 = MFMA16(Aq[0][s], Bk[nt][s], a0); a1 = MFMA16(Aq[1][s], Bk[nt][s], a1); }
#pragma unroll
                for (int r = 0; r < 4; ++r) { sc[(lbase + 4 * g + r) * 129 + 16 * nt + fr] = a0[r]; sc[(lbase + 16 + 4 * g + r) * 129 + 16 * nt + fr] = a1[r]; }
            }
            {
                const int un = (u + G < 1024) ? u + G : u, hn = 2 * (un & 3) + hh, tn = (un >> 2) * 64;
#pragma unroll
                for (int mt = 0; mt < 2; ++mt)
#pragma unroll
                    for (int s = 0; s < 4; ++s) Aq[mt][s] = *(const s16x8*)(qq + (size_t)(tn + 32 * th + 16 * mt + fr) * 2048 + hn * 256 + half * 128 + 32 * s + 8 * g);
            }
        }
        __syncthreads(); RSTAMP(16);
        unsigned T[16];
        const int li = tid & 255, part = tid >> 8;
        {
            const LAS float* src = sc + li * 129 + 64 * part;
#pragma unroll
            for (int k = 0; k < 16; ++k) T[k] = (ord_key(src[k]) & ~127u) | (unsigned)(127 - k);
            RT_SORT16(T);
#pragma unroll 1
            for (int b = 2; b < 8; ++b) {
                unsigned S[8];
#pragma unroll
                for (int k = 0; k < 8; ++k) S[k] = (ord_key(src[8 * b + k]) & ~127u) | (unsigned)(127 - (8 * b + k));
                RT_SORT8(S);
                RT_MERGE8(T, S);
            }
            if (part == 1) {
#pragma unroll
                for (int i = 0; i < 16; ++i) scu[li * 129 + 64 + i] = T[i] ^ 64u;
            }
        }
        __syncthreads(); RSTAMP(17);
        if (part == 0) {
#pragma unroll
            for (int i = 0; i < 16; ++i) T[i] = max(T[i], scu[li * 129 + 64 + 15 - i]);
#pragma unroll
            for (int st = 8; st >= 1; st >>= 1)
#pragma unroll
                for (int i = 0; i < 16; ++i) if ((i & st) == 0) { const unsigned hi = max(T[i], T[i + st]), lo = min(T[i], T[i + st]); T[i] = hi; T[i + st] = lo; }
#pragma unroll
            for (int i = 0; i < 16; ++i) scu[li * 129 + i] = T[i];
        }
        __syncthreads(); RSTAMP(18);
        if (tid < 128) {
            const int tok = tid & 63, hh = tid >> 6, h = 2 * hp + hh;
            const int l1 = (hh * 2 + 0) * 64 + tok, l2 = (hh * 2 + 1) * 64 + tok;
            float v1[16], v2[16];
#pragma unroll
            for (int i = 0; i < 16; ++i) { v1[i] = ord_val(scu[l1 * 129 + i], 127u); v2[i] = ord_val(scu[l2 * 129 + i], 127u); }
#define RT_CKEY(i, j) ((ord_key(v1[i] + v2[j]) & ~255u) | (unsigned)(255 - ((i) * 16 + (j))))
#pragma unroll
            for (int j = 0; j < 16; ++j) T[j] = RT_CKEY(0, j);
            { unsigned S[8];
#pragma unroll
              for (int j = 0; j < 8; ++j) S[j] = RT_CKEY(1, j);
              RT_MERGE8(T, S); }
            { unsigned S[8];
#pragma unroll
              for (int j = 0; j < 5; ++j) S[j] = RT_CKEY(2, j);
              S[5] = RT_CKEY(3, 0); S[6] = RT_CKEY(3, 1); S[7] = RT_CKEY(3, 2);
              RT_SORT8(S); RT_MERGE8(T, S); }
            { unsigned S[8];
              S[0] = RT_CKEY(3, 3); S[1] = RT_CKEY(4, 0); S[2] = RT_CKEY(4, 1); S[3] = RT_CKEY(4, 2); S[4] = RT_CKEY(5, 0); S[5] = RT_CKEY(5, 1); S[6] = RT_CKEY(6, 0); S[7] = RT_CKEY(6, 1);
              RT_SORT8(S); RT_MERGE8(T, S); }
            { unsigned S[8];
              S[0] = RT_CKEY(7, 0); S[1] = RT_CKEY(7, 1); S[2] = RT_CKEY(8, 0); S[3] = RT_CKEY(9, 0); S[4] = RT_CKEY(10, 0); S[5] = RT_CKEY(11, 0); S[6] = RT_CKEY(12, 0); S[7] = RT_CKEY(13, 0);
              RT_SORT8(S); RT_MERGE8(T, S); }
            { unsigned S[8];
              S[0] = RT_CKEY(14, 0); S[1] = RT_CKEY(15, 0);
#pragma unroll
              for (int j = 2; j < 8; ++j) S[j] = 0u;
              RT_MERGE8(T, S); }
            const float mx = ord_val(T[0], 255u);
            float e[16], se = 0.f;
#pragma unroll
            for (int r = 0; r < 16; ++r) { e[r] = __expf(ord_val(T[r], 255u) - mx); se += e[r]; }
            const float inv = 1.f / se;
            const size_t ob = (size_t)(t0 + tok) * 128 + h * 16;
#pragma unroll
            for (int r = 0; r < 16; ++r) {
                const int pos = 255 - (int)(T[r] & 255u), i = pos >> 4, j = pos & 15;
                const int i1 = 127 - (int)(scu[l1 * 129 + i] & 127u), i2 = 127 - (int)(scu[l2 * 129 + j] & 127u);
                ids[ob + r] = i1 * 128 + i2;
                gates[ob + r] = e[r] * inv;
            }
        }
        __syncthreads(); RSTAMP(19);
    }
}


__device__ __forceinline__ void gmlp_phase(LAS unsigned char* lds, int bx, int G, int tid, const bf16* Pgm, const bf16* GWb, const float* gm_norm_w, const float* gm_bs, bf16* mixb, const float* vss) {
    const int lane = tid & 63, wave = tid >> 6, fr = lane & 15, g = lane >> 4;
    LAS unsigned char* vnT = lds + 512;
    for (int u = bx; u < 1024; u += G) {
        const int n = u >> 3, hd = u & 7, t0 = n * 128;
        const int dg = tid & 7, sp = tid >> 3, s0 = 2 * sp;
        float pa = vss[(size_t)dg * SEQ + t0 + s0], pb = vss[(size_t)dg * SEQ + t0 + s0 + 1];
        const v4u qa = *(const v4u*)(Pgm + (size_t)(t0 + s0) * 1024 + 512 + hd * 64 + dg * 8);
        const v4u qb = *(const v4u*)(Pgm + (size_t)(t0 + s0 + 1) * 1024 + 512 + hd * 64 + dg * 8);
        unsigned short uraw[4][4];
#pragma unroll
        for (int r = 0; r < 4; ++r)
#pragma unroll
            for (int nt = 0; nt < 4; ++nt) uraw[r][nt] = Pgm[(size_t)(t0 + 16 * wave + 4 * g + r) * 1024 + hd * 64 + 16 * nt + fr];
        pa += __shfl_xor(pa, 1); pa += __shfl_xor(pa, 2); pa += __shfl_xor(pa, 4);
        pb += __shfl_xor(pb, 1); pb += __shfl_xor(pb, 2); pb += __shfl_xor(pb, 4);
        {
            const float ra = __builtin_amdgcn_rsqf(pa * (1.f / 512.f) + 1e-6f), rb = __builtin_amdgcn_rsqf(pb * (1.f / 512.f) + 1e-6f);
            const unsigned wa[4] = {qa.x, qa.y, qa.z, qa.w}, wb[4] = {qb.x, qb.y, qb.z, qb.w};
#pragma unroll
            for (int e = 0; e < 8; ++e) {
                const float nw = gm_norm_w[hd * 64 + dg * 8 + e];
                const float va = ((e & 1) ? bfhi(wa[e >> 1]) : bflo(wa[e >> 1])) * ra * nw, vb = ((e & 1) ? bfhi(wb[e >> 1]) : bflo(wb[e >> 1])) * rb * nw;
                *(LAS unsigned*)(vnT + (dg * 8 + e) * 272 + sp * 4) = cvtpk(va, vb);
            }
        }
        __syncthreads();
        {
            const int mt = wave, nks = (mt >> 1) + 1;
            f32x4 acc[4];
#pragma unroll
            for (int nt = 0; nt < 4; ++nt) acc[nt] = (f32x4){0.f, 0.f, 0.f, 0.f};
            const bf16* wrow = GWb + ((size_t)hd * 128 + 16 * mt + fr) * 128 + 8 * g;
#pragma unroll
            for (int ks = 0; ks < 4; ++ks) {
                if (ks < nks) {
                    const s16x8 a = *(const s16x8*)(wrow + 32 * ks);
#pragma unroll
                    for (int nt = 0; nt < 4; ++nt) { const s16x8 b = *(const LAS s16x8*)(vnT + (16 * nt + fr) * 272 + (32 * ks + 8 * g) * 2); acc[nt] = MFMA16(a, b, acc[nt]); }
                }
            }
#pragma unroll
            for (int r = 0; r < 4; ++r) {
                const int t = 16 * mt + 4 * g + r;
                const float bias = gm_bs[hd * 128 + t];
#pragma unroll
                for (int nt = 0; nt < 4; ++nt) {
                    const size_t o = (size_t)(t0 + t) * 1024 + hd * 64 + 16 * nt + fr;
                    mixb[o] = (bf16)f2bf(bf2f(uraw[r][nt]) * (acc[nt][r] + bias));
                }
            }
        }
        __syncthreads();
    }
}


__device__ __forceinline__ int otid_(int wave_s) { int t = wave_s * 64 + (int)__builtin_amdgcn_mbcnt_hi(~0u, __builtin_amdgcn_mbcnt_lo(~0u, 0u)); asm volatile("" : "+v"(t)); return t; }
#define otid() otid_(wave_s)
#define PH_IDS const int tid = otid(), lane = tid & 63, wave = wave_s, gw = bx * NWAVES + wave; (void)lane; (void)wave; (void)gw
__global__ void __launch_bounds__(NT, 2) fwd_kernel(Args A) {
    extern __shared__ __attribute__((aligned(16))) unsigned char lds_raw[];
    LAS unsigned char* lds = (LAS unsigned char*)lds_raw;
    LAS float* ldsf = (LAS float*)lds;
    const int G = gridDim.x, bx = blockIdx.x, NGW = G * NWAVES;
    const int wave_s = __builtin_amdgcn_readfirstlane((int)(threadIdx.x >> 6));
    unsigned char* ws = A.ws;
    float* mod = (float*)(ws + WS_MOD); float* a2g = (float*)(ws + WS_A2); float* bias1 = (float*)(ws + WS_BIAS1); float* bias3 = (float*)(ws + WS_BIAS3);
    float* r1 = (float*)(ws + WS_R1); float* rss2 = (float*)(ws + WS_RSS2); float* gbuf = (float*)(ws + WS_G); float* bbuf = (float*)(ws + WS_BETA); float* pab = (float*)(ws + WS_PAB);
    bf16* K1b = (bf16*)(ws + WS_K1B); bf16* K2b = (bf16*)(ws + WS_K2B); bf16* GWb = (bf16*)(ws + WS_GWB);
    bf16* W1T = (bf16*)(ws + WS_W1T); bf16* W2T = (bf16*)(ws + WS_W2T); bf16* W3T = (bf16*)(ws + WS_W3T);
    bf16* xb = (bf16*)(ws + WS_XB); bf16* mixb = (bf16*)(ws + WS_XB);
    bf16* Pgm = (bf16*)(ws + WS_PGM); bf16* x1b = (bf16*)(ws + WS_PGM);
    bf16* Pqkv = (bf16*)(ws + WS_PQKV); bf16* qq = (bf16*)(ws + WS_WC);
    bf16* Pz = (bf16*)(ws + WS_PZ);
    bf16* Wc = (bf16*)(ws + WS_WC); bf16* KdT = (bf16*)(ws + WS_KDT); bf16* Uc = (bf16*)(ws + WS_UC); bf16* Qd = (bf16*)(ws + WS_QD); bf16* At = (bf16*)(ws + WS_AT);
    bf16* Sbuf = (bf16*)(ws + WS_PGM); bf16* Vbuf = (bf16*)(ws + WS_PQKV); float* glb = gbuf;
    int* ids = (int*)(ws + WS_IDS); float* gates = (float*)(ws + WS_GATES);

    if (threadIdx.x < 128) ((LAS unsigned*)(lds + LDSCTL_OFF))[threadIdx.x] = 0u;
    __syncthreads();
    XcdBarrier bar; bar.bar = (unsigned*)(ws + WS_CTL) + 1024; bar.x = xb_xcc_id(); bar.w = wave_s; bar.st = (volatile LAS unsigned*)(lds + MISC_OFF);
    if (threadIdx.x == 0) bar.st[2] = xb_add(&bar.bar[XB_XCNT(bar.x)], 1u);

#define STAMP(k) do { if (TS_B >= 0 && bx == 0 && wave_s == 0 && __builtin_amdgcn_mbcnt_hi(~0u, __builtin_amdgcn_mbcnt_lo(~0u, 0u)) == 0u) ((unsigned long long*)(A.ws + WS_CTL + 32 * KiB))[k] = __builtin_amdgcn_s_memrealtime(); } while (0)
    STAMP(0);
    for (int rep_ = 0; rep_ < REP_P0; ++rep_) {
        PH_IDS;
        if (bx < 192) {
            for (int i = tid; i < 1024; i += NT) ldsf[i] = silu_f(A.c[i]);
            __syncthreads();
            for (int it = bx; it < 192; it += G) gemv_item<32>(ldsf, A.w_ada, 6144, it * 32, 6144, mod, A.b_ada, ldsf + 1024, tid);
        }
        {
            LAS float* scr = ldsf + 4096 + wave * 2176;
            int it0 = gw, its = NGW, itn = 3072;
            if (G == 256) { if (bx < 192) { it0 = gw; itn = gw + 1; its = 1; } else { it0 = 1536 + (bx - 192) * NWAVES + wave; its = 512; } }
            for (int it = it0; it < itn; it += its) {
                if (it < 512) transpose_item(A.w_out, 1024, 1024, 32, W2T, scr, it, lane, nullptr, nullptr);
                else if (it < 2048) transpose_item(A.w_in, DIN, 1024, 96, W1T, scr, it - 512, lane, nullptr, nullptr);
                else transpose_item(A.peer_wq, 2048, 1024, 64, W3T, scr, it - 2048, lane, nullptr, nullptr);
            }
        }
        for (int i = bx * NT + tid; i < 2 * 32768; i += G * NT) {
            const f32x4 v = (i < 32768) ? ((const f32x4*)A.keys1)[i] : ((const f32x4*)A.keys2)[i - 32768];
            unsigned long long* dst = (i < 32768) ? (unsigned long long*)K1b + i : (unsigned long long*)K2b + (i - 32768);
            *dst = (unsigned long long)pk2(v.x, v.y) | ((unsigned long long)pk2(v.z, v.w) << 32);
        }
        for (int i = bx * NT + tid; i < 32768; i += G * NT) {
            const f32x4 v = ((const f32x4*)A.gm_ws)[i]; const int t = (i >> 5) & 127, s0 = (i & 31) * 4;
            ((unsigned long long*)GWb)[i] = (unsigned long long)pk2(s0 <= t ? v.x : 0.f, s0 + 1 <= t ? v.y : 0.f) | ((unsigned long long)pk2(s0 + 2 <= t ? v.z : 0.f, s0 + 3 <= t ? v.w : 0.f) << 32);
        }
    }
    xcd_barrier(bar); STAMP(1);

    for (int rep_ = 0; rep_ < REP_P1; ++rep_) {
        PH_IDS;
        const float* sh1 = mod; const float* sc1 = mod + 1024; const float* sh2 = mod + 3072; const float* sc2 = mod + 4096;
        LAS float* vec1 = ldsf;
        LAS float* vec2 = ldsf + 1024;
        LAS float* part = ldsf + 2048;
        LAS float* wab = ldsf + 4096;
        LAS float* bab = ldsf + 12288;
        LAS float* sA = ldsf + 12544;
#pragma unroll
        for (int i = tid; i < 1024; i += NT) { vec1[i] = sh1[i]; vec2[i] = sh2[i]; sA[i] = A.norm1_w[i] * (1.f + sc1[i]); }
        {
            float wv[16], nv[16], sv[16];
#pragma unroll
            for (int q = 0; q < 16; ++q) { const int i = tid + q * NT, k = i >> 3, j = i & 7; wv[q] = A.w_in[(size_t)k * DIN + 3072 + j]; nv[q] = A.norm1_w[k]; sv[q] = sc1[k]; }
#pragma unroll
            for (int q = 0; q < 16; ++q) { const int i = tid + q * NT, k = i >> 3, j = i & 7; wab[j * 1024 + k] = nv[q] * (1.f + sv[q]) * wv[q]; }
        }
        if (bx == G - 1) for (int i = tid; i < 1024; i += NT) a2g[i] = A.norm2_w[i] * (1.f + sc2[i]);
        __syncthreads();
        {
            float s = 0.f, wv[16];
#pragma unroll
            for (int q = 0; q < 16; ++q) wv[q] = A.w_in[(size_t)(lane + 64 * q) * DIN + 3072 + wave];
#pragma unroll
            for (int q = 0; q < 16; ++q) s += vec1[lane + 64 * q] * wv[q];
            s = wave_sum(s);
            if (lane == 0) bab[wave] = s;
        }
        __syncthreads();
        for (int it = bx; it < 160; it += G) {
            if (it < 96) gemv_item<32>(vec1, A.w_in, DIN, it * 32, 3072, bias1, nullptr, part, tid);
            else gemv_item<32>(vec2, A.peer_wq, 2048, (it - 96) * 32, 2048, bias3, nullptr, part, tid);
        }
        int r0, nr;
        if (G == 256) { if (bx < 160) { r0 = 56 * bx; nr = 56; } else { const int j = bx - 160; r0 = 8960 + 77 * j + (j < 32 ? j : 32); nr = 77 + (j < 32 ? 1 : 0); } }
        else { r0 = (int)(((long long)SEQ * bx) / G); nr = (int)(((long long)SEQ * (bx + 1)) / G) - r0; }
        f32x4 sa[4];
#pragma unroll
        for (int j = 0; j < 4; ++j) sa[j] = ((const LAS f32x4*)sA)[j * 64 + lane];
        const bool b1 = (lane & 1) != 0, b2 = (lane & 2) != 0, b4 = (lane & 4) != 0;
        for (int i0 = wave; i0 < nr; i0 += 32) {
            int rows[4];
            f32x4 v[4][4];
#pragma unroll
            for (int r = 0; r < 4; ++r) {
                const int i = i0 + 8 * r;
                rows[r] = r0 + (i < nr ? i : nr - 1);
#pragma unroll
                for (int j = 0; j < 4; ++j) v[r][j] = ((const f32x4*)(A.x + (size_t)rows[r] * 1024))[j * 64 + lane];
            }
            float d[4][8], ss[4];
#pragma unroll
            for (int r = 0; r < 4; ++r) {
                float s = 0.f;
#pragma unroll
                for (int j = 0; j < 4; ++j) s += (v[r][j].x * v[r][j].x + v[r][j].y * v[r][j].y) + (v[r][j].z * v[r][j].z + v[r][j].w * v[r][j].w);
                ss[r] = s;
            }
#pragma unroll
            for (int jc = 0; jc < 8; ++jc) {
#pragma unroll
                for (int r = 0; r < 4; ++r) d[r][jc] = 0.f;
#pragma unroll
                for (int j = 0; j < 4; ++j) {
                    const f32x4 w = ((const LAS f32x4*)(wab + jc * 1024))[j * 64 + lane];
#pragma unroll
                    for (int r = 0; r < 4; ++r) d[r][jc] += (v[r][j].x * w.x + v[r][j].y * w.y) + (v[r][j].z * w.z + v[r][j].w * w.w);
                }
            }
#pragma unroll
            for (int r = 0; r < 4; ++r) {
#pragma unroll
                for (int j = 0; j < 4; ++j) {
                    const f32x4 y = v[r][j] * sa[j];
                    ((unsigned long long*)(xb + (size_t)rows[r] * 1024))[j * 64 + lane] = (unsigned long long)pk2(y.x, y.y) | ((unsigned long long)pk2(y.z, y.w) << 32);
                }
                float e4[4], e2[2];
#pragma unroll
                for (int i = 0; i < 4; ++i) { const float send = b4 ? d[r][i] : d[r][i + 4], keep = b4 ? d[r][i + 4] : d[r][i]; e4[i] = keep + __shfl_xor(send, 4); }
#pragma unroll
                for (int i = 0; i < 2; ++i) { const float send = b2 ? e4[i] : e4[i + 2], keep = b2 ? e4[i + 2] : e4[i]; e2[i] = keep + __shfl_xor(send, 2); }
                float e1 = (b1 ? e2[1] : e2[0]) + __shfl_xor(b1 ? e2[0] : e2[1], 1);
                e1 += __shfl_xor(e1, 8); e1 += __shfl_xor(e1, 16); e1 += __shfl_xor(e1, 32);
                const float rr = __builtin_amdgcn_rsqf(wave_sum(ss[r]) * (1.f / 1024.f) + 1e-6f);
                if (lane < 8) pab[(size_t)rows[r] * 8 + lane] = e1 * rr + bab[lane];
                if (lane == 0) r1[rows[r]] = rr;
            }
        }
    }
    xcd_barrier(bar); STAMP(2);

    {
        pg8::Gemm g{xb, W1T, SEQ, 3072, 1024}; pg8::StaticOrder S; S.init(SEQ, 3072, G, bx);
        pg8::Epi1 E{Pgm, Pqkv, Pz, r1, bias1, rss2, SEQ};
        pg8::gemm_phase<pg8::Epi1, pg8::StaticOrder, true, true>(lds, g, S, E, otid());
    }
    xcd_barrier(bar); STAMP(3);

    {
        PH_IDS;
        for (int rep_ = 0; rep_ < REP_GMLP; ++rep_) gmlp_phase(lds, bx, G, tid, Pgm, GWb, A.gm_norm_w, A.gm_bs, mixb, rss2);
        STAMP(14);
        for (int rep_ = 0; rep_ < REP_DNPREP; ++rep_) dn_prep(lds, bx, G, otid(), Pqkv, pab, A.conv_w, A.a_log, A.dt_bias, Wc, KdT, Uc, Qd, At, glb, TS_B >= 0 ? (unsigned long long*)(A.ws + WS_CTL + 32 * KiB) : nullptr);
    }
    xcd_barrier(bar); STAMP(4);

    int vbx = bx; bool xuni;
    {
        if (otid() == 0) {
            int np = 0, px = 0, nloc = 1; bool uni = (G == 256);
#pragma unroll
            for (int j = 0; j < 16; ++j) { const unsigned c = xb_ld(&bar.bar[XB_XCNT(j)]); if (c > 0u) { if (j < (int)bar.x) ++px; ++np; if (c != 32u) uni = false; } if (j == (int)bar.x) nloc = (int)c; }
            bar.st[4] = (unsigned)np; bar.st[5] = (unsigned)px; bar.st[6] = (unsigned)(nloc > 0 ? nloc : 1); bar.st[7] = (uni && np == 8) ? 1u : 0u;
        }
        __syncthreads();
        xuni = bar.st[7] != 0u;
        if (xuni) vbx = (int)bar.st[5] * 32 + (int)bar.st[2];
        vbx = __builtin_amdgcn_readfirstlane(vbx);
    }
    for (int rep_ = 0; rep_ < REP_SCAN; ++rep_)
    for (int u = vbx; u < 256; u += G) {
        const int h = u >> 6, grp = (u >> 2) & 15, p = u & 3;
        if (p < 2) dn_seg<1>(lds, otid(), h, grp, 4 * (p & 1), Wc, KdT, Uc, glb, Sbuf, Vbuf, ws + WS_PHI, (float*)(ws + WS_SL), (const float*)(ws + WS_SS));
        else       dn_seg<0>(lds, otid(), h, grp, 4 * (p & 1), Wc, KdT, Uc, glb, Sbuf, Vbuf, ws + WS_PHI, (float*)(ws + WS_SL), (const float*)(ws + WS_SS));
    }
    xcd_barrier(bar); STAMP(25);
    const int mu = xuni ? ((vbx & 63) < 2 ? (vbx >> 6) * 2 + (vbx & 63) : -1) : (bx < 8 ? bx : -1);
    if (mu >= 0) for (int rep_ = 0; rep_ < REP_SCAN; ++rep_) dn_mid2(lds, otid(), mu >> 1, mu & 1, ws + WS_PHI, (const float*)(ws + WS_SL), (float*)(ws + WS_SS));
    {
        PH_IDS;
        if (xuni && ((vbx >> 5) & 1) == 0 && mu < 0) {
            const int hh = vbx >> 6, L = ((vbx & 31) - 2) * NT + tid;
            if (L < 15 * 768) {
                const int gq = L / 768, r = L - gq * 768;
                const unsigned char* pa = (r < 256) ? (ws + WS_PHI) + (size_t)(hh * DN_G + gq) * 32768 + (size_t)r * 128
                                                    : (const unsigned char*)((const float*)(ws + WS_SL) + (size_t)(hh * DN_G + gq) * 8 * 2048) + (size_t)(r - 256) * 128;
                const unsigned tv = *(const unsigned*)pa;
                asm volatile("" :: "v"(tv));
            }
        }
        const int cb = xuni ? ((((vbx >> 5) & 1) == 1) ? (vbx >> 6) * 32 + (vbx & 31) : -1) : ((G > 8) ? bx - 8 : bx), ncb = xuni ? 128 : ((G > 8) ? G - 8 : G);
        if (cb >= 0) for (int rep_ = 0; rep_ < REP_CONV; ++rep_) uv_convert_table_dma(A.peer_u, ws + WS_UB, (float*)(ws + WS_SCU), cb * NWAVES + wave, ncb * NWAVES, lane, lds + wave * 16384);
    }
    xcd_barrier(bar); STAMP(5);

    {
    const int xr = vbx & 31, xp = vbx >> 5;
    const int u3 = xuni ? (xr < 16 ? xp * 16 + xr : 128) : bx, u3s = xuni ? 256 : G;
    const int cb = xuni ? (xr >= 16 ? xp * 16 + xr - 16 : -1) : ((G > 128) ? bx - 128 : bx), ncb = xuni ? 128 : ((G > 128) ? G - 128 : G);
    for (int rep_ = 0; rep_ < REP_SCAN; ++rep_)
    for (int u = u3; u < 128; u += u3s) {
        const int h = u >> 5, grp = (u >> 1) & 15, hb = u & 1;
        dn_seg<2>(lds, otid(), h, grp, 4 * hb, Wc, KdT, Uc, glb, Sbuf, Vbuf, ws + WS_PHI, (float*)(ws + WS_SL), (const float*)(ws + WS_SS));
    }
    {
        PH_IDS;
        if (cb >= 0) for (int rep_ = 0; rep_ < REP_CONV; ++rep_) uv_convert_table_dma(A.peer_v, ws + WS_VB, (float*)(ws + WS_SCV), cb * NWAVES + wave, ncb * NWAVES, lane, lds + wave * 16384);
    }
    }
    xcd_barrier(bar); STAMP(26);

    for (int rep_ = 0; rep_ < REP_DNOUT; ++rep_) dn_out(lds, bx, G, otid(), Qd, At, Sbuf, Vbuf, Pz, A.o_norm_w, mixb);
    xcd_barrier(bar); STAMP(6);

    {
        pg8::Gemm g{mixb, W2T, SEQ, 1024, 1024}; pg8::StaticOrder S; S.init(SEQ, 1024, G, bx);
        pg8::Epi2 E{A.x, (bf16*)A.out, x1b, mod + 2048, rss2, SEQ, a2g};
        pg8::gemm_phase<pg8::Epi2, pg8::StaticOrder, true, true>(lds, g, S, E, otid());
    }
    xcd_barrier(bar); STAMP(7);

    {
        pg8::Gemm g{x1b, W3T, SEQ, 2048, 1024}; pg8::StaticOrder S; S.init(SEQ, 2048, G, bx);
        pg8::Epi3 E{qq, rss2, bias3, SEQ};
        pg8::gemm_phase<pg8::Epi3, pg8::StaticOrder, true, true>(lds, g, S, E, otid());
    }
    xcd_barrier(bar); STAMP(8);

    {
        PH_IDS;
        for (int row = gw; row < SEQ; row += NGW) {
            const float rs = (lane < 16) ? rss2[(size_t)lane * SEQ + row] : 0.f;
            const float r = __builtin_amdgcn_rsqf(wave_sum(rs) * (1.f / 1024.f) + 1e-6f);
            if (lane == 0) r1[row] = r;
        }
        STAMP(20);
        for (int rep_ = 0; rep_ < REP_ROUTE; ++rep_) route_phase(lds, bx, G, tid, qq, K1b, K2b, ids, gates, nullptr);
    }
    xcd_barrier(bar); STAMP(9);

    {
    PH_IDS;
    XcdMap XM;
    { const int np = (int)bar.st[4]; XM.rank = (int)bar.st[2]; XM.nloc = (int)bar.st[6]; XM.px = (int)bar.st[5]; XM.np = np > 0 ? np : 1; }
    for (int rep_ = 0; rep_ < REP_PRE; ++rep_) peer_pre_dma(XM, tid, lds, ws, ws + WS_UB, (const bf16*)A.out, r1, mod, A.norm2_w, ids);
    xcd_barrier(bar); STAMP(10);

    for (int rep_ = 0; rep_ < REP_P10; ++rep_)
    for (int idx = bx * NT + tid; idx < SEQ * 128 / 4; idx += G * NT) {
        f32x4 sacc = {0.f, 0.f, 0.f, 0.f};
#pragma unroll
        for (int c = 0; c < 8; ++c) sacc += *(const f32x4*)(pre_slab(ws, c) + (size_t)idx * 4);
        const f32x4 gt = *(const f32x4*)(gates + (size_t)idx * 4);
        const int4 id4 = *(const int4*)(ids + (size_t)idx * 4);
        const float* scu = (const float*)(ws + WS_SCU); const float* scv = (const float*)(ws + WS_SCV);
        f32x4 o; o.x = gt.x * gelu_f(sacc.x * scu[id4.x]) * scv[id4.x]; o.y = gt.y * gelu_f(sacc.y * scu[id4.y]) * scv[id4.y];
        o.z = gt.z * gelu_f(sacc.z * scu[id4.z]) * scv[id4.z]; o.w = gt.w * gelu_f(sacc.w * scu[id4.w]) * scv[id4.w];
        v4u opk; opk.x = (f2bf(o.x) << 16) | (unsigned)id4.x; opk.y = (f2bf(o.y) << 16) | (unsigned)id4.y; opk.z = (f2bf(o.z) << 16) | (unsigned)id4.z; opk.w = (f2bf(o.w) << 16) | (unsigned)id4.w;
        *(v4u*)((unsigned*)(ws + WS_COEF) + (size_t)idx * 4) = opk;
    }
    xcd_barrier(bar); STAMP(11);

    for (int rep_ = 0; rep_ < REP_OUT; ++rep_) peer_out(XM, tid, ws + WS_VB, (const bf16*)A.out, (float*)(ws + WS_X2), mod, ids, (const float*)(ws + WS_COEF), rss2);
    xcd_barrier(bar); STAMP(12);

    for (int row = gw; row < SEQ; row += NGW) {
        const float rs = (lane < 8) ? rss2[(size_t)lane * SEQ + row] : 0.f;
        const float rn = __builtin_amdgcn_rsqf(wave_sum(rs) * (1.f / 1024.f) + 1e-6f);
        f32x4* o = (f32x4*)(A.out + (size_t)row * 1024) + lane; const f32x4* fw = (const f32x4*)A.final_w + lane;
        const unsigned long long* xi = (const unsigned long long*)((const unsigned short*)(ws + WS_X2) + (size_t)row * 1024) + lane;
        unsigned long long q[4];
#pragma unroll
        for (int j = 0; j < 4; ++j) q[j] = xi[64 * j];
#pragma unroll
        for (int j = 0; j < 4; ++j) o[64 * j] = (f32x4){bflo((unsigned)q[j]), bfhi((unsigned)q[j]), bflo((unsigned)(q[j] >> 32)), bfhi((unsigned)(q[j] >> 32))} * rn * fw[64 * j];
    }
    }
    for (int rep_ = 0; rep_ < REP_BAR; ++rep_) xcd_barrier(bar);
    if (TS_B >= 0) {
        xcd_barrier(bar); STAMP(13);
        xcd_barrier(bar);
        const unsigned long long* stamps = (const unsigned long long*)(A.ws + WS_CTL + 32 * KiB);
        const unsigned long long ta = __hip_atomic_load(&stamps[TS_A >= 0 ? TS_A : 0], __ATOMIC_RELAXED, __HIP_MEMORY_SCOPE_AGENT), tb = __hip_atomic_load(&stamps[TS_B >= 0 ? TS_B : 0], __ATOMIC_RELAXED, __HIP_MEMORY_SCOPE_AGENT);
        const float dtus = (float)(tb - ta) * 0.01f;
        const float scale = 1.f + 0.01f * floorf((dtus + (float)TS_T1) / (float)TS_T2);
        for (size_t i = (size_t)bx * NT + otid(); i < (size_t)SEQ * 1024; i += (size_t)G * NT) A.out[i] *= scale;
    }
}

extern "C" void kernel_launch(void* const* d_in, const int* in_sizes, int n_in, void* d_out, int out_size, void* d_ws, size_t ws_size, hipStream_t stream) {
    static int grid = 0;
    if (grid == 0) {
        if (n_in != 21 || in_sizes[0] != SEQ * DM || out_size != SEQ * DM || ws_size < WS_END) { fprintf(stderr, "kernel_launch: unexpected shapes (n_in %d, ws %zu); nothing launched\n", n_in, ws_size); grid = -1; return; }
        int dev = 0, cus = 0, per_cu = 0;
        if (hipGetDevice(&dev) != hipSuccess || hipDeviceGetAttribute(&cus, hipDeviceAttributeMultiprocessorCount, dev) != hipSuccess) { grid = -1; return; }
        if (hipFuncSetAttribute((const void*)fwd_kernel, hipFuncAttributeMaxDynamicSharedMemorySize, LDS_BYTES) != hipSuccess) { fprintf(stderr, "kernel_launch: hipFuncSetAttribute failed\n"); grid = -1; return; }
        if (hipOccupancyMaxActiveBlocksPerMultiprocessor(&per_cu, (const void*)fwd_kernel, NT, LDS_BYTES) != hipSuccess || per_cu < 1) { fprintf(stderr, "kernel_launch: occupancy query says %d blocks per CU\n", per_cu); }
        (void)hipGetLastError();
        grid = cus;
    }
    if (grid < 0) return;
    (void)hipMemsetAsync((char*)d_ws + WS_CTL, 0, CTL_ZERO_BYTES, stream);
    Args a{};
    a.x = (const float*)d_in[0]; a.c = (const float*)d_in[1]; a.w_ada = (const float*)d_in[2]; a.b_ada = (const float*)d_in[3]; a.norm1_w = (const float*)d_in[4];
    a.w_in = (const float*)d_in[5]; a.gm_norm_w = (const float*)d_in[6]; a.gm_ws = (const float*)d_in[7]; a.gm_bs = (const float*)d_in[8]; a.conv_w = (const float*)d_in[9];
    a.a_log = (const float*)d_in[10]; a.dt_bias = (const float*)d_in[11]; a.o_norm_w = (const float*)d_in[12]; a.w_out = (const float*)d_in[13]; a.norm2_w = (const float*)d_in[14];
    a.peer_wq = (const float*)d_in[15]; a.keys1 = (const float*)d_in[16]; a.keys2 = (const float*)d_in[17]; a.peer_u = (const float*)d_in[18]; a.peer_v = (const float*)d_in[19];
    a.final_w = (const float*)d_in[20]; a.out = (float*)d_out; a.ws = (unsigned char*)d_ws;
    hipLaunchKernelGGL(fwd_kernel, dim3(grid), dim3(NT), LDS_BYTES, stream, a);
}
```
